# Optimizing an MI355X kernel written in HIP

```python
import jax
import jax.numpy as jnp
from jax import lax
import numpy as np


D_MODEL = 1024
BATCH = 4
SEQ = 4096
DEPTH = 2

EPS = 1e-6
NEG_INF = -1e30
Q_BLOCK = 128

MLA_HEADS = 8
MLA_NOPE = 64
MLA_ROPE = 32
MLA_V = 64
MLA_Q_RANK = 384
MLA_KV_RANK = 256
ROPE_THETA = 10000.0

NSA_HEADS = 8
NSA_KV_HEADS = 2
NSA_REP = NSA_HEADS // NSA_KV_HEADS
NSA_DH = 64
L_CMP = 32
D_CMP = 16
CMP_HID = 128
L_SEL = 64
N_SEL = 16
W_WIN = 512

D_MIX = MLA_HEADS * MLA_V + NSA_HEADS * NSA_DH
NSA_KV = NSA_KV_HEADS * NSA_DH
D_IN = MLA_Q_RANK + MLA_KV_RANK + MLA_ROPE + NSA_HEADS * NSA_DH + 6 * NSA_KV + 3 * NSA_HEADS

D_FF = 2816
CONV_W = 3

kernel_name = 'mla_nsa_hybrid_convffn'


def rmsnorm(x, g):
    x32 = x.astype(jnp.float32)
    y = x32 * lax.rsqrt(jnp.mean(x32 * x32, axis=-1, keepdims=True) + EPS)
    return (y * g.astype(jnp.float32)).astype(x.dtype)


def alibi_slopes(n):
    return jnp.exp2(-8.0 * jnp.arange(1, n + 1, dtype=jnp.float32) / n)


def rope_tables(S, dim):
    inv = 1.0 / (ROPE_THETA ** (jnp.arange(0, dim, 2, dtype=jnp.float32) / dim))
    ang = jnp.arange(S, dtype=jnp.float32)[:, None] * inv[None, :]
    return jnp.cos(ang), jnp.sin(ang)


def apply_rope(x, cos, sin):
    x1, x2 = jnp.split(x, 2, axis=-1)
    c = cos.astype(x.dtype)
    s = sin.astype(x.dtype)
    return jnp.concatenate([x1 * c - x2 * s, x2 * c + x1 * s], axis=-1)


def mla_attention(c_q, c_kv, k_rope, q_norm, kv_norm, w_uq, w_ukv):
    B, S, _ = c_q.shape
    H = MLA_HEADS
    q = (rmsnorm(c_q, q_norm) @ w_uq).reshape(B, S, H, MLA_NOPE + MLA_ROPE)
    kv = (rmsnorm(c_kv, kv_norm) @ w_ukv).reshape(B, S, H, MLA_NOPE + MLA_V)
    q_nope, q_rope = q[..., :MLA_NOPE], q[..., MLA_NOPE:]
    k_nope, v = kv[..., :MLA_NOPE], kv[..., MLA_NOPE:]
    cos, sin = rope_tables(S, MLA_ROPE)
    q_rope = apply_rope(q_rope, cos[:, None, :], sin[:, None, :])
    k_rope = apply_rope(k_rope, cos, sin)
    scale = (MLA_NOPE + MLA_ROPE) ** -0.5
    nq = S // Q_BLOCK
    qn = q_nope.reshape(B, nq, Q_BLOCK, H, MLA_NOPE).transpose(1, 0, 2, 3, 4)
    qr = q_rope.reshape(B, nq, Q_BLOCK, H, MLA_ROPE).transpose(1, 0, 2, 3, 4)
    kpos = jnp.arange(S)

    def block(args):
        qn_b, qr_b, qb = args
        s = (jnp.einsum('bqhd,bkhd->bhqk', qn_b, k_nope)
             + jnp.einsum('bqhd,bkd->bhqk', qr_b, k_rope)).astype(jnp.float32) * scale
        qpos = qb * Q_BLOCK + jnp.arange(Q_BLOCK)
        s = jnp.where(kpos[None, :] <= qpos[:, None], s, NEG_INF)
        p = jax.nn.softmax(s, axis=-1).astype(v.dtype)
        return jnp.einsum('bhqk,bkhd->bqhd', p, v)

    o = lax.map(block, (qn, qr, jnp.arange(nq)))
    return o.transpose(1, 0, 2, 3, 4).reshape(B, S, H * MLA_V)


def nsa_attention(q, k_c, v_c, k_s, v_s, k_w, v_w, gates,
                  pos_k, pos_v, ck_w1, ck_w2, cv_w1, cv_w2):
    B, S, G, R, dh = q.shape
    dt = q.dtype
    slopes = alibi_slopes(NSA_HEADS).reshape(G, R)
    scale = dh ** -0.5
    t = jnp.arange(S)

    n_cmp = (S - L_CMP) // D_CMP + 1
    tok = jnp.arange(n_cmp)[:, None] * D_CMP + jnp.arange(L_CMP)[None, :]

    def compress(a, pos, w1, w2):
        blocks = a[:, tok] + pos[None, None, :, None, :]
        hid = jax.nn.gelu(jnp.einsum('bnlgd,lde->bnge', blocks, w1))
        return jnp.einsum('bnge,ed->bngd', hid, w2)

    kc = compress(k_c, pos_k, ck_w1, ck_w2)
    vc = compress(v_c, pos_v, cv_w1, cv_w2)
    blk_end = jnp.arange(n_cmp) * D_CMP + L_CMP - 1
    dist_c = t[:, None] - blk_end[None, :]
    mask_c = dist_c >= 0
    s_c = (jnp.einsum('bsgrd,bngd->bgrsn', q, kc).astype(jnp.float32) * scale
           - slopes[:, :, None, None] * dist_c.astype(jnp.float32))
    p_cmp = jax.nn.softmax(jnp.where(mask_c, s_c, NEG_INF), axis=-1) * mask_c
    o_cmp = jnp.einsum('bgrsn,bngd->bsgrd', p_cmp.astype(dt), vc)

    n_blk = S // L_SEL
    cs = jnp.arange(n_cmp) * D_CMP
    ss = jnp.arange(n_blk) * L_SEL
    overlap = ((cs[:, None] < ss[None, :] + L_SEL)
               & (cs[:, None] + L_CMP > ss[None, :])).astype(jnp.float32)
    imp = jnp.einsum('bgrsn,nj->bgsj', p_cmp, overlap)
    cur = (t // L_SEL)[:, None]
    j = jnp.arange(n_blk)[None, :]
    imp = jnp.where(j > cur, -jnp.inf, imp)
    imp = jnp.where((j == 0) | (j == cur) | (j == cur - 1), jnp.inf, imp)
    n_top = min(N_SEL, n_blk)
    _, idx = lax.top_k(imp, n_top)

    kb = k_s.reshape(B, n_blk, L_SEL, G, dh).transpose(0, 3, 1, 2, 4)
    vb = v_s.reshape(B, n_blk, L_SEL, G, dh).transpose(0, 3, 1, 2, 4)
    nq = S // Q_BLOCK
    q_ch = q.reshape(B, nq, Q_BLOCK, G, R, dh).transpose(1, 0, 2, 3, 4, 5)
    idx_ch = idx.reshape(B, G, nq, Q_BLOCK, n_top).transpose(2, 0, 1, 3, 4)
    bi = jnp.arange(B)[:, None, None, None]
    gi = jnp.arange(G)[None, :, None, None]

    def sel_block(args):
        q_b, idx_b, qb = args
        kg = kb[bi, gi, idx_b]
        vg = vb[bi, gi, idx_b]
        tq = qb * Q_BLOCK + jnp.arange(Q_BLOCK)
        kpos = idx_b[..., None] * L_SEL + jnp.arange(L_SEL)
        dist = (tq[None, None, :, None, None] - kpos)[:, :, None]
        s = (jnp.einsum('bqgrd,bgqnld->bgrqnl', q_b, kg).astype(jnp.float32) * scale
             - slopes[None, :, :, None, None, None] * dist.astype(jnp.float32))
        s = jnp.where(dist >= 0, s, NEG_INF).reshape(B, G, R, Q_BLOCK, n_top * L_SEL)
        p = jax.nn.softmax(s, axis=-1).reshape(B, G, R, Q_BLOCK, n_top, L_SEL).astype(dt)
        return jnp.einsum('bgrqnl,bgqnld->bqgrd', p, vg)

    o_sel = lax.map(sel_block, (q_ch, idx_ch, jnp.arange(nq)))
    o_sel = o_sel.transpose(1, 0, 2, 3, 4, 5).reshape(B, S, G, R, dh)

    n_prev = W_WIN // Q_BLOCK

    def bands(a):
        ap = jnp.pad(a, ((0, 0), (W_WIN, 0), (0, 0), (0, 0)))
        ap = ap.reshape(B, nq + n_prev, Q_BLOCK, G, dh)
        return jnp.concatenate([ap[:, i:i + nq] for i in range(n_prev + 1)], axis=2)

    kw = bands(k_w)
    vw = bands(v_w)
    qw = q.reshape(B, nq, Q_BLOCK, G, R, dh)
    tq = t.reshape(nq, Q_BLOCK)
    kpos = jnp.arange(nq)[:, None] * Q_BLOCK - W_WIN + jnp.arange((n_prev + 1) * Q_BLOCK)[None, :]
    dist_w = tq[:, :, None] - kpos[:, None, :]
    mask_w = (dist_w >= 0) & (dist_w < W_WIN) & (kpos[:, None, :] >= 0)
    s_w = (jnp.einsum('bnqgrd,bnkgd->bgrnqk', qw, kw).astype(jnp.float32) * scale
           - slopes[:, :, None, None, None] * dist_w.astype(jnp.float32))
    p_w = jax.nn.softmax(jnp.where(mask_w, s_w, NEG_INF), axis=-1).astype(dt)
    o_win = jnp.einsum('bgrnqk,bnkgd->bnqgrd', p_w, vw).reshape(B, S, G, R, dh)

    g = jax.nn.sigmoid(gates.astype(jnp.float32)).astype(dt)
    o = g[..., 0:1] * o_cmp + g[..., 1:2] * o_sel + g[..., 2:3] * o_win
    return o.reshape(B, S, G * R * dh)


def token_mixer(n, w_in, q_norm, kv_norm, w_uq, w_ukv, pos_k, pos_v,
                ck_w1, ck_w2, cv_w1, cv_w2, w_o):
    B, S, _ = n.shape
    z = n @ w_in
    sizes = [MLA_Q_RANK, MLA_KV_RANK, MLA_ROPE, NSA_HEADS * NSA_DH] + [NSA_KV] * 6 + [3 * NSA_HEADS]
    offs = [int(o) for o in np.cumsum(sizes)[:-1]]
    (c_q, c_kv, k_rope, q_n, kc, vc, ks, vs, kwin, vwin, gt) = jnp.split(z, offs, axis=-1)
    o_mla = mla_attention(c_q, c_kv, k_rope, q_norm, kv_norm, w_uq, w_ukv)
    G, R, dh = NSA_KV_HEADS, NSA_REP, NSA_DH
    kvs = (B, S, G, dh)
    o_nsa = nsa_attention(q_n.reshape(B, S, G, R, dh),
                          kc.reshape(kvs), vc.reshape(kvs), ks.reshape(kvs), vs.reshape(kvs),
                          kwin.reshape(kvs), vwin.reshape(kvs), gt.reshape(B, S, G, R, 3),
                          pos_k, pos_v, ck_w1, ck_w2, cv_w1, cv_w2)
    return jnp.concatenate([o_mla, o_nsa], axis=-1) @ w_o


def conv_ffn(x, norm_g, w_up, conv_w, conv_b, w_down):
    S = x.shape[1]
    h = rmsnorm(x, norm_g) @ w_up
    hp = jnp.pad(h, ((0, 0), (CONV_W - 1, 0), (0, 0)))
    hc = conv_b
    for i in range(CONV_W):
        hc = hc + hp[:, i:i + S] * conv_w[i]
    gate, up = jnp.split(hc, 2, axis=-1)
    return (jax.nn.silu(gate) * up) @ w_down


def setup_inputs(seed: int = 0) -> dict:
    key = jax.random.key(seed)
    ks = jax.random.split(key, 20)
    f32 = jnp.float32
    L = DEPTH

    def nrm(k, shape, fan_in):
        return jax.random.normal(k, shape, f32) * (fan_in ** -0.5)

    def gain(k, shape):
        return 1.0 + 0.01 * jax.random.normal(k, shape, f32)

    return {
        'x': jax.random.normal(ks[0], (BATCH, SEQ, D_MODEL), f32),
        'attn_norm': gain(ks[1], (L, D_MODEL)),
        'w_in': nrm(ks[2], (L, D_MODEL, D_IN), D_MODEL),
        'q_norm': gain(ks[3], (L, MLA_Q_RANK)),
        'kv_norm': gain(ks[4], (L, MLA_KV_RANK)),
        'w_uq': nrm(ks[5], (L, MLA_Q_RANK, MLA_HEADS * (MLA_NOPE + MLA_ROPE)), MLA_Q_RANK),
        'w_ukv': nrm(ks[6], (L, MLA_KV_RANK, MLA_HEADS * (MLA_NOPE + MLA_V)), MLA_KV_RANK),
        'cmp_pos_k': 0.1 * jax.random.normal(ks[7], (L, L_CMP, NSA_DH), f32),
        'cmp_pos_v': 0.1 * jax.random.normal(ks[8], (L, L_CMP, NSA_DH), f32),
        'cmp_k_w1': nrm(ks[9], (L, L_CMP, NSA_DH, CMP_HID), L_CMP * NSA_DH),
        'cmp_k_w2': nrm(ks[10], (L, CMP_HID, NSA_DH), CMP_HID),
        'cmp_v_w1': nrm(ks[11], (L, L_CMP, NSA_DH, CMP_HID), L_CMP * NSA_DH),
        'cmp_v_w2': nrm(ks[12], (L, CMP_HID, NSA_DH), CMP_HID),
        'w_o': nrm(ks[13], (L, D_MIX, D_MODEL), D_MIX),
        'ffn_norm': gain(ks[14], (L, D_MODEL)),
        'w_up': nrm(ks[15], (L, D_MODEL, 2 * D_FF), D_MODEL),
        'conv_w': nrm(ks[16], (L, CONV_W, 2 * D_FF), CONV_W),
        'conv_b': 0.01 * jax.random.normal(ks[17], (L, 2 * D_FF), f32),
        'w_down': nrm(ks[18], (L, D_FF, D_MODEL), D_FF),
        'final_norm': gain(ks[19], (D_MODEL,)),
    }


def reference(x, attn_norm, w_in, q_norm, kv_norm, w_uq, w_ukv, cmp_pos_k, cmp_pos_v,
              cmp_k_w1, cmp_k_w2, cmp_v_w1, cmp_v_w2, w_o, ffn_norm, w_up, conv_w,
              conv_b, w_down, final_norm):
    h = x
    for l in range(DEPTH):
        h = h + token_mixer(rmsnorm(h, attn_norm[l]), w_in[l], q_norm[l], kv_norm[l],
                            w_uq[l], w_ukv[l], cmp_pos_k[l], cmp_pos_v[l],
                            cmp_k_w1[l], cmp_k_w2[l], cmp_v_w1[l], cmp_v_w2[l], w_o[l])
        h = h + conv_ffn(h, ffn_norm[l], w_up[l], conv_w[l], conv_b[l], w_down[l])
    return rmsnorm(h, final_norm)
```

```cpp
#include <hip/hip_runtime.h>
#include <hip/hip_cooperative_groups.h>
#include <stdint.h>
#include <cstdio>
namespace cg = cooperative_groups;

#define DI __device__ __forceinline__
typedef unsigned short bf16_t;
typedef short bf16x8 __attribute__((ext_vector_type(8)));
typedef float f32x4 __attribute__((ext_vector_type(4)));
typedef float f32x16 __attribute__((ext_vector_type(16)));
typedef unsigned u32x2 __attribute__((ext_vector_type(2)));
typedef unsigned u32x4 __attribute__((ext_vector_type(4)));
#define MFMA32(a, b, c) __builtin_amdgcn_mfma_f32_32x32x16_bf16((a), (b), (c), 0, 0, 0)

constexpr int NB = 4, S = 4096, M = NB * S, DM = 1024, ZP = 2048, NT = 512;
constexpr int DFF = 2816, NUP = 2 * DFF;
constexpr float EPS = 1e-6f;
constexpr int Z_CQ = 0, Z_KR = 384, Z_GT = 416, Z_CKV = 512, Z_QN = 768, Z_KC = 1280, Z_KS = 1408, Z_KW = 1536, Z_VC = 1664, Z_VS = 1792, Z_VW = 1920;
constexpr size_t MiB = 1024 * 1024;
constexpr size_t W_IN = 0, W_UQ = W_IN + (size_t)2048 * 1024 * 2, W_UKV = W_UQ + (size_t)768 * 384 * 2, W_C1K = W_UKV + (size_t)1024 * 256 * 2,
                 W_C1V = W_C1K + (size_t)256 * 2048 * 2, W_C2K = W_C1V + (size_t)256 * 2048 * 2, W_C2V = W_C2K + (size_t)256 * 128 * 2,
                 W_O = W_C2V + (size_t)256 * 128 * 2, W_UP = W_O + (size_t)1024 * 1024 * 2, W_DN = W_UP + (size_t)NUP * 1024 * 2,
                 W_END = W_DN + (size_t)1024 * DFF * 2;
constexpr size_t WL_STRIDE = 26 * MiB;
static_assert(W_END <= WL_STRIDE, "weights per layer");
constexpr size_t WS_A = 52 * MiB;
constexpr size_t WS_Z = WS_A, WS_Q = WS_A + 64 * MiB + 256 * 1024, WS_GACT = WS_A;
constexpr size_t WS_KV = 141 * MiB, WS_MIX = 173 * MiB, WS_HU = WS_KV;
constexpr size_t WS_HB = 205 * MiB + 64 * 1024;
constexpr size_t WS_MISC = 238 * MiB;
constexpr size_t WS_SSQH = WS_MISC, WS_SSQZ = WS_SSQH + 1 * MiB, WS_KR = WS_SSQZ + 2 * MiB, WS_HIDK = WS_KR + 1 * MiB, WS_HIDV = WS_HIDK + 1 * MiB,
                 WS_KCMP = WS_HIDV + 1 * MiB, WS_VCMP = WS_KCMP + 1 * MiB, WS_ROPE = WS_VCMP + 1 * MiB, WS_B1 = WS_ROPE + 1 * MiB, WS_CTL = WS_B1 + 64 * 1024,
                 WS_ENDALL = WS_CTL + 64 * 1024;
static_assert(WS_ENDALL <= 256 * MiB, "workspace");

struct Params {
    const float* in[20];
    float* out;
    unsigned char* ws;
    int ph_lo, ph_hi;
};

DI bf16_t f2bf(float x) { unsigned u = __float_as_uint(x); u += 0x7fffu + ((u >> 16) & 1u); return (bf16_t)(u >> 16); }
DI float bf2f(bf16_t b) { return __uint_as_float(((unsigned)b) << 16); }
DI unsigned pk2(float lo, float hi) { return (unsigned)f2bf(lo) | ((unsigned)f2bf(hi) << 16); }
DI float wave_sum(float v) {
#pragma unroll
    for (int o = 1; o < 64; o <<= 1) v += __shfl_xor(v, o);
    return v;
}
DI float wave_max(float v) {
#pragma unroll
    for (int o = 1; o < 64; o <<= 1) v = fmaxf(v, __shfl_xor(v, o));
    return v;
}
DI float gelu_tanh(float x) { return 0.5f * x * (1.f + tanhf(0.7978845608028654f * (x + 0.044715f * x * x * x))); }
DI float rstd_h(const float* ssqh, int row) {
    const f32x4* p = (const f32x4*)(ssqh + (size_t)row * 16); float s = 0.f;
#pragma unroll
    for (int i = 0; i < 4; ++i) { f32x4 v = p[i]; s += (v[0] + v[1]) + (v[2] + v[3]); }
    return rsqrtf(s * (1.f / 1024.f) + EPS);
}
DI float rstd_q(const float* ssqz, int row) {
    const f32x4* p = (const f32x4*)(ssqz + (size_t)row * 24); float s = 0.f;
#pragma unroll
    for (int i = 0; i < 3; ++i) { f32x4 v = p[i]; s += (v[0] + v[1]) + (v[2] + v[3]); }
    return rsqrtf(s * (1.f / 384.f) + EPS);
}
DI float rstd_kv(const float* ssqz, int row) {
    const f32x4* p = (const f32x4*)(ssqz + (size_t)row * 24 + 16); float s = 0.f;
#pragma unroll
    for (int i = 0; i < 2; ++i) { f32x4 v = p[i]; s += (v[0] + v[1]) + (v[2] + v[3]); }
    return rsqrtf(s * (1.f / 256.f) + EPS);
}

struct MapZ { DI int operator()(int n) const {
    if (n < 384) return n; if (n < 416) return 640 + (n - 384); if (n < 440) return 1952 + (n - 416); if (n < 512) return -1;
    if (n < 768) return 384 + (n - 512); if (n < 1280) return 672 + (n - 768); if (n < 1408) return 1184 + (n - 1280);
    if (n < 1536) return 1440 + (n - 1408); if (n < 1664) return 1696 + (n - 1536); if (n < 1792) return 1312 + (n - 1664);
    if (n < 1920) return 1568 + (n - 1792); return 1824 + (n - 1920); } };
struct MapUQ { DI int operator()(int n) const { if (n < 512) return (n >> 6) * 96 + (n & 63); n -= 512; return (n >> 5) * 96 + 64 + (n & 31); } };
struct MapUKV { DI int operator()(int n) const { if (n < 512) return (n >> 6) * 128 + (n & 63); n -= 512; return (n >> 6) * 128 + 64 + (n & 63); } };
struct MapUP { DI int operator()(int n) const { const int pn = n >> 8, j = n & 255; return j < 128 ? 128 * pn + j : DFF + 128 * pn + (j - 128); } };
struct MapId { int nvalid; DI int operator()(int n) const { return n < nvalid ? n : -1; } };

template <class Map>
DI void wconv(const float* __restrict__ W, int K, int Nsrc, const float* __restrict__ gain, bf16_t* __restrict__ dst, int Ndst, Map map, float* tile) {
    const int nkt = K / 64, nnt = Ndst / 64;
    for (int it = blockIdx.x; it < nkt * nnt; it += gridDim.x) {
        const int kt = it % nkt, nt = it / nkt, k0 = kt * 64, n0 = nt * 64;
        __syncthreads();
        for (int e = threadIdx.x; e < 4096; e += NT) {
            const int kk = e >> 6, nn = e & 63; const int src = map(n0 + nn); float v = 0.f;
            if (src >= 0) { v = W[(size_t)(k0 + kk) * Nsrc + src]; if (gain) v *= gain[k0 + kk]; }
            tile[kk * 65 + nn] = v;
        }
        __syncthreads();
        for (int e = threadIdx.x; e < 4096; e += NT) { const int nn = e >> 6, kk = e & 63; dst[(size_t)(n0 + nn) * K + k0 + kk] = f2bf(tile[kk * 65 + nn]); }
    }
}

template <class AF, class Epi>
DI void ngemm(AF af, const bf16_t* __restrict__ Bt, int ldb, int Mr, int N, int K, Epi epi) {
    const int lane = threadIdx.x & 63, wv = threadIdx.x >> 6, r = lane & 31, h = lane >> 5;
    const int ntn = N / 64, ntm = Mr / 64; const int gw = blockIdx.x * 8 + wv, ngw = gridDim.x * 8;
    for (int t = gw; t < ntn * ntm; t += ngw) {
        const int tn = t % ntn, tm = t / ntn, m0 = tm * 64, n0 = tn * 64;
        f32x16 acc[2][2];
#pragma unroll
        for (int a = 0; a < 2; ++a)
#pragma unroll
            for (int b = 0; b < 2; ++b)
#pragma unroll
                for (int i = 0; i < 16; ++i) acc[a][b][i] = 0.f;
        for (int k0 = 0; k0 < K; k0 += 16) {
            bf16x8 a[2], b[2];
#pragma unroll
            for (int mi = 0; mi < 2; ++mi) a[mi] = *(const bf16x8*)af(m0 + mi * 32 + r, k0 + 8 * h);
#pragma unroll
            for (int ni = 0; ni < 2; ++ni) b[ni] = *(const bf16x8*)(Bt + (size_t)(n0 + ni * 32 + r) * ldb + k0 + 8 * h);
#pragma unroll
            for (int mi = 0; mi < 2; ++mi)
#pragma unroll
                for (int ni = 0; ni < 2; ++ni) acc[mi][ni] = MFMA32(b[ni], a[mi], acc[mi][ni]);
        }
#pragma unroll
        for (int mi = 0; mi < 2; ++mi) {
            const int row = m0 + mi * 32 + r; const float ctx = epi.prep(row);
#pragma unroll
            for (int ni = 0; ni < 2; ++ni)
#pragma unroll
                for (int g = 0; g < 4; ++g) {
                    f32x4 v = {acc[mi][ni][4 * g], acc[mi][ni][4 * g + 1], acc[mi][ni][4 * g + 2], acc[mi][ni][4 * g + 3]};
                    epi.store(row, n0 + ni * 32 + 8 * g + 4 * h, v, ctx);
                }
        }
    }
}
struct APlain { const bf16_t* A; size_t lda; DI const bf16_t* operator()(int row, int k) const { return A + (size_t)row * lda + k; } };
struct ACmp { const bf16_t* z; int col0; DI const bf16_t* operator()(int row, int k) const {
    const int bg = row >> 8, n = row & 255, b = bg >> 1, g = bg & 1; return z + (size_t)(b * S + 16 * n + (k >> 6)) * ZP + col0 + g * 64 + (k & 63); } };

DI void st_bf4(bf16_t* p, f32x4 v) { u32x2 w; w.x = pk2(v[0], v[1]); w.y = pk2(v[2], v[3]); *(u32x2*)p = w; }
struct EpiScaleH { bf16_t* O; int ldc; const float* ssqh; int rowoff;
    DI float prep(int row) const { return rstd_h(ssqh, row + rowoff); }
    DI void store(int row, int col, f32x4 v, float c) const { st_bf4(O + (size_t)row * ldc + col, v * c); } };
struct EpiScaleQ { bf16_t* O; int ldc; const float* ssqz; int kv;
    DI float prep(int row) const { return kv ? rstd_kv(ssqz, row) : rstd_q(ssqz, row); }
    DI void store(int row, int col, f32x4 v, float c) const { st_bf4(O + (size_t)row * ldc + col, v * c); } };
struct EpiGelu { bf16_t* O; int ldc; const float* bias;
    DI float prep(int) const { return 0.f; }
    DI void store(int row, int col, f32x4 v, float) const { f32x4 o; for (int i = 0; i < 4; ++i) o[i] = gelu_tanh(v[i] + bias[col + i]); st_bf4(O + (size_t)row * ldc + col, o); } };
struct EpiPlain { bf16_t* O; int ldc;
    DI float prep(int) const { return 0.f; }
    DI void store(int row, int col, f32x4 v, float) const { st_bf4(O + (size_t)row * ldc + col, v); } };
struct EpiRes { float* H; bf16_t* HB;
    DI float prep(int) const { return 0.f; }
    DI void store(int row, int col, f32x4 v, float) const { f32x4* hp = (f32x4*)(H + (size_t)row * DM + col); f32x4 o = *hp + v; *hp = o; st_bf4(HB + (size_t)row * DM + col, o); } };

struct Frame {
    Params p; unsigned char* ws; float* smem;
    int tid, lane, wave, gw, ngw;
    DI bf16_t* wl(int l, size_t off) const { return (bf16_t*)(ws + (size_t)l * WL_STRIDE + off); }
    DI bf16_t* z() const { return (bf16_t*)(ws + WS_Z); }
    DI bf16_t* q() const { return (bf16_t*)(ws + WS_Q); }
    DI bf16_t* kv() const { return (bf16_t*)(ws + WS_KV); }
    DI bf16_t* mix() const { return (bf16_t*)(ws + WS_MIX); }
    DI bf16_t* hu() const { return (bf16_t*)(ws + WS_HU); }
    DI bf16_t* gact() const { return (bf16_t*)(ws + WS_GACT); }
    DI bf16_t* hb() const { return (bf16_t*)(ws + WS_HB); }
    DI float* ssqh() const { return (float*)(ws + WS_SSQH); }
    DI float* ssqz() const { return (float*)(ws + WS_SSQZ); }
    DI bf16_t* kr() const { return (bf16_t*)(ws + WS_KR); }
    DI bf16_t* hidk() const { return (bf16_t*)(ws + WS_HIDK); }
    DI bf16_t* hidv() const { return (bf16_t*)(ws + WS_HIDV); }
    DI bf16_t* kcmp() const { return (bf16_t*)(ws + WS_KCMP); }
    DI bf16_t* vcmp() const { return (bf16_t*)(ws + WS_VCMP); }
    DI float* rope() const { return (float*)(ws + WS_ROPE); }
    DI float* b1(int l, int v) const { return (float*)(ws + WS_B1) + (l * 2 + v) * 128; }
    DI float* h() const { return p.out; }
};

DI void phase_prep(Frame& F) {
    const Params& P = F.p;
    for (int l = 0; l < 2; ++l) {
        wconv(P.in[2] + (size_t)l * 1024 * 1976, 1024, 1976, P.in[1] + l * 1024, F.wl(l, W_IN), 2048, MapZ(), F.smem);
        wconv(P.in[5] + (size_t)l * 384 * 768, 384, 768, P.in[3] + l * 384, F.wl(l, W_UQ), 768, MapUQ(), F.smem);
        wconv(P.in[6] + (size_t)l * 256 * 1024, 256, 1024, P.in[4] + l * 256, F.wl(l, W_UKV), 1024, MapUKV(), F.smem);
        wconv(P.in[9] + (size_t)l * 2048 * 128, 2048, 128, nullptr, F.wl(l, W_C1K), 256, MapId{128}, F.smem);
        wconv(P.in[11] + (size_t)l * 2048 * 128, 2048, 128, nullptr, F.wl(l, W_C1V), 256, MapId{128}, F.smem);
        wconv(P.in[10] + (size_t)l * 128 * 64, 128, 64, nullptr, F.wl(l, W_C2K), 256, MapId{64}, F.smem);
        wconv(P.in[12] + (size_t)l * 128 * 64, 128, 64, nullptr, F.wl(l, W_C2V), 256, MapId{64}, F.smem);
        wconv(P.in[13] + (size_t)l * 1024 * 1024, 1024, 1024, nullptr, F.wl(l, W_O), 1024, MapId{1024}, F.smem);
        wconv(P.in[15] + (size_t)l * 1024 * NUP, 1024, NUP, P.in[14] + l * 1024, F.wl(l, W_UP), NUP, MapUP(), F.smem);
        wconv(P.in[18] + (size_t)l * DFF * 1024, DFF, 1024, nullptr, F.wl(l, W_DN), 1024, MapId{1024}, F.smem);
    }
    if (blockIdx.x == 0) {
        const int l = F.tid >> 8, v = (F.tid >> 7) & 1, e = F.tid & 127;
        const float* pos = (v ? P.in[8] : P.in[7]) + l * 2048; const float* w1 = (v ? P.in[11] : P.in[9]) + (size_t)l * 2048 * 128;
        float s = 0.f; for (int k = 0; k < 2048; ++k) s += pos[k] * w1[(size_t)k * 128 + e];
        F.b1(l, v)[e] = s;
        if (F.tid < 64) ((unsigned*)(F.ws + WS_CTL))[F.tid] = 0u;
    }
    for (int i = blockIdx.x * NT + F.tid; i < S * 16; i += gridDim.x * NT) {
        const int t = i >> 4, j = i & 15; const float inv = 1.0f / powf(10000.0f, (float)(2 * j) / 32.0f); const float ang = (float)t * inv;
        F.rope()[i] = cosf(ang); F.rope()[S * 16 + i] = sinf(ang);
    }
    for (int row = F.gw; row < M; row += F.ngw) {
        const f32x4* xr = (const f32x4*)(P.in[0] + (size_t)row * DM) + F.lane; f32x4* hr = (f32x4*)(F.h() + (size_t)row * DM) + F.lane; float s = 0.f;
#pragma unroll
        for (int j = 0; j < 4; ++j) { f32x4 v = xr[64 * j]; hr[64 * j] = v; s += (v[0] * v[0] + v[1] * v[1]) + (v[2] * v[2] + v[3] * v[3]);
            st_bf4(F.hb() + (size_t)row * DM + 4 * (F.lane + 64 * j), v); }
        s = wave_sum(s);
        if (F.lane < 16) F.ssqh()[(size_t)row * 16 + F.lane] = F.lane == 0 ? s : 0.f;
    }
}
DI void phase_stat_h(Frame& F) {
    for (int row = F.gw; row < M; row += F.ngw) {
        const f32x4* hr = (const f32x4*)(F.h() + (size_t)row * DM) + F.lane; float s = 0.f;
#pragma unroll
        for (int j = 0; j < 4; ++j) { f32x4 v = hr[64 * j]; s += (v[0] * v[0] + v[1] * v[1]) + (v[2] * v[2] + v[3] * v[3]); }
        s = wave_sum(s);
        if (F.lane < 16) F.ssqh()[(size_t)row * 16 + F.lane] = F.lane == 0 ? s : 0.f;
    }
}
DI void phase_stat_z(Frame& F) {
    for (int row = F.gw; row < M; row += F.ngw) {
        const bf16_t* zr = F.z() + (size_t)row * ZP; float sq = 0.f, sk = 0.f;
        for (int j = 0; j < 6; ++j) { float v = bf2f(zr[Z_CQ + F.lane + 64 * j]); sq += v * v; }
        for (int j = 0; j < 4; ++j) { float v = bf2f(zr[Z_CKV + F.lane + 64 * j]); sk += v * v; }
        sq = wave_sum(sq); sk = wave_sum(sk);
        if (F.lane < 24) F.ssqz()[(size_t)row * 24 + F.lane] = F.lane == 0 ? sq : (F.lane == 16 ? sk : 0.f);
    }
}
DI void job_krope(Frame& F) {
    for (int i = blockIdx.x * NT + F.tid; i < M * 16; i += gridDim.x * NT) {
        const int row = i >> 4, j = i & 15, t = row & (S - 1);
        const float c = F.rope()[t * 16 + j], s = F.rope()[S * 16 + t * 16 + j];
        const float x1 = bf2f(F.z()[(size_t)row * ZP + Z_KR + j]), x2 = bf2f(F.z()[(size_t)row * ZP + Z_KR + 16 + j]);
        F.kr()[(size_t)row * 32 + j] = f2bf(x1 * c - x2 * s); F.kr()[(size_t)row * 32 + 16 + j] = f2bf(x2 * c + x1 * s);
    }
}

struct OS { float m, l, o; };
DI void os_init(OS& s) { s.m = -INFINITY; s.l = 0.f; s.o = 0.f; }
DI void os_chunk(OS& st, float s, bool valid, const bf16_t* vbase, size_t vstride, int lane) {
    unsigned long long bal = __ballot(valid);
    if (!bal) return;
    const float cm = wave_max(valid ? s : -INFINITY);
    const float mn = fmaxf(st.m, cm);
    const float alpha = __expf(st.m - mn);
    const float p = valid ? __expf(s - mn) : 0.f;
    st.l = st.l * alpha + wave_sum(p);
    float acc = st.o * alpha;
    while (bal) { const int kk = __ffsll((long long)bal) - 1; bal &= bal - 1; const float pk = __shfl(p, kk); acc += pk * bf2f(vbase[(size_t)kk * vstride + lane]); }
    st.o = acc; st.m = mn;
}
DI float dot_bf(const float* q, const bf16_t* k, int n) {
    float s = 0.f;
    for (int d = 0; d < n; d += 8) { bf16x8 kv = *(const bf16x8*)(k + d);
#pragma unroll
        for (int j = 0; j < 8; ++j) s += q[d + j] * bf2f((bf16_t)kv[j]); }
    return s;
}
DI void phase_attn_naive(Frame& F) {
    float* wq = F.smem + F.wave * 640;
    float* pl = wq + 128;
    const bf16_t* q = F.q(); const bf16_t* kv = F.kv(); const bf16_t* kr = F.kr(); const bf16_t* z = F.z(); bf16_t* mix = F.mix();
    const int lane = F.lane;
    for (int task = F.gw; task < M * 8; task += F.ngw) {
        const int hd = task & 7, row = task >> 3, b = row >> 12, t = row & (S - 1);
        wq[lane] = bf2f(q[(size_t)row * 768 + hd * 64 + lane]);
        if (lane < 16) { const float c = F.rope()[t * 16 + lane], s = F.rope()[S * 16 + t * 16 + lane];
            const float x1 = bf2f(q[(size_t)row * 768 + 512 + hd * 32 + lane]), x2 = bf2f(q[(size_t)row * 768 + 512 + hd * 32 + 16 + lane]);
            wq[64 + lane] = x1 * c - x2 * s; wq[80 + lane] = x2 * c + x1 * s; }
        __builtin_amdgcn_wave_barrier();
        OS st; os_init(st);
        const float scale = 0.10206207261596575f;
        for (int k0 = 0; k0 <= t; k0 += 64) {
            const int key = k0 + lane; const bool valid = key <= t; const size_t kro = (size_t)(b * S + (valid ? key : t));
            const float s = (dot_bf(wq, kv + kro * 1024 + hd * 64, 64) + dot_bf(wq + 64, kr + kro * 32, 32)) * scale;
            os_chunk(st, s, valid, kv + (size_t)(b * S + k0) * 1024 + 512 + hd * 64, 1024, lane);
        }
        mix[(size_t)row * DM + hd * 64 + lane] = f2bf(st.o / st.l);
        __builtin_amdgcn_wave_barrier();
    }
    for (int task = F.gw; task < M * 2; task += F.ngw) {
        const int g = task & 1, row = task >> 1, b = row >> 12, t = row & (S - 1), bg = b * 2 + g, cur = t >> 6;
        const int nvis = t >= 31 ? ((t - 31) >> 4) + 1 : 0;
        float* ocs = wq + 384; float imp = 0.f;
        const bf16_t* kc = F.kcmp() + (size_t)bg * 256 * 64; const bf16_t* vc = F.vcmp() + (size_t)bg * 256 * 64;
        for (int r = 0; r < 4; ++r) {
            const int hd = g * 4 + r; const float slope = exp2f(-(float)(hd + 1));
            wq[lane] = bf2f(z[(size_t)row * ZP + Z_QN + hd * 64 + lane]);
            __builtin_amdgcn_wave_barrier();
            float sc[4]; float mx = -INFINITY;
#pragma unroll
            for (int i = 0; i < 4; ++i) { const int n = lane + 64 * i; const bool valid = n < nvis;
                sc[i] = valid ? dot_bf(wq, kc + (size_t)n * 64, 64) * 0.125f - slope * (float)(t - (16 * n + 31)) : -INFINITY; mx = fmaxf(mx, sc[i]); }
            mx = wave_max(mx);
            float ps[4]; float l = 0.f;
#pragma unroll
            for (int i = 0; i < 4; ++i) { ps[i] = (lane + 64 * i) < nvis ? __expf(sc[i] - mx) : 0.f; l += ps[i]; }
            l = wave_sum(l); const float il = nvis > 0 ? 1.f / l : 0.f;
            float o = 0.f;
#pragma unroll
            for (int i = 0; i < 4; ++i) { ps[i] *= il; pl[lane + 64 * i] = ps[i];
                const int cnt = nvis - 64 * i; for (int kk = 0; kk < 64 && kk < cnt; ++kk) { const float pk = __shfl(ps[i], kk); o += pk * bf2f(vc[(size_t)(64 * i + kk) * 64 + lane]); } }
            ocs[r * 64 + lane] = o;
            __builtin_amdgcn_wave_barrier();
            { const int j = lane; float a = 0.f; for (int n = 4 * j - 1; n <= 4 * j + 3; ++n) if (n >= 0 && n < 255) a += pl[n]; imp += a; }
            __builtin_amdgcn_wave_barrier();
        }
        float v = imp; if (lane > cur) v = -INFINITY; if (lane == 0 || lane == cur || lane == cur - 1) v = INFINITY;
        int rank = 0;
        for (int j = 0; j < 64; ++j) { const float vj = __shfl(v, j); rank += (vj > v || (vj == v && j < lane)) ? 1 : 0; }
        const unsigned long long selmask = __ballot(rank < 16 && lane <= cur);
        for (int r = 0; r < 4; ++r) {
            const int hd = g * 4 + r; const float slope = exp2f(-(float)(hd + 1));
            wq[lane] = bf2f(z[(size_t)row * ZP + Z_QN + hd * 64 + lane]);
            __builtin_amdgcn_wave_barrier();
            OS ss; os_init(ss);
            unsigned long long mm = selmask;
            while (mm) { const int j = __ffsll((long long)mm) - 1; mm &= mm - 1; const int key = 64 * j + lane; const bool valid = key <= t;
                const size_t kro = (size_t)(b * S + (valid ? key : t));
                const float s = dot_bf(wq, z + kro * ZP + Z_KS + g * 64, 64) * 0.125f - slope * (float)(t - key);
                os_chunk(ss, s, valid, z + (size_t)(b * S + 64 * j) * ZP + Z_VS + g * 64, ZP, lane); }
            OS sw; os_init(sw);
            for (int c = 0; c < 9; ++c) { const int j = cur - 8 + c; if (j < 0) continue; const int key = 64 * j + lane; const bool valid = key <= t && (t - key) < 512;
                const size_t kro = (size_t)(b * S + (key <= t ? key : t));
                const float s = dot_bf(wq, z + kro * ZP + Z_KW + g * 64, 64) * 0.125f - slope * (float)(t - key);
                os_chunk(sw, s, valid, z + (size_t)(b * S + 64 * j) * ZP + Z_VW + g * 64, ZP, lane); }
            const bf16_t* gt = z + (size_t)row * ZP + Z_GT + hd * 3;
            const float g0 = 1.f / (1.f + __expf(-bf2f(gt[0]))), g1 = 1.f / (1.f + __expf(-bf2f(gt[1]))), g2 = 1.f / (1.f + __expf(-bf2f(gt[2])));
            const float o = g0 * ocs[r * 64 + lane] + g1 * (ss.o / ss.l) + g2 * (sw.o / sw.l);
            mix[(size_t)row * DM + 512 + hd * 64 + lane] = f2bf(o);
            __builtin_amdgcn_wave_barrier();
        }
    }
}

DI void phase_conv(Frame& F, int l, int b) {
    const float* cw = F.p.in[16] + (size_t)l * 3 * NUP; const float* cb = F.p.in[17] + (size_t)l * NUP;
    const bf16_t* hu = F.hu(); bf16_t* ga = F.gact() + (size_t)b * S * DFF;
    for (size_t i = (size_t)blockIdx.x * NT + F.tid; i < (size_t)S * DFF; i += (size_t)gridDim.x * NT) {
        const int t = (int)(i / DFF), c = (int)(i % DFF), pn = c >> 7, j = c & 127, colg = pn * 256 + j, colu = colg + 128, cu = DFF + c;
        float hg = cb[c], hup = cb[cu];
#pragma unroll
        for (int k = 0; k < 3; ++k) { const int tt = t - 2 + k; if (tt >= 0) { hg += cw[k * NUP + c] * bf2f(hu[(size_t)tt * NUP + colg]); hup += cw[k * NUP + cu] * bf2f(hu[(size_t)tt * NUP + colu]); } }
        ga[(size_t)t * DFF + c] = f2bf(hg / (1.f + __expf(-hg)) * hup);
    }
}
DI void phase_final(Frame& F) {
    const float* fn = F.p.in[19];
    for (int row = F.gw; row < M; row += F.ngw) {
        const float rs = rstd_h(F.ssqh(), row); f32x4* hr = (f32x4*)(F.h() + (size_t)row * DM) + F.lane; const f32x4* gn = (const f32x4*)fn + F.lane;
#pragma unroll
        for (int j = 0; j < 4; ++j) hr[64 * j] = hr[64 * j] * rs * gn[64 * j];
    }
}

constexpr int NPH = 36;
DI void run_phase(Frame& F, int ph) {
    if (ph == 0) { phase_prep(F); return; }
    if (ph == 35) { phase_final(F); return; }
    const int l = (ph - 1) / 17, s = (ph - 1) % 17;
    if (s == 0) { ngemm(APlain{F.hb(), DM}, F.wl(l, W_IN), 1024, M, ZP, 1024, EpiScaleH{F.z(), ZP, F.ssqh(), 0}); return; }
    if (s == 1) { phase_stat_z(F); return; }
    if (s == 2) {
        ngemm(APlain{F.z() + Z_CQ, ZP}, F.wl(l, W_UQ), 384, M, 768, 384, EpiScaleQ{F.q(), 768, F.ssqz(), 0});
        ngemm(APlain{F.z() + Z_CKV, ZP}, F.wl(l, W_UKV), 256, M, 1024, 256, EpiScaleQ{F.kv(), 1024, F.ssqz(), 1});
        job_krope(F);
        ngemm(ACmp{F.z(), Z_KC}, F.wl(l, W_C1K), 2048, 2048, 128, 2048, EpiGelu{F.hidk(), 256, F.b1(l, 0)});
        ngemm(ACmp{F.z(), Z_VC}, F.wl(l, W_C1V), 2048, 2048, 128, 2048, EpiGelu{F.hidv(), 256, F.b1(l, 1)});
        return;
    }
    if (s == 3) {
        ngemm(APlain{F.hidk(), 256}, F.wl(l, W_C2K), 128, 2048, 64, 128, EpiPlain{F.kcmp(), 64});
        ngemm(APlain{F.hidv(), 256}, F.wl(l, W_C2V), 128, 2048, 64, 128, EpiPlain{F.vcmp(), 64});
        return;
    }
    if (s == 4) { phase_attn_naive(F); return; }
    if (s == 5) { ngemm(APlain{F.mix(), DM}, F.wl(l, W_O), 1024, M, DM, 1024, EpiRes{F.h(), F.hb()}); return; }
    if (s == 6 || s == 16) { phase_stat_h(F); return; }
    if (s >= 7 && s <= 14) {
        const int b = (s - 7) >> 1;
        if (((s - 7) & 1) == 0) ngemm(APlain{F.hb() + (size_t)b * S * DM, DM}, F.wl(l, W_UP), 1024, S, NUP, 1024, EpiScaleH{F.hu(), NUP, F.ssqh(), b * S});
        else phase_conv(F, l, b);
        return;
    }
    if (s == 15) { ngemm(APlain{F.gact(), DFF}, F.wl(l, W_DN), DFF, M, DM, DFF, EpiRes{F.h(), F.hb()}); return; }
}

__global__ void __launch_bounds__(NT, 2) mk(Params p) {
    __shared__ __attribute__((aligned(16))) float smem[8192];
    cg::grid_group grid = cg::this_grid();
    Frame F; F.p = p; F.ws = p.ws; F.smem = smem; F.tid = threadIdx.x; F.lane = F.tid & 63; F.wave = F.tid >> 6;
    F.gw = blockIdx.x * 8 + F.wave; F.ngw = gridDim.x * 8;
    for (int ph = p.ph_lo; ph < p.ph_hi; ++ph) {
        asm volatile("" : "+s"(F.ws), "+s"(F.p.out));
#pragma unroll
        for (int i = 0; i < 20; ++i) asm volatile("" : "+s"(F.p.in[i]));
        asm volatile("" : "+v"(F.tid), "+v"(F.lane), "+v"(F.gw));
        run_phase(F, ph);
        if (ph + 1 < p.ph_hi) grid.sync();
    }
}

extern "C" void kernel_launch(void* const* d_in, const int* in_sizes, int n_in, void* d_out, int out_size, void* d_ws, size_t ws_size, hipStream_t stream) {
    if (n_in != 20 || ws_size < WS_ENDALL) { fprintf(stderr, "kernel_launch: unexpected n_in %d / ws %zu\n", n_in, ws_size); return; }
    static int grid_blocks = 0;
    if (!grid_blocks) {
        int dev = 0, cus = 0, per_cu = 0;
        hipGetDevice(&dev);
        hipDeviceGetAttribute(&cus, hipDeviceAttributeMultiprocessorCount, dev);
        hipOccupancyMaxActiveBlocksPerMultiprocessor(&per_cu, mk, NT, 0);
        if (per_cu < 1) per_cu = 1;
        if (per_cu > 1) per_cu = 1;
        grid_blocks = cus * per_cu;
    }
    Params p{};
    for (int i = 0; i < 20; ++i) p.in[i] = (const float*)d_in[i];
    p.out = (float*)d_out; p.ws = (unsigned char*)d_ws;
    for (int ph = 0; ph < NPH; ++ph) {
        p.ph_lo = ph; p.ph_hi = ph + 1;
        void* args[] = {&p};
        hipError_t e = hipLaunchCooperativeKernel((void*)mk, dim3(grid_blocks), dim3(NT), args, 0, stream);
        if (e != hipSuccess) { fprintf(stderr, "cooperative launch failed: %s (grid %d)\n", hipGetErrorString(e), grid_blocks); break; }
    }
}
```

```cpp
#include <hip/hip_runtime.h>
#include <hip/hip_cooperative_groups.h>
#include <stdint.h>
#include <cstdio>
namespace cg = cooperative_groups;

#define DI __device__ __forceinline__
typedef unsigned short bf16_t;
typedef short bf16x8 __attribute__((ext_vector_type(8)));
typedef float f32x4 __attribute__((ext_vector_type(4)));
typedef float f32x16 __attribute__((ext_vector_type(16)));
typedef unsigned u32x2 __attribute__((ext_vector_type(2)));
typedef unsigned u32x4 __attribute__((ext_vector_type(4)));
#define MFMA32(a, b, c) __builtin_amdgcn_mfma_f32_32x32x16_bf16((a), (b), (c), 0, 0, 0)

constexpr int NB = 4, S = 4096, M = NB * S, DM = 1024, ZP = 2048, NT = 512;
constexpr int DFF = 2816, NUP = 2 * DFF;
constexpr float EPS = 1e-6f;
constexpr int LDS_BYTES = 147456, LDS_ST = LDS_BYTES - 64;
constexpr int Z_CQ = 0, Z_KR = 384, Z_GT = 416, Z_CKV = 512, Z_QN = 768, Z_KC = 1280, Z_KS = 1408, Z_KW = 1536, Z_VC = 1664, Z_VS = 1792, Z_VW = 1920;
constexpr size_t MiB = 1024 * 1024;
constexpr size_t W_IN = 0, W_UQ = W_IN + (size_t)2048 * 1024 * 2, W_UKV = W_UQ + (size_t)768 * 384 * 2, W_C1K = W_UKV + (size_t)1024 * 256 * 2,
                 W_C1V = W_C1K + (size_t)256 * 2048 * 2, W_C2K = W_C1V + (size_t)256 * 2048 * 2, W_C2V = W_C2K + (size_t)256 * 128 * 2,
                 W_O = W_C2V + (size_t)256 * 128 * 2, W_UP = W_O + (size_t)1024 * 1024 * 2, W_DN = W_UP + (size_t)NUP * 1024 * 2,
                 W_END = W_DN + (size_t)1024 * DFF * 2;
constexpr size_t WL_STRIDE = 26 * MiB;
static_assert(W_END <= WL_STRIDE, "weights per layer");
constexpr size_t WS_A = 52 * MiB;
constexpr size_t WS_Z = WS_A, WS_Q = WS_A + 64 * MiB + 256 * 1024, WS_GACT = WS_A;
constexpr size_t WS_KV = 141 * MiB, WS_MIX = 173 * MiB, WS_HU = WS_KV;
constexpr size_t WS_HB = 205 * MiB + 64 * 1024;
constexpr size_t WS_MISC = 238 * MiB;
constexpr size_t WS_SSQH = WS_MISC, WS_SSQZ = WS_SSQH + 1 * MiB, WS_KR = WS_SSQZ + 2 * MiB, WS_HIDK = WS_KR + 1 * MiB, WS_HIDV = WS_HIDK + 1 * MiB,
                 WS_KCMP = WS_HIDV + 1 * MiB, WS_VCMP = WS_KCMP + 1 * MiB, WS_ROPE = WS_VCMP + 1 * MiB, WS_B1 = WS_ROPE + 1 * MiB, WS_CTL = WS_B1 + 64 * 1024,
                 WS_ENDALL = WS_CTL + 64 * 1024;
static_assert(WS_ENDALL <= 256 * MiB, "workspace");

struct Params {
    const float* in[20];
    float* out;
    unsigned char* ws;
    int ph_lo, ph_hi;
};

DI bf16_t f2bf(float x) { unsigned u = __float_as_uint(x); u += 0x7fffu + ((u >> 16) & 1u); return (bf16_t)(u >> 16); }
DI int tid_now() { int t = threadIdx.x; asm volatile("" : "+v"(t)); return t; }
DI float bf2f(bf16_t b) { return __uint_as_float(((unsigned)b) << 16); }
DI unsigned pk2(float lo, float hi) { return (unsigned)f2bf(lo) | ((unsigned)f2bf(hi) << 16); }
DI float wave_sum(float v) {
#pragma unroll
    for (int o = 1; o < 64; o <<= 1) v += __shfl_xor(v, o);
    return v;
}
DI float wave_max(float v) {
#pragma unroll
    for (int o = 1; o < 64; o <<= 1) v = fmaxf(v, __shfl_xor(v, o));
    return v;
}
DI float gelu_tanh(float x) { return 0.5f * x * (1.f + tanhf(0.7978845608028654f * (x + 0.044715f * x * x * x))); }
DI float rstd_h(const float* ssqh, int row) {
    const f32x4* p = (const f32x4*)(ssqh + (size_t)row * 16); float s = 0.f;
#pragma unroll
    for (int i = 0; i < 4; ++i) { f32x4 v = p[i]; s += (v[0] + v[1]) + (v[2] + v[3]); }
    return rsqrtf(s * (1.f / 1024.f) + EPS);
}
DI float rstd_q(const float* ssqz, int row) {
    const f32x4* p = (const f32x4*)(ssqz + (size_t)row * 24); float s = 0.f;
#pragma unroll
    for (int i = 0; i < 3; ++i) { f32x4 v = p[i]; s += (v[0] + v[1]) + (v[2] + v[3]); }
    return rsqrtf(s * (1.f / 384.f) + EPS);
}
DI float rstd_kv(const float* ssqz, int row) {
    const f32x4* p = (const f32x4*)(ssqz + (size_t)row * 24 + 16); float s = 0.f;
#pragma unroll
    for (int i = 0; i < 2; ++i) { f32x4 v = p[i]; s += (v[0] + v[1]) + (v[2] + v[3]); }
    return rsqrtf(s * (1.f / 256.f) + EPS);
}

namespace pg8 {
#define PG8_LAS __attribute__((address_space(3)))
typedef unsigned short bf16_t;
typedef short bf16x8 __attribute__((ext_vector_type(8)));
typedef float f32x4 __attribute__((ext_vector_type(4)));
typedef unsigned u32x4 __attribute__((ext_vector_type(4)));
constexpr int BM = 256, BK = 64, HALF = 128, HTB = HALF * BK * 2  , STAGE_BYTES = 8 * HTB, NXCD = 8, WGM = 8;

__host__ __device__ __forceinline__ int lds_byte(int r, int c) { const int st = (r >> 4) * 2 + (c >> 5), rr = r & 15, cc = c & 31, ob = rr * 64 + cc * 2; return st * 1024 + (ob ^ (((ob >> 9) & 1) << 5)); }
__host__ __device__ __forceinline__ void stage_rc(int b, int& R, int& C) { const int st = b / 1024, sb = b % 1024, swz = sb ^ (((sb >> 9) & 1) << 5); R = (st >> 1) * 16 + swz / 64; C = (st & 1) * 32 + (swz % 64) / 2; }
__host__ __device__ __forceinline__ int perm32(int rho) { const int n = rho >> 4, i = rho & 15; return 8 * (i >> 2) + 4 * n + (i & 3); }

struct Unit { int pm, pn; };
struct Gemm { const bf16_t* A; const bf16_t* Bt; int M, N, K; int lda; int kstepA; int cmp; };
__device__ __forceinline__ long long tileA_off(const Gemm& g, int pm) {
    if (g.cmp == 1) return (long long)(pm >> 1) * ((long long)4096 * 2048 * 2) + (long long)(pm & 1) * 128;
    if (g.cmp == 2) return ((long long)(pm / 17) * 4096 + 254 * (pm % 17) - 2) * (long long)(g.lda * 2);
    return (long long)pm * ((long long)BM * g.lda * 2); }

struct StaticOrder {
    int nM, nN, nwg, G, c;
    __host__ __device__ void init(int M, int N, int G_, int c_) { nM = M / BM; nN = N / BM; nwg = nM * nN; G = G_; c = c_; }
    __host__ __device__ bool next(int i, Unit& u) const {
        const long L = (long)i * G + c; if (L >= nwg) return false;
        int wgid = (int)L; { const int q = nwg / NXCD, r = nwg % NXCD, xcd = wgid % NXCD, off = wgid / NXCD; wgid = (xcd < r ? xcd * (q + 1) : r * (q + 1) + (xcd - r) * q) + off; }
        const int nig = WGM * nN, gid = wgid / nig, fm = gid * WGM, gsz = (nM - fm) < WGM ? (nM - fm) : WGM;
        u.pm = fm + ((wgid % nig) % gsz); u.pn = (wgid % nig) / gsz; return true;
    }
    __device__ __forceinline__ void a_ready(const Unit&) const {}
    __device__ __forceinline__ void done(const Unit&) const {}
};
__device__ __forceinline__ unsigned cvt_pk_bf16(float lo, float hi) { unsigned r; asm volatile("v_cvt_pk_bf16_f32 %0, %1, %2" : "=v"(r) : "v"(lo), "v"(hi)); return r; }
template <class Epi, class Sched, bool ALIGN_EPI = false, bool SP2 = false>
__device__ __forceinline__ void gemm_phase(PG8_LAS unsigned char* lds, const Gemm g, const Sched& S, const Epi& E) {
    int tid_ = threadIdx.x; asm volatile("" : "+v"(tid_));
    const int tid = tid_, wid = __builtin_amdgcn_readfirstlane(tid >> 6), lane = tid & 63, wr = wid >> 2, wc = wid & 3, fr = lane & 15, fq = lane >> 4;
    const int K = g.K, nt = K / BK;
    unsigned voffA[2], voffB[2];
#pragma unroll
    for (int i = 0; i < 2; ++i) { int R, C; stage_rc(tid * 16 + i * 8192, R, C); const int Rb = Epi::PERM ? ((R & ~31) + perm32(R & 31)) : R;
        voffA[i] = (unsigned)(R * g.lda + C) * 2u; voffB[i] = (unsigned)(Rb * K + C) * 2u; }
    const size_t kstepB = (size_t)(BK * 2), kstepA = (size_t)g.kstepA;
    const size_t hstepB = (size_t)HALF * K * 2, hstepA = (size_t)HALF * g.lda * 2;
    const size_t tstepB = 2 * hstepB;
    const unsigned ldsw = (unsigned)wid * 1024u;
    const int aoff = lds_byte(wr * 64 + fr, fq * 8), boff = lds_byte(wc * 32 + fr, fq * 8);
#define PG8_SA(b, h) (((b) * 2 + (h)) * HTB)
#define PG8_SB(b, h) ((4 + (b) * 2 + (h)) * HTB)
#define PG8_STAGE(bufoff, gbase, voff) do { _Pragma("unroll") for (int _i = 0; _i < 2; ++_i) \
        __builtin_amdgcn_global_load_lds((const unsigned*)((const char*)(gbase) + (voff)[_i]), (PG8_LAS unsigned*)(lds + (bufoff) + ldsw + _i * 8192), 16, 0, 0); } while (0)
#define PG8_LDA(dst, b, h) do { _Pragma("unroll") for (int m = 0; m < 4; ++m) _Pragma("unroll") for (int k = 0; k < 2; ++k) dst[m][k] = *(const PG8_LAS bf16x8*)(lds + PG8_SA(b, h) + aoff + m * 2048 + k * 1024); } while (0)
#define PG8_LDB(dst, b, h) do { _Pragma("unroll") for (int n = 0; n < 2; ++n) _Pragma("unroll") for (int k = 0; k < 2; ++k) dst[n][k] = *(const PG8_LAS bf16x8*)(lds + PG8_SB(b, h) + boff + n * 2048 + k * 1024); } while (0)
#define PG8_MMA(ai, bj, At, Bt) do { __builtin_amdgcn_s_setprio(1); _Pragma("unroll") for (int m = 0; m < 4; ++m) _Pragma("unroll") for (int n = 0; n < 2; ++n) _Pragma("unroll") for (int k = 0; k < 2; ++k) \
        acc[ai][bj][m][n] = __builtin_amdgcn_mfma_f32_16x16x32_bf16(Bt[n][k], At[m][k], acc[ai][bj][m][n], 0, 0, 0); __builtin_amdgcn_s_setprio(0); } while (0)
#define PG8_WAIT_V(n) asm volatile("s_waitcnt vmcnt(" #n ")" ::: "memory")
#define PG8_WAIT_L(n) asm volatile("s_waitcnt lgkmcnt(" #n ")" ::: "memory")
#define PG8_BAR __builtin_amdgcn_s_barrier()
#define PG8_SCHED __builtin_amdgcn_sched_barrier(0)
    Unit cur, nxt; int ui = 0;
    if (!S.next(0, cur)) return;
    f32x4 acc[2][2][4][2];
#pragma unroll
    for (int a = 0; a < 2; ++a)
#pragma unroll
        for (int b = 0; b < 2; ++b)
#pragma unroll
            for (int m = 0; m < 4; ++m)
#pragma unroll
                for (int n = 0; n < 2; ++n) acc[a][b][m][n] = (f32x4){0.f, 0.f, 0.f, 0.f};
    bf16x8 At[4][2], B0[2][2], B1[2][2];
    const char* cA = (const char*)g.A + tileA_off(g, cur.pm); const char* cB = (const char*)g.Bt + (size_t)cur.pn * tstepB;
    S.a_ready(cur);
    if constexpr (SP2) {
        PG8_STAGE(PG8_SB(0, 0), cB, voffB); PG8_STAGE(PG8_SB(0, 1), cB + hstepB, voffB); PG8_STAGE(PG8_SA(0, 0), cA, voffA); PG8_STAGE(PG8_SA(0, 1), cA + hstepA, voffA);
        if (wr == 1) PG8_BAR;
        PG8_WAIT_V(2); PG8_BAR;
        PG8_STAGE(PG8_SB(1, 0), cB + kstepB, voffB); PG8_STAGE(PG8_SA(1, 0), cA + kstepA, voffA); PG8_STAGE(PG8_SB(1, 1), cB + hstepB + kstepB, voffB);
        PG8_WAIT_V(6); PG8_BAR;
    } else {
        PG8_STAGE(PG8_SB(0, 0), cB, voffB); PG8_STAGE(PG8_SA(0, 0), cA, voffA); PG8_STAGE(PG8_SB(0, 1), cB + hstepB, voffB); PG8_STAGE(PG8_SA(0, 1), cA + hstepA, voffA);
        if (wr == 1) PG8_BAR;
        PG8_WAIT_V(4); PG8_BAR;
        PG8_STAGE(PG8_SB(1, 0), cB + kstepB, voffB); PG8_STAGE(PG8_SA(1, 0), cA + kstepA, voffA); PG8_STAGE(PG8_SB(1, 1), cB + hstepB + kstepB, voffB);
        PG8_WAIT_V(6); PG8_BAR;
    }
    for (;;) {
        const bool has_next = S.next(ui + 1, nxt);
        const char* nA = has_next ? (const char*)g.A + tileA_off(g, nxt.pm) : cA; const char* nB = has_next ? (const char*)g.Bt + (size_t)nxt.pn * tstepB : cB;
        for (int t = 0; t < nt; t += 2) {
            const bool last = (t == nt - 2);
            const char* a1 = cA + (size_t)(t + 1) * kstepA;
            const char* a2 = last ? nA : cA + (size_t)(t + 2) * kstepA; const char* b2 = last ? nB : cB + (size_t)(t + 2) * kstepB;
            const char* a3 = a2 + kstepA; const char* b3 = b2 + kstepB;
            if (last && has_next) S.a_ready(nxt);
            if constexpr (SP2) {
            PG8_LDB(B0, 0, 0); PG8_LDB(B1, 0, 1); PG8_SCHED; PG8_LDA(At, 0, 0); PG8_STAGE(PG8_SA(1, 1), a1 + hstepA, voffA);
            PG8_WAIT_V(8); PG8_WAIT_L(0); PG8_BAR; PG8_MMA(0, 0, At, B0); PG8_MMA(0, 1, At, B1); PG8_BAR; PG8_SCHED;
            PG8_LDA(At, 0, 1); PG8_STAGE(PG8_SB(0, 0), b2, voffB); PG8_STAGE(PG8_SB(0, 1), b2 + hstepB, voffB); PG8_STAGE(PG8_SA(0, 0), a2, voffA);
            PG8_WAIT_V(8); PG8_WAIT_L(0); PG8_BAR; PG8_MMA(1, 0, At, B0); PG8_MMA(1, 1, At, B1); PG8_BAR; PG8_SCHED;
            PG8_LDB(B0, 1, 0); PG8_LDB(B1, 1, 1); PG8_SCHED; PG8_LDA(At, 1, 0); PG8_STAGE(PG8_SA(0, 1), a2 + hstepA, voffA);
            PG8_WAIT_V(8); PG8_WAIT_L(0); PG8_BAR; PG8_MMA(0, 0, At, B0); PG8_MMA(0, 1, At, B1); PG8_BAR; PG8_SCHED;
            PG8_LDA(At, 1, 1); PG8_STAGE(PG8_SB(1, 0), b3, voffB); PG8_STAGE(PG8_SB(1, 1), b3 + hstepB, voffB); PG8_STAGE(PG8_SA(1, 0), a3, voffA);
            PG8_WAIT_V(8); PG8_WAIT_L(0); PG8_BAR; PG8_MMA(1, 0, At, B0); PG8_MMA(1, 1, At, B1); PG8_BAR; PG8_SCHED;
            } else {
            PG8_LDB(B0, 0, 0); PG8_SCHED; PG8_LDA(At, 0, 0); PG8_STAGE(PG8_SA(1, 1), a1 + hstepA, voffA);
            PG8_WAIT_L(8); PG8_BAR; PG8_WAIT_L(0); PG8_MMA(0, 0, At, B0); PG8_BAR; PG8_SCHED;
            PG8_LDB(B1, 0, 1); PG8_STAGE(PG8_SB(0, 0), b2, voffB);
            PG8_BAR; PG8_WAIT_L(0); PG8_MMA(0, 1, At, B1); PG8_BAR;
            PG8_LDA(At, 0, 1); PG8_STAGE(PG8_SA(0, 0), a2, voffA);
            PG8_BAR; PG8_WAIT_L(0); PG8_MMA(1, 0, At, B0); PG8_BAR; PG8_SCHED;
            PG8_STAGE(PG8_SB(0, 1), b2 + hstepB, voffB);
            PG8_WAIT_V(6); PG8_BAR; PG8_MMA(1, 1, At, B1); PG8_BAR;
            PG8_LDB(B0, 1, 0); PG8_SCHED; PG8_LDA(At, 1, 0); PG8_STAGE(PG8_SA(0, 1), a2 + hstepA, voffA);
            PG8_WAIT_L(8); PG8_BAR; PG8_WAIT_L(0); PG8_MMA(0, 0, At, B0); PG8_BAR; PG8_SCHED;
            PG8_LDB(B1, 1, 1); PG8_STAGE(PG8_SB(1, 0), b3, voffB);
            PG8_BAR; PG8_WAIT_L(0); PG8_MMA(0, 1, At, B1); PG8_BAR;
            PG8_LDA(At, 1, 1); PG8_STAGE(PG8_SA(1, 0), a3, voffA);
            PG8_BAR; PG8_WAIT_L(0); PG8_MMA(1, 0, At, B0); PG8_BAR; PG8_SCHED;
            PG8_STAGE(PG8_SB(1, 1), b3 + hstepB, voffB);
            PG8_WAIT_V(6); PG8_BAR; PG8_MMA(1, 1, At, B1); PG8_BAR;
            }
        }
        if constexpr (ALIGN_EPI) { if (wr == 0) PG8_BAR; }
        if constexpr (!Epi::AFTER_DRAIN) { E(acc, cur, wr, wc, fr, fq); S.done(cur); }
        if (!has_next) break;
#pragma unroll
        for (int a = 0; a < 2; ++a)
#pragma unroll
            for (int b = 0; b < 2; ++b)
#pragma unroll
                for (int m = 0; m < 4; ++m)
#pragma unroll
                    for (int n = 0; n < 2; ++n) acc[a][b][m][n] = (f32x4){0.f, 0.f, 0.f, 0.f};
        cur = nxt; cA = nA; cB = nB; ++ui;
        if constexpr (ALIGN_EPI) { if (wr == 1) PG8_BAR; }
    }
    PG8_WAIT_V(0);
    if constexpr (!ALIGN_EPI) { if (wr == 0) PG8_BAR; }
    PG8_BAR;
    if constexpr (Epi::AFTER_DRAIN) { E.fused(acc, cur, wr, wc, fr, fq, lds, wid, lane); S.done(cur); }
#undef PG8_SA
#undef PG8_SB
#undef PG8_STAGE
#undef PG8_LDA
#undef PG8_LDB
#undef PG8_MMA
#undef PG8_WAIT_V
#undef PG8_WAIT_L
#undef PG8_BAR
#undef PG8_SCHED
}
}

namespace pg8 {
enum { EM_SCALEH = 0, EM_SCALEQ = 1, EM_SCALEKV = 2, EM_GELU = 3, EM_PLAIN = 4, EM_RES = 5 };
template <int MODE, int STATS  > struct EpiG {
    static constexpr bool PERM = true, AFTER_DRAIN = false;
    bf16_t* O; int ldc; int nvalid; const float* ssq_in; int rowoff; const float* bias; float* H; float* ssq_out; const float* Hin;
    __device__ __forceinline__ void operator()(const f32x4 (&acc)[2][2][4][2], const Unit& u, int wr, int wc, int fr, int fq) const {
        const int row0 = u.pm * BM + wr * 64 + fr, col0 = u.pn * BM + wc * 32 + 8 * fq;
#pragma unroll
        for (int ai = 0; ai < 2; ++ai)
#pragma unroll
            for (int m = 0; m < 4; ++m) {
                const int row = row0 + ai * HALF + m * 16;
                float sc = 1.f;
                if (MODE == EM_SCALEH) sc = ::rstd_h(ssq_in, row + rowoff);
                if (MODE == EM_SCALEQ) sc = ::rstd_q(ssq_in, row);
                if (MODE == EM_SCALEKV) sc = ::rstd_kv(ssq_in, row);
                float ss[2] = {0.f, 0.f};
#pragma unroll
                for (int bj = 0; bj < 2; ++bj) {
                    const int col = col0 + bj * HALF;
                    f32x4 v0 = acc[ai][bj][m][0] * sc, v1 = acc[ai][bj][m][1] * sc;
                    if (MODE == EM_GELU) { if (col < nvalid) { const f32x4 b0 = *(const f32x4*)(bias + col), b1 = *(const f32x4*)(bias + col + 4);
#pragma unroll
                        for (int i = 0; i < 4; ++i) { v0[i] = ::gelu_tanh(v0[i] + b0[i]); v1[i] = ::gelu_tanh(v1[i] + b1[i]); } } }
                    if (MODE == EM_RES) { const f32x4* hi = (const f32x4*)(Hin + (size_t)row * 1024 + col); f32x4* hp = (f32x4*)(H + (size_t)row * 1024 + col); v0 += hi[0]; v1 += hi[1]; hp[0] = v0; hp[1] = v1; }
                    if (STATS) ss[bj] = ((v0[0] * v0[0] + v0[1] * v0[1]) + (v0[2] * v0[2] + v0[3] * v0[3])) + ((v1[0] * v1[0] + v1[1] * v1[1]) + (v1[2] * v1[2] + v1[3] * v1[3]));
                    if (col < nvalid) { u32x4 w; w.x = cvt_pk_bf16(v0[0], v0[1]); w.y = cvt_pk_bf16(v0[2], v0[3]); w.z = cvt_pk_bf16(v1[0], v1[1]); w.w = cvt_pk_bf16(v1[2], v1[3]);
                        *(u32x4*)(O + (size_t)row * ldc + col) = w; }
                }
                if (STATS == 1) { float t = ss[0] + ss[1]; t += __shfl_xor(t, 16); t += __shfl_xor(t, 32); if (fq == 0) ssq_out[(size_t)row * 16 + u.pn * 4 + wc] = t; }
                if (STATS == 2) { if (u.pn <= 2) { float t0 = ss[0], t1 = ss[1]; t0 += __shfl_xor(t0, 16); t0 += __shfl_xor(t0, 32); t1 += __shfl_xor(t1, 16); t1 += __shfl_xor(t1, 32);
                    if (fq == 0) { ssq_out[(size_t)row * 24 + u.pn * 8 + wc] = t0; ssq_out[(size_t)row * 24 + u.pn * 8 + 4 + wc] = t1; } } }
            }
    }
};

typedef unsigned u32x2_t __attribute__((ext_vector_type(2)));
template <int CTRL> __device__ __forceinline__ float dppf(float v) { return __int_as_float(__builtin_amdgcn_update_dpp(0, __float_as_int(v), CTRL, 0xf, 0xf, true)); }
#define DPPF(v, ctrl) dppf<ctrl>(v)
template <int STRIDE> struct EpiConv {
    static constexpr bool PERM = true, AFTER_DRAIN = false;
    bf16_t* Gt; const float* ssqh; const float* cw; const float* cb; PG8_LAS float* xch;
    __device__ __forceinline__ void operator()(f32x4 (&acc)[2][2][4][2], const Unit& u, int wr, int wc, int fr_in, int fq_in) const {
        int fr = fr_in, fq = fq_in; asm volatile("" : "+v"(fr), "+v"(fq));
        const int b = STRIDE == 254 ? u.pm / 17 : u.pm / 16, tl0 = STRIDE == 254 ? 254 * (u.pm % 17) - 2 : 256 * (u.pm % 16), wid = wr * 4 + wc;
#pragma unroll
        for (int ai = 0; ai < 2; ++ai)
#pragma unroll
            for (int m = 0; m < 4; ++m) {
                const int tl = tl0 + ai * HALF + wr * 64 + m * 16 + fr; float sc = 0.f;
                if (tl >= 0 && tl < 4096) sc = ::rstd_h(ssqh, b * 4096 + tl);
#pragma unroll
                for (int bj = 0; bj < 2; ++bj)
#pragma unroll
                    for (int n = 0; n < 2; ++n) acc[ai][bj][m][n] *= sc;
            }
        if (fr >= 14) {
#pragma unroll
            for (int ai = 0; ai < 2; ++ai)
#pragma unroll
                for (int bj = 0; bj < 2; ++bj)
#pragma unroll
                    for (int n = 0; n < 2; ++n) *(PG8_LAS f32x4*)(xch + ((((wid * 2 + ai) * 4 + fq) * 2 + (fr - 14)) * 4 + bj * 2 + n) * 4) = acc[ai][bj][3][n];
        }
        asm volatile("s_waitcnt lgkmcnt(0)" ::: "memory"); __builtin_amdgcn_s_barrier(); asm volatile("" ::: "memory");
        const int chl = u.pn * 128 + wc * 32 + 8 * fq;
#pragma unroll
        for (int n = 0; n < 2; ++n) {
            const int ch = chl + 4 * n;
            const float* cwv = cw + ch; const float* cbv = cb + ch; asm volatile("" : "+v"(cwv), "+v"(cbv));
            const f32x4 wg0 = *(const f32x4*)(cwv), wg1 = *(const f32x4*)(cwv + 5632), wg2 = *(const f32x4*)(cwv + 2 * 5632), bg = *(const f32x4*)(cbv);
            const f32x4 wu0 = *(const f32x4*)(cwv + 2816), wu1 = *(const f32x4*)(cwv + 5632 + 2816), wu2 = *(const f32x4*)(cwv + 2 * 5632 + 2816), bu = *(const f32x4*)(cbv + 2816);
#pragma unroll
            for (int ai = 0; ai < 2; ++ai)
#pragma unroll
                for (int m = 0; m < 4; ++m) {
                    f32x4 pg = {0.f, 0.f, 0.f, 0.f}, pu = {0.f, 0.f, 0.f, 0.f};
                    if (m > 0) { pg = acc[ai][0][m - 1][n]; pu = acc[ai][1][m - 1][n]; }
                    else if (wr == 1 || ai == 1) {
                        const int sw = (wr == 1 ? 0 : 4) + wc, sai = wr == 1 ? ai : 0;
                        if (fr >= 14) { const PG8_LAS float* xp = xch + ((((sw * 2 + sai) * 4 + fq) * 2 + (fr - 14)) * 4 + n) * 4; pg = *(const PG8_LAS f32x4*)xp; pu = *(const PG8_LAS f32x4*)(xp + 8); }
                    }
                    const f32x4 cg = acc[ai][0][m][n], cu = acc[ai][1][m][n];
                    f32x4 o;
#pragma unroll
                    for (int k = 0; k < 4; ++k) {
                        float hg = fmaf(wg2[k], cg[k], bg[k]), hu = fmaf(wu2[k], cu[k], bu[k]);
                        {
                            const float cgk = cg[k], pgk = pg[k], cuk = cu[k], puk = pu[k], g1w = wg1[k], g0w = wg0[k], u1w = wu1[k], u0w = wu0[k];
                            asm volatile("s_nop 1\n\t"
                                         "v_fmac_f32_dpp %0, %2, %4 row_shr:1 row_mask:0xf bank_mask:0xf bound_ctrl:1\n\t"
                                         "v_fmac_f32_dpp %1, %6, %8 row_shr:1 row_mask:0xf bank_mask:0xf bound_ctrl:1\n\t"
                                         "v_fmac_f32_dpp %0, %3, %4 row_shl:15 row_mask:0xf bank_mask:0xf bound_ctrl:1\n\t"
                                         "v_fmac_f32_dpp %1, %7, %8 row_shl:15 row_mask:0xf bank_mask:0xf bound_ctrl:1\n\t"
                                         "v_fmac_f32_dpp %0, %2, %5 row_shr:2 row_mask:0xf bank_mask:0xf bound_ctrl:1\n\t"
                                         "v_fmac_f32_dpp %1, %6, %9 row_shr:2 row_mask:0xf bank_mask:0xf bound_ctrl:1\n\t"
                                         "v_fmac_f32_dpp %0, %3, %5 row_shl:14 row_mask:0xf bank_mask:0xf bound_ctrl:1\n\t"
                                         "v_fmac_f32_dpp %1, %7, %9 row_shl:14 row_mask:0xf bank_mask:0xf bound_ctrl:1"
                                         : "+v"(hg), "+v"(hu) : "v"(cgk), "v"(pgk), "v"(g1w), "v"(g0w), "v"(cuk), "v"(puk), "v"(u1w), "v"(u0w));
                        }
                        o[k] = hg * __builtin_amdgcn_rcpf(1.f + __builtin_amdgcn_exp2f(-1.4426950408889634f * hg)) * hu;
                    }
                    const int lr = ai * HALF + wr * 64 + m * 16 + fr, tl = tl0 + lr;
                    if (lr >= (STRIDE == 254 ? 2 : 0) && tl < 4096) { u32x2_t w; w.x = cvt_pk_bf16(o[0], o[1]); w.y = cvt_pk_bf16(o[2], o[3]); *(u32x2_t*)(Gt + (size_t)(b * 4096 + tl) * 2816 + ch) = w; }
                }
        }
    }
};

struct EpiFinal {
    static constexpr bool PERM = true, AFTER_DRAIN = false;
    const float* Hin; float* Out; const float* gain; float* part; unsigned* cnt; PG8_LAS unsigned* flag;
    __device__ __forceinline__ void operator()(f32x4 (&acc)[2][2][4][2], const Unit& u, int wr, int wc, int fr, int fq) const {
        const int row0 = u.pm * BM + wr * 64 + fr, col0 = u.pn * BM + wc * 32 + 8 * fq;
#pragma unroll
        for (int ai = 0; ai < 2; ++ai)
#pragma unroll
            for (int m = 0; m < 4; ++m) {
                const int row = row0 + ai * HALF + m * 16; float ss = 0.f;
#pragma unroll
                for (int bj = 0; bj < 2; ++bj) { const f32x4* hi = (const f32x4*)(Hin + (size_t)row * 1024 + col0 + bj * HALF);
                    const f32x4 v0 = acc[ai][bj][m][0] + hi[0], v1 = acc[ai][bj][m][1] + hi[1]; acc[ai][bj][m][0] = v0; acc[ai][bj][m][1] = v1;
                    ss += ((v0[0] * v0[0] + v0[1] * v0[1]) + (v0[2] * v0[2] + v0[3] * v0[3])) + ((v1[0] * v1[0] + v1[1] * v1[1]) + (v1[2] * v1[2] + v1[3] * v1[3])); }
                ss += __shfl_xor(ss, 16); ss += __shfl_xor(ss, 32);
                if (fq == 0) __hip_atomic_store(part + (size_t)row * 16 + u.pn * 4 + wc, ss, __ATOMIC_RELAXED, __HIP_MEMORY_SCOPE_AGENT);
            }
        asm volatile("s_waitcnt vmcnt(0)" ::: "memory");
        unsigned* pc = cnt + 16 * u.pm;
        if (fr == 0 && fq == 0) __hip_atomic_fetch_add(pc, 1u, __ATOMIC_RELAXED, __HIP_MEMORY_SCOPE_AGENT);
        if (wr == 0 && wc == 0) {
            unsigned spins = 0;
            while (__hip_atomic_load(pc, __ATOMIC_RELAXED, __HIP_MEMORY_SCOPE_AGENT) < 32u && ++spins < (1u << 22)) __builtin_amdgcn_s_sleep(2);
        }
        asm volatile("s_waitcnt vmcnt(0) lgkmcnt(0)" ::: "memory"); __builtin_amdgcn_s_barrier(); asm volatile("" ::: "memory");
        __builtin_amdgcn_fence(__ATOMIC_ACQUIRE, "agent");
#pragma unroll
        for (int ai = 0; ai < 2; ++ai)
#pragma unroll
            for (int m = 0; m < 4; ++m) {
                const int row = row0 + ai * HALF + m * 16; float sq = 0.f;
#pragma unroll
                for (int i = 0; i < 4; ++i) sq += __hip_atomic_load(part + (size_t)row * 16 + 4 * fq + i, __ATOMIC_RELAXED, __HIP_MEMORY_SCOPE_AGENT);
                sq += __shfl_xor(sq, 16); sq += __shfl_xor(sq, 32);
                const float rs = rsqrtf(sq * (1.f / 1024.f) + 1e-6f);
#pragma unroll
                for (int bj = 0; bj < 2; ++bj) { const int col = col0 + bj * HALF; const f32x4 g0 = *(const f32x4*)(gain + col), g1 = *(const f32x4*)(gain + col + 4);
                    f32x4* op = (f32x4*)(Out + (size_t)row * 1024 + col); op[0] = acc[ai][bj][m][0] * rs * g0; op[1] = acc[ai][bj][m][1] * rs * g1; }
            }
    }
};
}
template <class Epi> __device__ __forceinline__ void run_gemm(PG8_LAS unsigned char* lds, const pg8::Gemm& g, const Epi& E, int G, int c) {
    pg8::StaticOrder So; So.init(g.M, g.N, G, c);
    pg8::gemm_phase<Epi, pg8::StaticOrder, true, true>(lds, g, So, E);
}

struct MapZ { DI int operator()(int n) const {
    if (n < 384) return n; if (n < 416) return 640 + (n - 384); if (n < 440) return 1952 + (n - 416); if (n < 512) return -1;
    if (n < 768) return 384 + (n - 512); if (n < 1280) return 672 + (n - 768); if (n < 1408) return 1184 + (n - 1280);
    if (n < 1536) return 1440 + (n - 1408); if (n < 1664) return 1696 + (n - 1536); if (n < 1792) return 1312 + (n - 1664);
    if (n < 1920) return 1568 + (n - 1792); return 1824 + (n - 1920); } };
struct MapUQ { DI int operator()(int n) const { if (n < 512) return (n >> 6) * 96 + (n & 63); n -= 512; return (n >> 5) * 96 + 64 + (n & 31); } };
struct MapUKV { DI int operator()(int n) const { if (n < 512) return (n >> 6) * 128 + (n & 63); n -= 512; return (n >> 6) * 128 + 64 + (n & 63); } };
struct MapUP { DI int operator()(int n) const { const int pn = n >> 8, j = n & 255; return j < 128 ? 128 * pn + j : DFF + 128 * pn + (j - 128); } };
struct MapId { int nvalid; DI int operator()(int n) const { return n < nvalid ? n : -1; } };

template <class Map>
DI void wconv(const float* __restrict__ W, int K, int Nsrc, const float* __restrict__ gain, bf16_t* __restrict__ dst, int Ndst, Map map, float* tile) {
    const int nkt = K / 64, ntiles = nkt * (Ndst / 64); const int tid = tid_now();
    const int kk0 = tid >> 4, nn4 = (tid & 15) * 4, nw = tid >> 3, cw = tid & 7;
    int it = blockIdx.x; if (it >= ntiles) return;
    f32x4 a0, a1, b0 = {0.f, 0.f, 0.f, 0.f}, b1 = {0.f, 0.f, 0.f, 0.f};
#define WCONV_LOAD(IT, R0, R1) do { const int kt_ = (IT) % nkt, nt_ = (IT) / nkt, k0_ = kt_ * 64, n0_ = nt_ * 64; const int src_ = map(n0_ + nn4); \
        R0 = (f32x4){0.f, 0.f, 0.f, 0.f}; R1 = R0; \
        if (src_ >= 0) { R0 = *(const f32x4*)(W + (size_t)(k0_ + kk0) * Nsrc + src_); R1 = *(const f32x4*)(W + (size_t)(k0_ + kk0 + 32) * Nsrc + src_); \
            if (gain) { R0 *= gain[k0_ + kk0]; R1 *= gain[k0_ + kk0 + 32]; } } } while (0)
    WCONV_LOAD(it, a0, a1);
    for (;;) {
        const int nit = it + gridDim.x;
        __syncthreads();
#pragma unroll
        for (int e = 0; e < 4; ++e) { tile[kk0 * 65 + nn4 + e] = a0[e]; tile[(kk0 + 32) * 65 + nn4 + e] = a1[e]; }
        if (nit < ntiles) WCONV_LOAD(nit, b0, b1);
        __syncthreads();
        { const int kt = it % nkt, nt = it / nkt, k0 = kt * 64, n0 = nt * 64;
          const float* tp = tile + (8 * cw) * 65 + nw;
          u32x4 w; w.x = pk2(tp[0], tp[65]); w.y = pk2(tp[2 * 65], tp[3 * 65]); w.z = pk2(tp[4 * 65], tp[5 * 65]); w.w = pk2(tp[6 * 65], tp[7 * 65]);
          *(u32x4*)(dst + (size_t)(n0 + nw) * K + k0 + 8 * cw) = w; }
        if (nit >= ntiles) break;
        a0 = b0; a1 = b1; it = nit;
    }
#undef WCONV_LOAD
}

template <class AF, class Epi>
DI void ngemm(AF af, const bf16_t* __restrict__ Bt, int ldb, int Mr, int N, int K, Epi epi, bool local = false) {
    const int tid = tid_now(), lane = tid & 63, wv = tid >> 6, r = lane & 31, h = lane >> 5;
    const int ntn = N / 64, ntm = Mr / 64; const int gw = local ? wv : blockIdx.x * 8 + wv, ngw = local ? 8 : gridDim.x * 8;
    for (int t = gw; t < ntn * ntm; t += ngw) {
        const int tn = t % ntn, tm = t / ntn, m0 = tm * 64, n0 = tn * 64;
        f32x16 acc[2][2];
#pragma unroll
        for (int a = 0; a < 2; ++a)
#pragma unroll
            for (int b = 0; b < 2; ++b)
#pragma unroll
                for (int i = 0; i < 16; ++i) acc[a][b][i] = 0.f;
        for (int k0 = 0; k0 < K; k0 += 16) {
            bf16x8 a[2], b[2];
#pragma unroll
            for (int mi = 0; mi < 2; ++mi) a[mi] = *(const bf16x8*)af(m0 + mi * 32 + r, k0 + 8 * h);
#pragma unroll
            for (int ni = 0; ni < 2; ++ni) b[ni] = *(const bf16x8*)(Bt + (size_t)(n0 + ni * 32 + r) * ldb + k0 + 8 * h);
#pragma unroll
            for (int mi = 0; mi < 2; ++mi)
#pragma unroll
                for (int ni = 0; ni < 2; ++ni) acc[mi][ni] = MFMA32(b[ni], a[mi], acc[mi][ni]);
        }
#pragma unroll
        for (int mi = 0; mi < 2; ++mi) {
            const int row = m0 + mi * 32 + r; const float ctx = epi.prep(row);
#pragma unroll
            for (int ni = 0; ni < 2; ++ni)
#pragma unroll
                for (int g = 0; g < 4; ++g) {
                    f32x4 v = {acc[mi][ni][4 * g], acc[mi][ni][4 * g + 1], acc[mi][ni][4 * g + 2], acc[mi][ni][4 * g + 3]};
                    epi.store(row, n0 + ni * 32 + 8 * g + 4 * h, v, ctx);
                }
        }
    }
}
struct APlain { const bf16_t* A; size_t lda; DI const bf16_t* operator()(int row, int k) const { return A + (size_t)row * lda + k; } };
struct ACmp { const bf16_t* z; int col0; DI const bf16_t* operator()(int row, int k) const {
    const int bg = row >> 8, n = row & 255, b = bg >> 1, g = bg & 1; return z + (size_t)(b * S + 16 * n + (k >> 6)) * ZP + col0 + g * 64 + (k & 63); } };

DI void st_bf4(bf16_t* p, f32x4 v) { u32x2 w; w.x = pk2(v[0], v[1]); w.y = pk2(v[2], v[3]); *(u32x2*)p = w; }
struct EpiScaleH { bf16_t* O; int ldc; const float* ssqh; int rowoff;
    DI float prep(int row) const { return rstd_h(ssqh, row + rowoff); }
    DI void store(int row, int col, f32x4 v, float c) const { st_bf4(O + (size_t)row * ldc + col, v * c); } };
struct EpiScaleQ { bf16_t* O; int ldc; const float* ssqz; int kv;
    DI float prep(int row) const { return kv ? rstd_kv(ssqz, row) : rstd_q(ssqz, row); }
    DI void store(int row, int col, f32x4 v, float c) const { st_bf4(O + (size_t)row * ldc + col, v * c); } };
struct EpiGelu { bf16_t* O; int ldc; const float* bias;
    DI float prep(int) const { return 0.f; }
    DI void store(int row, int col, f32x4 v, float) const { f32x4 o; for (int i = 0; i < 4; ++i) o[i] = gelu_tanh(v[i] + bias[col + i]); st_bf4(O + (size_t)row * ldc + col, o); } };
struct EpiPlain { bf16_t* O; int ldc;
    DI float prep(int) const { return 0.f; }
    DI void store(int row, int col, f32x4 v, float) const { st_bf4(O + (size_t)row * ldc + col, v); } };
struct EpiRes { float* H; bf16_t* HB;
    DI float prep(int) const { return 0.f; }
    DI void store(int row, int col, f32x4 v, float) const { f32x4* hp = (f32x4*)(H + (size_t)row * DM + col); f32x4 o = *hp + v; *hp = o; st_bf4(HB + (size_t)row * DM + col, o); } };

#define LAS PG8_LAS
#define XB_TMO      128
#define XB_XCNT(j)  (256  + 64 * (j))
#define XB_XSUB(j)  (1280 + 64 * (j))
#define XB_XGEN(j)  (2304 + 64 * (j))
#define XB_TOP      3328
#define XB_TOPGEN   3392
#define XCD_BAR_WORDS 3456
#define XB_SPIN_CAP (1u << 22)

__device__ __forceinline__ unsigned xb_ld(unsigned* p)              { return __hip_atomic_load(p, __ATOMIC_RELAXED, __HIP_MEMORY_SCOPE_AGENT); }
__device__ __forceinline__ unsigned xb_add(unsigned* p, unsigned v) { return __hip_atomic_fetch_add(p, v, __ATOMIC_RELAXED, __HIP_MEMORY_SCOPE_AGENT); }
__device__ __forceinline__ unsigned xb_xcc_id() { return (unsigned)__builtin_amdgcn_s_getreg((3 << 11) | 20) & 0xFu; }
#define XB_SPIN(cond, bar) do { unsigned _sp = 0; while (cond) { __builtin_amdgcn_s_sleep(1); \
    if ((++_sp & 255u) == 0u) { if (xb_ld(&(bar)[XB_TMO])) break; if (_sp > XB_SPIN_CAP) { atomicAdd(&(bar)[XB_TMO], 1u); break; } } } } while (0)

struct XcdBarrier {
    unsigned* bar; unsigned x;
    volatile LAS unsigned* st;
};

__device__ __forceinline__ XcdBarrier xcd_barrier_post(unsigned* bar, volatile LAS unsigned* st) {
    XcdBarrier b; b.bar = bar; b.x = xb_xcc_id(); b.st = st;
    if (threadIdx.x == 0) (void)xb_add(&bar[XB_XCNT(b.x)], 1u);
    return b;
}
__device__ __forceinline__ void xcd_barrier_complete(unsigned* bar, unsigned x, unsigned& nloc, unsigned& nx) {
    const unsigned G = gridDim.x * gridDim.y * gridDim.z;
    unsigned sum, cnt, mine, sp = 0u;
    for (;;) {
        sum = 0u; cnt = 0u; mine = 0u;
#pragma unroll
        for (unsigned j = 0; j < 16; ++j) { const unsigned c = xb_ld(&bar[XB_XCNT(j)]); sum += c; cnt += (c > 0u) ? 1u : 0u; mine = (j == x) ? c : mine; }
        if (sum == G) break;
        __builtin_amdgcn_s_sleep(1);
        if ((++sp & 255u) == 0u) { if (xb_ld(&bar[XB_TMO])) break; if (sp > XB_SPIN_CAP) { atomicAdd(&bar[XB_TMO], 1u); break; } }
    }
    nloc = mine > 0u ? mine : 1u; nx = cnt > 0u ? cnt : 1u;
}

__device__ __forceinline__ void xcd_barrier(const XcdBarrier& b) {
    asm volatile("s_waitcnt vmcnt(0)" ::: "memory");
    __syncthreads();
    if (threadIdx.x == 0) {
        unsigned* bar = b.bar;
        __builtin_amdgcn_s_waitcnt(0);
        unsigned nloc = b.st[0], nx = b.st[1];
        if (nloc == 0u) { xcd_barrier_complete(bar, b.x, nloc, nx); b.st[0] = nloc; b.st[1] = nx; }
        const unsigned old = xb_add(&bar[XB_XSUB(b.x)], 1u);
        const unsigned gen = old / nloc;
        if (old + 1u == (gen + 1u) * nloc) {
            __builtin_amdgcn_fence(__ATOMIC_RELEASE, "agent");
            asm volatile("s_waitcnt vmcnt(0)" ::: "memory");
            const unsigned og = xb_add(&bar[XB_TOP], 1u);
            const unsigned tg = og / nx;
            if (og + 1u == (tg + 1u) * nx) xb_add(&bar[XB_TOPGEN], 1u);
            else XB_SPIN(xb_ld(&bar[XB_TOPGEN]) == tg, bar);
            __builtin_amdgcn_fence(__ATOMIC_ACQUIRE, "agent");
            xb_add(&bar[XB_XGEN(b.x)], 1u);
            asm volatile("s_waitcnt vmcnt(0)" ::: "memory");
        } else {
            XB_SPIN(xb_ld(&bar[XB_XGEN(b.x)]) == gen, bar);
            __builtin_amdgcn_fence(__ATOMIC_ACQUIRE, "agent");
            asm volatile("s_waitcnt vmcnt(0)" ::: "memory");
        }
    }
    __syncthreads();
}
struct Frame {
    const Params __attribute__((address_space(4)))* kp; unsigned char* ws; float* smem; PG8_LAS unsigned char* ldsp;
    int tid, lane, wave, gw, ngw;
    DI bf16_t* wl(int l, size_t off) const { return (bf16_t*)(ws + (size_t)l * WL_STRIDE + off); }
    DI bf16_t* z() const { return (bf16_t*)(ws + WS_Z); }
    DI bf16_t* q() const { return (bf16_t*)(ws + WS_Q); }
    DI bf16_t* kv() const { return (bf16_t*)(ws + WS_KV); }
    DI bf16_t* mix() const { return (bf16_t*)(ws + WS_MIX); }
    DI bf16_t* hu() const { return (bf16_t*)(ws + WS_HU); }
    DI bf16_t* gact() const { return (bf16_t*)(ws + WS_GACT); }
    DI bf16_t* hb() const { return (bf16_t*)(ws + WS_HB); }
    DI float* ssqh() const { return (float*)(ws + WS_SSQH); }
    DI float* ssqz() const { return (float*)(ws + WS_SSQZ); }
    DI bf16_t* kr() const { return (bf16_t*)(ws + WS_KR); }
    DI bf16_t* hidk() const { return (bf16_t*)(ws + WS_HIDK); }
    DI bf16_t* hidv() const { return (bf16_t*)(ws + WS_HIDV); }
    DI bf16_t* kcmp() const { return (bf16_t*)(ws + WS_KCMP); }
    DI bf16_t* vcmp() const { return (bf16_t*)(ws + WS_VCMP); }
    DI float* rope() const { return (float*)(ws + WS_ROPE); }
    DI float* b1(int l, int v) const { return (float*)(ws + WS_B1) + (l * 2 + v) * 128; }
    DI float* h() const { return (float*)(__attribute__((address_space(1))) float*)kp->out; }
    DI const float* gin(int i) const { return (const float*)(const __attribute__((address_space(1))) float*)kp->in[i]; }
};

DI void phase_prep(Frame& F) {
    for (int l = 0; l < 2; ++l) {
        wconv(F.gin(2) + (size_t)l * 1024 * 1976, 1024, 1976, F.gin(1) + l * 1024, F.wl(l, W_IN), 2048, MapZ(), F.smem);
        wconv(F.gin(5) + (size_t)l * 384 * 768, 384, 768, F.gin(3) + l * 384, F.wl(l, W_UQ), 768, MapUQ(), F.smem);
        wconv(F.gin(6) + (size_t)l * 256 * 1024, 256, 1024, F.gin(4) + l * 256, F.wl(l, W_UKV), 1024, MapUKV(), F.smem);
        wconv(F.gin(9) + (size_t)l * 2048 * 128, 2048, 128, nullptr, F.wl(l, W_C1K), 256, MapId{128}, F.smem);
        wconv(F.gin(11) + (size_t)l * 2048 * 128, 2048, 128, nullptr, F.wl(l, W_C1V), 256, MapId{128}, F.smem);
        wconv(F.gin(10) + (size_t)l * 128 * 64, 128, 64, nullptr, F.wl(l, W_C2K), 256, MapId{64}, F.smem);
        wconv(F.gin(12) + (size_t)l * 128 * 64, 128, 64, nullptr, F.wl(l, W_C2V), 256, MapId{64}, F.smem);
        wconv(F.gin(13) + (size_t)l * 1024 * 1024, 1024, 1024, nullptr, F.wl(l, W_O), 1024, MapId{1024}, F.smem);
        wconv(F.gin(15) + (size_t)l * 1024 * NUP, 1024, NUP, F.gin(14) + l * 1024, F.wl(l, W_UP), NUP, MapUP(), F.smem);
        wconv(F.gin(18) + (size_t)l * DFF * 1024, DFF, 1024, nullptr, F.wl(l, W_DN), 1024, MapId{1024}, F.smem);
    }
    if (blockIdx.x >= gridDim.x - 64) {
        const int bb = blockIdx.x - (gridDim.x - 64), lv = bb >> 4, kp = bb & 15, l = lv >> 1, v = lv & 1, e = F.tid & 127, sub = F.tid >> 7;
        const float* pos = (v ? F.gin(8) : F.gin(7)) + l * 2048; const float* w1 = (v ? F.gin(11) : F.gin(9)) + (size_t)l * 2048 * 128;
        float s = 0.f; const int k0 = kp * 128 + sub * 32;
#pragma unroll 8
        for (int k = k0; k < k0 + 32; ++k) s += pos[k] * w1[(size_t)k * 128 + e];
        __syncthreads(); F.smem[F.tid] = s; __syncthreads();
        if (F.tid < 128) ((float*)(F.ws + WS_B1))[1024 + (lv * 16 + kp) * 128 + e] = (F.smem[e] + F.smem[128 + e]) + (F.smem[256 + e] + F.smem[384 + e]);
        __syncthreads();
    }
    for (int i = blockIdx.x * NT + F.tid; i < S * 16; i += gridDim.x * NT) {
        const int t = i >> 4, j = i & 15; const float inv = 1.0f / powf(10000.0f, (float)(2 * j) / 32.0f); const float ang = (float)t * inv;
        F.rope()[i] = cosf(ang); F.rope()[S * 16 + i] = sinf(ang);
    }
    for (int row = F.gw; row < M; row += F.ngw) {
        const f32x4* xr = (const f32x4*)(F.gin(0) + (size_t)row * DM) + F.lane; float s = 0.f;
#pragma unroll
        for (int j = 0; j < 4; ++j) { f32x4 v = xr[64 * j]; s += (v[0] * v[0] + v[1] * v[1]) + (v[2] * v[2] + v[3] * v[3]);
            st_bf4(F.hb() + (size_t)row * DM + 4 * (F.lane + 64 * j), v); }
        s = wave_sum(s);
        if (F.lane < 16) F.ssqh()[(size_t)row * 16 + F.lane] = F.lane == 0 ? s : 0.f;
    }
}
DI void phase_stat_h(Frame& F) {
    for (int row = F.gw; row < M; row += F.ngw) {
        const f32x4* hr = (const f32x4*)(F.h() + (size_t)row * DM) + F.lane; float s = 0.f;
#pragma unroll
        for (int j = 0; j < 4; ++j) { f32x4 v = hr[64 * j]; s += (v[0] * v[0] + v[1] * v[1]) + (v[2] * v[2] + v[3] * v[3]); }
        s = wave_sum(s);
        if (F.lane < 16) F.ssqh()[(size_t)row * 16 + F.lane] = F.lane == 0 ? s : 0.f;
    }
}
DI void phase_stat_z(Frame& F) {
    for (int row = F.gw; row < M; row += F.ngw) {
        const bf16_t* zr = F.z() + (size_t)row * ZP; float sq = 0.f, sk = 0.f;
        for (int j = 0; j < 6; ++j) { float v = bf2f(zr[Z_CQ + F.lane + 64 * j]); sq += v * v; }
        for (int j = 0; j < 4; ++j) { float v = bf2f(zr[Z_CKV + F.lane + 64 * j]); sk += v * v; }
        sq = wave_sum(sq); sk = wave_sum(sk);
        if (F.lane < 24) F.ssqz()[(size_t)row * 24 + F.lane] = F.lane == 0 ? sq : (F.lane == 16 ? sk : 0.f);
    }
}
DI void job_krope(Frame& F) {
    for (int i = blockIdx.x * NT + F.tid; i < M * 16; i += gridDim.x * NT) {
        const int row = i >> 4, j = i & 15, t = row & (S - 1);
        const float c = F.rope()[t * 16 + j], s = F.rope()[S * 16 + t * 16 + j];
        const float x1 = bf2f(F.z()[(size_t)row * ZP + Z_KR + j]), x2 = bf2f(F.z()[(size_t)row * ZP + Z_KR + 16 + j]);
        F.kr()[(size_t)row * 32 + j] = f2bf(x1 * c - x2 * s); F.kr()[(size_t)row * 32 + 16 + j] = f2bf(x2 * c + x1 * s);
    }
}

struct OS { float m, l, o; };
DI void os_init(OS& s) { s.m = -INFINITY; s.l = 0.f; s.o = 0.f; }
DI void os_chunk(OS& st, float s, bool valid, const bf16_t* vbase, size_t vstride, int lane) {
    unsigned long long bal = __ballot(valid);
    if (!bal) return;
    const float cm = wave_max(valid ? s : -INFINITY);
    const float mn = fmaxf(st.m, cm);
    const float alpha = __expf(st.m - mn);
    const float p = valid ? __expf(s - mn) : 0.f;
    st.l = st.l * alpha + wave_sum(p);
    float acc = st.o * alpha;
    while (bal) { const int kk = __ffsll((long long)bal) - 1; bal &= bal - 1; const float pk = __shfl(p, kk); acc += pk * bf2f(vbase[(size_t)kk * vstride + lane]); }
    st.o = acc; st.m = mn;
}
DI float dot_bf(const float* q, const bf16_t* k, int n) {
    float s = 0.f;
    for (int d = 0; d < n; d += 8) { bf16x8 kv = *(const bf16x8*)(k + d);
#pragma unroll
        for (int j = 0; j < 8; ++j) s += q[d + j] * bf2f((bf16_t)kv[j]); }
    return s;
}
DI void phase_attn_naive(Frame& F) {
    float* wq = F.smem + F.wave * 640;
    float* pl = wq + 128;
    const bf16_t* q = F.q(); const bf16_t* kv = F.kv(); const bf16_t* kr = F.kr(); const bf16_t* z = F.z(); bf16_t* mix = F.mix();
    const int lane = F.lane;
    for (int task = F.gw; task < M * 8; task += F.ngw) {
        const int hd = task & 7, row = task >> 3, b = row >> 12, t = row & (S - 1);
        wq[lane] = bf2f(q[(size_t)row * 768 + hd * 64 + lane]);
        if (lane < 16) { const float c = F.rope()[t * 16 + lane], s = F.rope()[S * 16 + t * 16 + lane];
            const float x1 = bf2f(q[(size_t)row * 768 + 512 + hd * 32 + lane]), x2 = bf2f(q[(size_t)row * 768 + 512 + hd * 32 + 16 + lane]);
            wq[64 + lane] = x1 * c - x2 * s; wq[80 + lane] = x2 * c + x1 * s; }
        __builtin_amdgcn_wave_barrier();
        OS st; os_init(st);
        const float scale = 0.10206207261596575f;
        for (int k0 = 0; k0 <= t; k0 += 64) {
            const int key = k0 + lane; const bool valid = key <= t; const size_t kro = (size_t)(b * S + (valid ? key : t));
            const float s = (dot_bf(wq, kv + kro * 1024 + hd * 64, 64) + dot_bf(wq + 64, kr + kro * 32, 32)) * scale;
            os_chunk(st, s, valid, kv + (size_t)(b * S + k0) * 1024 + 512 + hd * 64, 1024, lane);
        }
        mix[(size_t)row * DM + hd * 64 + lane] = f2bf(st.o / st.l);
        __builtin_amdgcn_wave_barrier();
    }
    for (int task = F.gw; task < M * 2; task += F.ngw) {
        const int g = task & 1, row = task >> 1, b = row >> 12, t = row & (S - 1), bg = b * 2 + g, cur = t >> 6;
        const int nvis = t >= 31 ? ((t - 31) >> 4) + 1 : 0;
        float* ocs = wq + 384; float imp = 0.f;
        const bf16_t* kc = F.kcmp() + (size_t)bg * 256 * 64; const bf16_t* vc = F.vcmp() + (size_t)bg * 256 * 64;
        for (int r = 0; r < 4; ++r) {
            const int hd = g * 4 + r; const float slope = exp2f(-(float)(hd + 1));
            wq[lane] = bf2f(z[(size_t)row * ZP + Z_QN + hd * 64 + lane]);
            __builtin_amdgcn_wave_barrier();
            float sc[4]; float mx = -INFINITY;
#pragma unroll
            for (int i = 0; i < 4; ++i) { const int n = lane + 64 * i; const bool valid = n < nvis;
                sc[i] = valid ? dot_bf(wq, kc + (size_t)n * 64, 64) * 0.125f - slope * (float)(t - (16 * n + 31)) : -INFINITY; mx = fmaxf(mx, sc[i]); }
            mx = wave_max(mx);
            float ps[4]; float l = 0.f;
#pragma unroll
            for (int i = 0; i < 4; ++i) { ps[i] = (lane + 64 * i) < nvis ? __expf(sc[i] - mx) : 0.f; l += ps[i]; }
            l = wave_sum(l); const float il = nvis > 0 ? 1.f / l : 0.f;
            float o = 0.f;
#pragma unroll
            for (int i = 0; i < 4; ++i) { ps[i] *= il; pl[lane + 64 * i] = ps[i];
                const int cnt = nvis - 64 * i; for (int kk = 0; kk < 64 && kk < cnt; ++kk) { const float pk = __shfl(ps[i], kk); o += pk * bf2f(vc[(size_t)(64 * i + kk) * 64 + lane]); } }
            ocs[r * 64 + lane] = o;
            __builtin_amdgcn_wave_barrier();
            { const int j = lane; float a = 0.f; for (int n = 4 * j - 1; n <= 4 * j + 3; ++n) if (n >= 0 && n < 255) a += pl[n]; imp += a; }
            __builtin_amdgcn_wave_barrier();
        }
        float v = imp; if (lane > cur) v = -INFINITY; if (lane == 0 || lane == cur || lane == cur - 1) v = INFINITY;
        int rank = 0;
        for (int j = 0; j < 64; ++j) { const float vj = __shfl(v, j); rank += (vj > v || (vj == v && j < lane)) ? 1 : 0; }
        const unsigned long long selmask = __ballot(rank < 16 && lane <= cur);
        for (int r = 0; r < 4; ++r) {
            const int hd = g * 4 + r; const float slope = exp2f(-(float)(hd + 1));
            wq[lane] = bf2f(z[(size_t)row * ZP + Z_QN + hd * 64 + lane]);
            __builtin_amdgcn_wave_barrier();
            OS ss; os_init(ss);
            unsigned long long mm = selmask;
            while (mm) { const int j = __ffsll((long long)mm) - 1; mm &= mm - 1; const int key = 64 * j + lane; const bool valid = key <= t;
                const size_t kro = (size_t)(b * S + (valid ? key : t));
                const float s = dot_bf(wq, z + kro * ZP + Z_KS + g * 64, 64) * 0.125f - slope * (float)(t - key);
                os_chunk(ss, s, valid, z + (size_t)(b * S + 64 * j) * ZP + Z_VS + g * 64, ZP, lane); }
            OS sw; os_init(sw);
            for (int c = 0; c < 9; ++c) { const int j = cur - 8 + c; if (j < 0) continue; const int key = 64 * j + lane; const bool valid = key <= t && (t - key) < 512;
                const size_t kro = (size_t)(b * S + (key <= t ? key : t));
                const float s = dot_bf(wq, z + kro * ZP + Z_KW + g * 64, 64) * 0.125f - slope * (float)(t - key);
                os_chunk(sw, s, valid, z + (size_t)(b * S + 64 * j) * ZP + Z_VW + g * 64, ZP, lane); }
            const bf16_t* gt = z + (size_t)row * ZP + Z_GT + hd * 3;
            const float g0 = 1.f / (1.f + __expf(-bf2f(gt[0]))), g1 = 1.f / (1.f + __expf(-bf2f(gt[1]))), g2 = 1.f / (1.f + __expf(-bf2f(gt[2])));
            const float o = g0 * ocs[r * 64 + lane] + g1 * (ss.o / ss.l) + g2 * (sw.o / sw.l);
            mix[(size_t)row * DM + 512 + hd * 64 + lane] = f2bf(o);
            __builtin_amdgcn_wave_barrier();
        }
    }
}

typedef PG8_LAS bf16_t* lbf;
typedef short s16x4 __attribute__((ext_vector_type(4)));
typedef __bf16 bfv2 __attribute__((ext_vector_type(2)));
typedef float f32x2 __attribute__((ext_vector_type(2)));
constexpr int A_KSZ = 64 * 104, A_VLD = 72, A_VSZ = 64 * A_VLD;
constexpr int A_KOFF = 0, A_VOFF = 2 * A_KSZ * 2, A_IMP = A_VOFF + 2 * A_VSZ * 2, A_IMPLD = 65, A_SELM = A_IMP + 4 * 64 * A_IMPLD * 4, A_UNI = A_SELM + 512, A_IL = A_UNI + 16, A_QIDX = A_IL + 1024, A_END = A_QIDX + 16;
static_assert(A_END <= LDS_BYTES, "attention LDS");
constexpr float LOG2E = 1.4426950408889634f;
DI unsigned cvt2(float lo, float hi) { f32x2 f = {lo, hi}; bfv2 b = __builtin_convertvector(f, bfv2); return __builtin_bit_cast(unsigned, b); }
DI int crow_(int i, int h) { return (i & 3) + 8 * (i >> 2) + 4 * h; }
struct TileRegs { u32x4 k, v, k2; };
template <bool MLA> DI void tile_gload(TileRegs& R, const bf16_t* kp, size_t kst, const bf16_t* vp, size_t vst, const bf16_t* k2p, int kb, int tid) {
    const int key = tid >> 3, c = tid & 7;
    R.k = *(const u32x4*)(kp + (size_t)(kb + key) * kst + 8 * c);
    R.v = *(const u32x4*)(vp + (size_t)(kb + (tid & 63)) * vst + 8 * (tid >> 6));
    if (MLA) R.k2 = *(const u32x4*)(k2p + (size_t)(kb + ((tid & 255) >> 2)) * 32 + 8 * (tid & 3));
}
template <bool MLA> DI void tile_lstore(const TileRegs& R, lbf Ks, lbf Vt, int tid) {
    constexpr int KLD = MLA ? 104 : 72;
    const int key = tid >> 3, c = tid & 7;
    *(PG8_LAS u32x4*)(Ks + key * KLD + 8 * c) = R.k;
    if (MLA) { if (tid < 256) *(PG8_LAS u32x4*)(Ks + (tid >> 2) * KLD + 64 + 8 * (tid & 3)) = R.k2; }
    { const int kv = tid & 63, cv = tid >> 6, kp = (kv & ~12) | ((kv & 4) << 1) | ((kv & 8) >> 1);
#pragma unroll
      for (int j = 0; j < 8; ++j) Vt[(8 * cv + j) * A_VLD + kp] = (bf16_t)(R.v[j >> 1] >> (16 * (j & 1))); }
}
template <int KS> DI void qk_tile(lbf Ks, const bf16x8 (&Q)[KS], f32x16& s0, f32x16& s1, int r, int h) {
    constexpr int KLD = KS == 6 ? 104 : 72;
#pragma unroll
    for (int i = 0; i < 16; ++i) { s0[i] = 0.f; s1[i] = 0.f; }
    const PG8_LAS bf16x8* p0 = (const PG8_LAS bf16x8*)(Ks + r * KLD + 8 * h); const PG8_LAS bf16x8* p1 = (const PG8_LAS bf16x8*)(Ks + (32 + r) * KLD + 8 * h);
    bf16x8 a0 = p0[0], a1 = p1[0], b0, b1;
#pragma unroll
    for (int ks = 0; ks < KS; ks += 2) {
        b0 = p0[2 * (ks + 1)]; b1 = p1[2 * (ks + 1)];
        __builtin_amdgcn_sched_barrier(0);
        s0 = MFMA32(a0, Q[ks], s0); s1 = MFMA32(a1, Q[ks], s1);
        __builtin_amdgcn_sched_barrier(0);
        if (ks + 2 < KS) { a0 = p0[2 * (ks + 2)]; a1 = p1[2 * (ks + 2)]; }
        __builtin_amdgcn_sched_barrier(0);
        s0 = MFMA32(b0, Q[ks + 1], s0); s1 = MFMA32(b1, Q[ks + 1], s1);
        __builtin_amdgcn_sched_barrier(0);
    }
}
DI bf16x8 pack8(const f32x16& p, int s) {
    u32x4 w; w.x = cvt2(p[8 * s], p[8 * s + 1]); w.y = cvt2(p[8 * s + 2], p[8 * s + 3]); w.z = cvt2(p[8 * s + 4], p[8 * s + 5]); w.w = cvt2(p[8 * s + 6], p[8 * s + 7]);
    return __builtin_bit_cast(bf16x8, w);
}
DI void pv_load(lbf Vt, int g, int r, int h, bf16x8& v0, bf16x8& v1) {
    const int col = 32 * (g >> 1) + 16 * (g & 1) + 8 * h;
    v0 = *(const PG8_LAS bf16x8*)(Vt + r * A_VLD + col); v1 = *(const PG8_LAS bf16x8*)(Vt + (32 + r) * A_VLD + col);
}
DI void pv_tile(lbf Vt, const f32x16& p0, const f32x16& p1, f32x16 (&O)[2], int r, int h) {
    bf16x8 va0, va1, vb0, vb1;
    pv_load(Vt, 0, r, h, va0, va1);
#pragma unroll
    for (int g = 0; g < 4; g += 2) {
        pv_load(Vt, g + 1, r, h, vb0, vb1);
        const bf16x8 pa = pack8(g >> 1 ? p1 : p0, 0);
        __builtin_amdgcn_sched_barrier(0);
        O[0] = MFMA32(va0, pa, O[0]); O[1] = MFMA32(va1, pa, O[1]);
        __builtin_amdgcn_sched_barrier(0);
        if (g + 2 < 4) pv_load(Vt, g + 2, r, h, va0, va1);
        const bf16x8 pb = pack8(g >> 1 ? p1 : p0, 1);
        __builtin_amdgcn_sched_barrier(0);
        O[0] = MFMA32(vb0, pb, O[0]); O[1] = MFMA32(vb1, pb, O[1]);
        __builtin_amdgcn_sched_barrier(0);
    }
}
DI float row_max(const f32x16& x0, const f32x16& x1) {
    float mx = fmaxf(x0[0], x1[0]);
#pragma unroll
    for (int i = 1; i < 16; ++i) mx = fmaxf(mx, fmaxf(x0[i], x1[i]));
    return fmaxf(mx, __shfl_xor(mx, 32));
}
template <bool PV> DI void online_step_mx(f32x16& x0, f32x16& x1, float mx, float& m, float& l, f32x16 (&O)[2]);
template <bool PV> DI void online_step(f32x16& x0, f32x16& x1, float& m, float& l, f32x16 (&O)[2]) { online_step_mx<PV>(x0, x1, row_max(x0, x1), m, l, O); }
template <bool PV> DI void online_step_mx(f32x16& x0, f32x16& x1, float mx, float& m, float& l, f32x16 (&O)[2]) {
    const float mn = fmaxf(m, mx), alpha = __builtin_amdgcn_exp2f(m - mn);
    float ls = 0.f;
#pragma unroll
    for (int i = 0; i < 16; ++i) { x0[i] = __builtin_amdgcn_exp2f(x0[i] - mn); x1[i] = __builtin_amdgcn_exp2f(x1[i] - mn); ls += x0[i] + x1[i]; }
    ls += __shfl_xor(ls, 32);
    l = l * alpha + ls; m = mn;
    if (PV) { if (__any(alpha != 1.f)) {
#pragma unroll
        for (int i = 0; i < 16; ++i) { O[0][i] *= alpha; O[1][i] *= alpha; } } }
}
DI void online_raw(f32x16& s0, f32x16& s1, float c1, float& m, float& l, f32x16 (&O)[2]) {
    float mx = fmaxf(s0[0], s1[0]);
#pragma unroll
    for (int i = 1; i < 16; ++i) mx = fmaxf(mx, fmaxf(s0[i], s1[i]));
    mx = fmaxf(mx, __shfl_xor(mx, 32));
    const float mn = fmaxf(m, mx * c1), alpha = __builtin_amdgcn_exp2f(m - mn), nmn = -mn;
    float ls = 0.f;
#pragma unroll
    for (int i = 0; i < 16; ++i) { s0[i] = __builtin_amdgcn_exp2f(fmaf(s0[i], c1, nmn)); s1[i] = __builtin_amdgcn_exp2f(fmaf(s1[i], c1, nmn)); ls += s0[i] + s1[i]; }
    ls += __shfl_xor(ls, 32);
    l = l * alpha + ls; m = mn;
    if (__any(alpha != 1.f)) {
#pragma unroll
        for (int i = 0; i < 16; ++i) { O[0][i] *= alpha; O[1][i] *= alpha; } }
}
struct TlRange { int lo, hi; DI int first() const { return lo <= hi ? lo * 64 : -1; } DI int next(int kb) const { return kb + 64 <= hi * 64 ? kb + 64 : -1; } };
struct TlRangeDesc { int lo, hi; DI int first() const { return lo <= hi ? hi * 64 : -1; } DI int next(int kb) const { return kb - 64 >= lo * 64 ? kb - 64 : -1; } };
struct TlMaskDesc { unsigned long long mask; DI int first() const { return mask ? (63 - __clzll((long long)mask)) * 64 : -1; }
    DI int next(int kb) const { const int j = kb >> 6; const unsigned long long rest = j == 0 ? 0ull : (mask & ((1ull << j) - 1ull)); return rest ? (63 - __clzll((long long)rest)) * 64 : -1; } };
struct TlMask { unsigned long long mask; DI int first() const { return mask ? (__ffsll((long long)mask) - 1) * 64 : -1; }
    DI int next(int kb) const { const int j = kb >> 6; const unsigned long long rest = j >= 63 ? 0ull : (mask >> (j + 1)); return rest ? (j + 1 + __ffsll((long long)rest) - 1) * 64 : -1; } };
template <bool MLA, class TL, class CF>
DI void att_pipe(lbf KB, lbf VB, const bf16_t* kp, size_t kst, const bf16_t* vp, size_t vst, const bf16_t* k2p, const TL& tl, CF& cf, int) {
    int kb = tl.first(); if (kb < 0) return;
    const int tid = tid_now();
    TileRegs R0, R1; tile_gload<MLA>(R0, kp, kst, vp, vst, k2p, kb, tid);
    int nk = tl.next(kb);
    tile_gload<MLA>(R1, kp, kst, vp, vst, k2p, nk >= 0 ? nk : kb, tid);
    __syncthreads();
    tile_lstore<MLA>(R0, KB, VB, tid);
    __syncthreads();
    int cb = 0;
#define ATT_STEP(RA, RB) { const int nn = nk >= 0 ? tl.next(nk) : -1; \
        tile_gload<MLA>(RA, kp, kst, vp, vst, k2p, nn >= 0 ? nn : kb, tid);     \
        cf(KB + cb * A_KSZ, VB + cb * A_VSZ, kb); \
        if (nk >= 0) tile_lstore<MLA>(RB, KB + (cb ^ 1) * A_KSZ, VB + (cb ^ 1) * A_VSZ, tid); \
        __syncthreads(); \
        if (nk < 0) break; \
        kb = nk; nk = nn; cb ^= 1; }
    for (;;) {
        ATT_STEP(R0, R1)
        ATT_STEP(R1, R0)
    }
#undef ATT_STEP
}
struct CfMla { const bf16x8 (&Q)[6]; f32x16 (&O)[2]; float& m; float& l; int t, tq0, r, h;
    DI void operator()(lbf Ks, lbf Vt, int kb) {
        if (kb > __builtin_amdgcn_readfirstlane(tq0) + 31) return;
        f32x16 x0, x1; qk_tile<6>(Ks, Q, x0, x1, r, h);
        const float c1 = 0.10206207261596575f * LOG2E;
        if (kb + 63 > __builtin_amdgcn_readfirstlane(tq0)) {
            const int dt = t - kb - 4 * h;
#pragma unroll
            for (int i = 0; i < 16; ++i) { const int ci = (i & 3) + 8 * (i >> 2); x0[i] = ci <= dt ? x0[i] : -INFINITY; x1[i] = ci + 32 <= dt ? x1[i] : -INFINITY; }
        }
        online_raw(x0, x1, c1, m, l, O); pv_tile(Vt, x0, x1, O, r, h);
    } };
template <bool SEL> struct CfNsa { const bf16x8 (&Q)[4]; f32x16 (&O)[2]; float& m; float& l; int t, r, h; float sl2; unsigned long long qsel;
    DI void operator()(lbf Ks, lbf Vt, int kb) {
        f32x16 x0, x1; qk_tile<4>(Ks, Q, x0, x1, r, h);
        const float c1 = 0.125f * LOG2E; const bool on = !SEL || ((qsel >> (kb >> 6)) & 1ull);
        const int tq0 = __builtin_amdgcn_readfirstlane(t - r);
        const float base = on ? sl2 * (float)(kb + 4 * h - t) : -INFINITY;
#pragma unroll
        for (int i = 0; i < 16; ++i) { const int ci = (i & 3) + 8 * (i >> 2); x0[i] = fmaf(x0[i], c1, fmaf(sl2, (float)ci, base)); x1[i] = fmaf(x1[i], c1, fmaf(sl2, (float)(ci + 32), base)); }
        if (kb + 63 > tq0 || (!SEL && tq0 + 31 - kb >= 512)) {
            const int dt = t - kb - 4 * h;
#pragma unroll
            for (int i = 0; i < 16; ++i) { const int ci = (i & 3) + 8 * (i >> 2);
                const bool v0 = ci <= dt && (SEL || dt - ci < 512), v1 = ci + 32 <= dt && (SEL || dt - ci - 32 < 512);
                x0[i] = v0 ? x0[i] : -INFINITY; x1[i] = v1 ? x1[i] : -INFINITY; }
        }
        {
            const float mx = row_max(x0, x1);
            if (!__any(mx - m > -160.f)) return;
            online_step_mx<true>(x0, x1, mx, m, l, O);
        }
        pv_tile(Vt, x0, x1, O, r, h);
    } };
struct CfCmp { const bf16x8 (&Q)[4]; f32x16 (&O)[2]; float& m; float& l; int t, r, h; float sl2; int nvis; PG8_LAS float* imp; int nvmin;
    DI void operator()(lbf Ks, lbf Vt, int kb) {
        f32x16 x0, x1; qk_tile<4>(Ks, Q, x0, x1, r, h);
        const float c1 = 0.125f * LOG2E;
        const int dn = nvis - kb - 4 * h;
        const float df = sl2 * (float)(16 * (kb + 4 * h) + 31 - t), s16 = 16.f * sl2;
#pragma unroll
        for (int i = 0; i < 16; ++i) { const int ci = (i & 3) + 8 * (i >> 2); const float bi = fmaf(s16, (float)ci, df); x0[i] = fmaf(x0[i], c1, bi); x1[i] = fmaf(x1[i], c1, bi + 32.f * s16); }
        if (kb + 64 > __builtin_amdgcn_readfirstlane(nvmin)) {
#pragma unroll
            for (int i = 0; i < 16; ++i) { const int ci = (i & 3) + 8 * (i >> 2); x0[i] = ci < dn ? x0[i] : -INFINITY; x1[i] = ci + 32 < dn ? x1[i] : -INFINITY; }
        }
        const float mold = m, mxr = row_max(x0, x1);
        if (!__any(mxr - m > -160.f)) return;
        online_step_mx<true>(x0, x1, mxr, m, l, O);
        const float alpha = __builtin_amdgcn_exp2f(mold - m);
        if (__any(alpha != 1.f && mold > -1e29f)) {
#pragma unroll 4
            for (int k = 0; k < 32; ++k) imp[2 * k + h] *= alpha;
        }
        pv_tile(Vt, x0, x1, O, r, h);
        { const int a0 = (kb >> 2) + h; float o[8];
#pragma unroll
          for (int k = 0; k < 8; ++k) o[k] = imp[a0 + 2 * k];
#pragma unroll
          for (int k = 0; k < 8; ++k) { const f32x16& p = (k >> 2) ? x1 : x0; const int g4 = k & 3; imp[a0 + 2 * k] = o[k] + ((p[4 * g4] + p[4 * g4 + 1]) + (p[4 * g4 + 2] + p[4 * g4 + 3])); }
          asm volatile("" ::: "memory");
#pragma unroll
          for (int k = 0; k < 8; ++k) o[k] = imp[a0 + 2 * k + 1];
#pragma unroll
          for (int k = 0; k < 8; ++k) { const f32x16& p = (k >> 2) ? x1 : x0; imp[a0 + 2 * k + 1] = o[k] + p[4 * (k & 3) + 3]; }
          asm volatile("" ::: "memory"); }
    } };
DI void write_o(bf16_t* dst, const f32x16 (&O)[2], float sc, int h) {
#pragma unroll
    for (int dh = 0; dh < 2; ++dh)
#pragma unroll
        for (int g4 = 0; g4 < 4; ++g4) { u32x2 w; w.x = cvt2(O[dh][4 * g4] * sc, O[dh][4 * g4 + 1] * sc); w.y = cvt2(O[dh][4 * g4 + 2] * sc, O[dh][4 * g4 + 3] * sc);
            *(u32x2*)(dst + 32 * dh + 8 * g4 + 4 * h) = w; }
}
DI void zero_o(f32x16 (&O)[2]) {
#pragma unroll
    for (int i = 0; i < 16; ++i) { O[0][i] = 0.f; O[1][i] = 0.f; }
}
DI void unit_mla(Frame& F, int b, int hd, int qb, int tid) {
    const int lane = tid & 63, w = tid >> 6, r = lane & 31, h = lane >> 5, tq0 = qb * 256 + 32 * w, t = tq0 + r; const size_t row = (size_t)b * S + t;
    lbf KB = (lbf)(F.ldsp + A_KOFF), VB = (lbf)(F.ldsp + A_VOFF);
    bf16x8 Q[6];
    const bf16_t* qr = F.q() + row * 768;
#pragma unroll
    for (int ks = 0; ks < 4; ++ks) Q[ks] = *(const bf16x8*)(qr + hd * 64 + 16 * ks + 8 * h);
    { const bf16x8 x1 = *(const bf16x8*)(qr + 512 + hd * 32 + 8 * h), x2 = *(const bf16x8*)(qr + 512 + hd * 32 + 16 + 8 * h);
      int ro = t * 16 + 8 * h; asm volatile("" : "+v"(ro));
      const f32x4* cs = (const f32x4*)(F.rope() + ro); const f32x4* sn = (const f32x4*)(F.rope() + S * 16 + ro);
      const f32x4 c0 = cs[0], c1 = cs[1], s0 = sn[0], s1 = sn[1];
#pragma unroll
      for (int j = 0; j < 8; ++j) { const float a = bf2f((bf16_t)x1[j]), bb = bf2f((bf16_t)x2[j]), c = j < 4 ? c0[j & 3] : c1[j & 3], s = j < 4 ? s0[j & 3] : s1[j & 3]; Q[4][j] = (short)f2bf(a * c - bb * s); Q[5][j] = (short)f2bf(bb * c + a * s); } }
    __builtin_amdgcn_sched_barrier(0);
    f32x16 O[2]; zero_o(O); float m = -1e30f, l = 0.f;
    CfMla cf{Q, O, m, l, t, tq0, r, h};
    const bf16_t* kvb = F.kv() + (size_t)b * S * 1024;
    att_pipe<true>(KB, VB, kvb + hd * 64, 1024, kvb + 512 + hd * 64, 1024, F.kr() + (size_t)b * S * 32, TlRange{0, 4 * qb + 3}, cf, tid);
    write_o(F.mix() + row * DM + hd * 64, O, 1.f / l, h);
}
DI void unit_nsa(Frame& F, int b, int g, int qt, int tid) {
    const int lane = tid & 63, w = tid >> 6, r = lane & 31, h = lane >> 5, rh = w >> 1, sub = w & 1, hd = 4 * g + rh, ql = 32 * sub + r, t = qt * 64 + ql, bg = b * 2 + g;
    const size_t row = (size_t)b * S + t;
    lbf KB = (lbf)(F.ldsp + A_KOFF), VB = (lbf)(F.ldsp + A_VOFF);
    PG8_LAS float* impr = (PG8_LAS float*)(F.ldsp + A_IMP) + (rh * 64 + ql) * A_IMPLD;
    PG8_LAS unsigned* selm = (PG8_LAS unsigned*)(F.ldsp + A_SELM); PG8_LAS unsigned* uni = (PG8_LAS unsigned*)(F.ldsp + A_UNI);
    const bf16_t* zb = F.z() + (size_t)b * S * ZP;
    bf16x8 Q[4];
#pragma unroll
    for (int ks = 0; ks < 4; ++ks) Q[ks] = *(const bf16x8*)(F.z() + row * ZP + Z_QN + hd * 64 + 16 * ks + 8 * h);
    const float sl2 = exp2f(-(float)(hd + 1)) * LOG2E;
    const bf16_t* gt = F.z() + row * ZP + Z_GT + hd * 3;
    const float g0 = 1.f / (1.f + __expf(-bf2f(gt[0]))), g1 = 1.f / (1.f + __expf(-bf2f(gt[1]))), g2 = 1.f / (1.f + __expf(-bf2f(gt[2])));
    f32x16 O[2], Of[2]; float m, l;
    const int tmax = qt * 64 + 63, nvmax = tmax >= 31 ? ((tmax - 31) >> 4) + 1 : 0, ntc = (nvmax + 63) >> 6, nvis = t >= 31 ? ((t - 31) >> 4) + 1 : 0;
    const int tw0 = t - r, nvmin = tw0 >= 31 ? ((tw0 - 31) >> 4) + 1 : 0;
    const bf16_t* kc = F.kcmp() + (size_t)bg * 256 * 64; const bf16_t* vc = F.vcmp() + (size_t)bg * 256 * 64;
    if (tid < 2) uni[tid] = 0u;
#pragma unroll
    for (int i = 0; i < 32; ++i) impr[32 * h + i] = 0.f;
    zero_o(O); m = -1e30f; l = 0.f;
    PG8_LAS float* ilq = (PG8_LAS float*)(F.ldsp + A_IL);
    { CfCmp c1{Q, O, m, l, t, r, h, sl2, nvis, impr, nvmin}; att_pipe<false>(KB, VB, kc, 64, vc, 64, nullptr, TlRangeDesc{0, ntc - 1}, c1, tid); }
    { const float il = l > 0.f ? 1.f / l : 0.f; if (h == 0) ilq[rh * 64 + ql] = il;
#pragma unroll
      for (int i = 0; i < 16; ++i) { Of[0][i] = (g0 * il) * O[0][i]; Of[1][i] = (g0 * il) * O[1][i]; } }
    __syncthreads();
#ifndef X_TOPK
    __builtin_amdgcn_sched_barrier(0);
    { const int tid = tid_now();
        PG8_LAS float* ib = (PG8_LAS float*)(F.ldsp + A_IMP);
        const int q = tid >> 3, jj = tid & 7;
        float mine[8];
#pragma unroll
        for (int k = 0; k < 8; ++k) { const int j = 8 * jj + k; const int o = q * A_IMPLD + j;
            float v = ((ib[o] * ilq[q] + ib[64 * A_IMPLD + o] * ilq[64 + q]) + ib[2 * 64 * A_IMPLD + o] * ilq[128 + q]) + ib[3 * 64 * A_IMPLD + o] * ilq[192 + q];
            if (j > qt) v = -INFINITY; if (j == 0 || j == qt || j == qt - 1) v = INFINITY; mine[k] = v; }
        __syncthreads();
#pragma unroll
        for (int k = 0; k < 8; ++k) ib[q * A_IMPLD + 8 * jj + k] = mine[k];
        __syncthreads();
        int rank[8];
#pragma unroll
        for (int k = 0; k < 8; ++k) rank[k] = 0;
        for (int j2 = 0; j2 <= qt; ++j2) { const float v2 = ib[q * A_IMPLD + j2];
#pragma unroll
            for (int k = 0; k < 8; ++k) rank[k] += (v2 > mine[k] || (v2 == mine[k] && j2 < 8 * jj + k)) ? 1 : 0; }
        unsigned bits = 0u;
#pragma unroll
        for (int k = 0; k < 8; ++k) if (rank[k] < 16 && 8 * jj + k <= qt) bits |= 1u << k;
        unsigned lo = jj < 4 ? bits << (8 * jj) : 0u, hi = jj >= 4 ? bits << (8 * (jj - 4)) : 0u;
#pragma unroll
        for (int o = 1; o < 8; o <<= 1) { lo |= __shfl_xor(lo, o); hi |= __shfl_xor(hi, o); }
        if (jj == 0) { selm[2 * q] = lo; selm[2 * q + 1] = hi; __hip_atomic_fetch_or(uni, lo, __ATOMIC_RELAXED, __HIP_MEMORY_SCOPE_WORKGROUP); __hip_atomic_fetch_or(uni + 1, hi, __ATOMIC_RELAXED, __HIP_MEMORY_SCOPE_WORKGROUP); }
        __syncthreads();
    }
#endif
    const unsigned long long qsel = (unsigned long long)selm[2 * ql] | ((unsigned long long)selm[2 * ql + 1] << 32);
    const unsigned long long umask = (unsigned long long)uni[0] | ((unsigned long long)uni[1] << 32);
    zero_o(O); m = -1e30f; l = 0.f;
#ifndef X_SEL
    __builtin_amdgcn_sched_barrier(0);
    { const int r = tid_now() & 31, h = (tid_now() >> 5) & 1; CfNsa<true> cs{Q, O, m, l, t, r, h, sl2, qsel}; att_pipe<false>(KB, VB, zb + Z_KS + g * 64, ZP, zb + Z_VS + g * 64, ZP, nullptr, TlMaskDesc{umask}, cs, tid); }
#endif
    { const float sc = g1 / l;
#pragma unroll
      for (int i = 0; i < 16; ++i) { Of[0][i] += sc * O[0][i]; Of[1][i] += sc * O[1][i]; } }
    zero_o(O); m = -1e30f; l = 0.f;
#ifndef X_WIN
    __builtin_amdgcn_sched_barrier(0);
    { const int r = tid_now() & 31, h = (tid_now() >> 5) & 1; CfNsa<false> cw{Q, O, m, l, t, r, h, sl2, 0ull}; att_pipe<false>(KB, VB, zb + Z_KW + g * 64, ZP, zb + Z_VW + g * 64, ZP, nullptr, TlRangeDesc{qt >= 8 ? qt - 8 : 0, qt}, cw, tid); }
#endif
    { const float sc = g2 / l;
#pragma unroll
      for (int i = 0; i < 16; ++i) { Of[0][i] += sc * O[0][i]; Of[1][i] += sc * O[1][i]; } }
    write_o(F.mix() + row * DM + 512 + hd * 64, Of, 1.f, h);
}
DI void phase_attn_fast(Frame& F, int l) {
    const int tid = tid_now();
    PG8_LAS int* qidx = (PG8_LAS int*)(F.ldsp + A_QIDX);
    unsigned* ctr = (unsigned*)(F.ws + WS_CTL) + (l & 3);
    unsigned* done = (unsigned*)(F.ws + WS_CTL) + 8 + (l & 1);
    if (blockIdx.x < 16 && l < 2) {
        const int c = blockIdx.x, G = gridDim.x, v = c >> 3, u = c & 7;
        if (v == 0) run_gemm(F.ldsp, pg8::Gemm{F.z() + Z_KC, F.wl(l, W_C1K), 2048, 256, 2048, 16 * ZP, ZP * 2, 1}, pg8::EpiG<pg8::EM_GELU, 0>{F.hidk(), 256, 128, nullptr, 0, F.b1(l, 0), nullptr, nullptr, nullptr}, G, u);
        else run_gemm(F.ldsp, pg8::Gemm{F.z() + Z_VC, F.wl(l, W_C1V), 2048, 256, 2048, 16 * ZP, ZP * 2, 1}, pg8::EpiG<pg8::EM_GELU, 0>{F.hidv(), 256, 128, nullptr, 0, F.b1(l, 1), nullptr, nullptr, nullptr}, G, u);
        __threadfence(); __syncthreads(); __builtin_amdgcn_fence(__ATOMIC_ACQUIRE, "agent");
        if (v == 0) ngemm(APlain{F.hidk() + (size_t)u * 256 * 256, 256}, F.wl(l, W_C2K), 128, 256, 64, 128, EpiPlain{F.kcmp() + (size_t)u * 256 * 64, 64}, true);
        else ngemm(APlain{F.hidv() + (size_t)u * 256 * 256, 256}, F.wl(l, W_C2V), 128, 256, 64, 128, EpiPlain{F.vcmp() + (size_t)u * 256 * 64, 64}, true);
        __threadfence(); __syncthreads();
        if (tid == 0) __hip_atomic_fetch_add(done, 1u, __ATOMIC_RELEASE, __HIP_MEMORY_SCOPE_AGENT);
    }
    bool cmp_ok = false;
    for (;;) {
        __syncthreads();
        if (tid == 0) qidx[0] = (int)atomicAdd(ctr, 1u);
        __syncthreads();
        const int i = qidx[0];
        if (i >= 1024) break;
        int tidu = tid; asm volatile("" : "+v"(tidu));
        if (i < 512) { const int k = i & 31; unit_mla(F, k >> 3, k & 7, 15 - (i >> 5), tidu); }
        else {
            if (!cmp_ok) {
                if (tid == 0) { while (__hip_atomic_load(done, __ATOMIC_RELAXED, __HIP_MEMORY_SCOPE_AGENT) < 16u) __builtin_amdgcn_s_sleep(8); }
                __syncthreads(); __builtin_amdgcn_fence(__ATOMIC_ACQUIRE, "agent"); cmp_ok = true;
            }
            const int j = i - 512; unit_nsa(F, (j & 7) >> 1, j & 1, 63 - (j >> 3), tidu);
        }
    }
}
DI void phase_conv(Frame& F, int l, int b) {
    const float* cw = F.gin(16) + (size_t)l * 3 * NUP; const float* cb = F.gin(17) + (size_t)l * NUP;
    const bf16_t* hu = F.hu(); bf16_t* ga = F.gact() + (size_t)b * S * DFF;
    for (size_t i = (size_t)blockIdx.x * NT + F.tid; i < (size_t)S * DFF; i += (size_t)gridDim.x * NT) {
        const int t = (int)(i / DFF), c = (int)(i % DFF), pn = c >> 7, j = c & 127, colg = pn * 256 + j, colu = colg + 128, cu = DFF + c;
        float hg = cb[c], hup = cb[cu];
#pragma unroll
        for (int k = 0; k < 3; ++k) { const int tt = t - 2 + k; if (tt >= 0) { hg += cw[k * NUP + c] * bf2f(hu[(size_t)tt * NUP + colg]); hup += cw[k * NUP + cu] * bf2f(hu[(size_t)tt * NUP + colu]); } }
        ga[(size_t)t * DFF + c] = f2bf(hg / (1.f + __expf(-hg)) * hup);
    }
}
DI void phase_final(Frame& F) {
    const float* fn = F.gin(19);
    for (int row = F.gw; row < M; row += F.ngw) {
        const float rs = rstd_h(F.ssqh(), row); f32x4* hr = (f32x4*)(F.h() + (size_t)row * DM) + F.lane; const f32x4* gn = (const f32x4*)fn + F.lane;
#pragma unroll
        for (int j = 0; j < 4; ++j) hr[64 * j] = hr[64 * j] * rs * gn[64 * j];
    }
}

constexpr int NPH = 13;
DI void run_phase(Frame& F, int ph) {
    if (ph == 0) { phase_prep(F);
#ifdef DUP_PREP
        __syncthreads(); phase_prep(F);
#endif
        return; }
    const int l = (ph - 1) / 6, s0_ = (ph - 1) % 6;
    const int s = s0_ == 0 ? 0 : (s0_ == 1 ? 2 : (s0_ == 2 ? 4 : (s0_ == 3 ? 5 : (s0_ == 4 ? 7 : 15))));
#ifdef ONLY_S
    if (s != ONLY_S) return;
#endif
    int G = gridDim.x, c = blockIdx.x; asm volatile("" : "+s"(G), "+s"(c));
    if (s == 0) { run_gemm(F.ldsp, pg8::Gemm{F.hb(), F.wl(l, W_IN), M, ZP, 1024, DM, 128, 0}, pg8::EpiG<pg8::EM_SCALEH, 2>{F.z(), ZP, ZP, F.ssqh(), 0, nullptr, nullptr, F.ssqz(), nullptr}, G, c);
#ifdef DUP_ZP
        run_gemm(F.ldsp, pg8::Gemm{F.hb(), F.wl(l, W_IN), M, ZP, 1024, DM, 128, 0}, pg8::EpiG<pg8::EM_SCALEH, 2>{F.z(), ZP, ZP, F.ssqh(), 0, nullptr, nullptr, F.ssqz(), nullptr}, G, c);
#endif
        return; }
    if (s == 1) { phase_stat_z(F); return; }
    if (s == 2) {
        run_gemm(F.ldsp, pg8::Gemm{F.z() + Z_CQ, F.wl(l, W_UQ), M, 768, 384, ZP, 128, 0}, pg8::EpiG<pg8::EM_SCALEQ, 0>{F.q(), 768, 768, F.ssqz(), 0, nullptr, nullptr, nullptr, nullptr}, G, c);
        run_gemm(F.ldsp, pg8::Gemm{F.z() + Z_CKV, F.wl(l, W_UKV), M, 1024, 256, ZP, 128, 0}, pg8::EpiG<pg8::EM_SCALEKV, 0>{F.kv(), 1024, 1024, F.ssqz(), 0, nullptr, nullptr, nullptr, nullptr}, G, c);
        job_krope(F);
        if (blockIdx.x == gridDim.x - 1 && F.tid < 256) {
            const int v = F.tid >> 7, e = F.tid & 127; const float* pp = (const float*)(F.ws + WS_B1) + 1024 + ((l * 2 + v) * 16) * 128 + e; float s = 0.f;
            for (int kp = 0; kp < 16; ++kp) s += pp[kp * 128];
            F.b1(l, v)[e] = s;
        }
#ifdef DUP_ZP
        run_gemm(F.ldsp, pg8::Gemm{F.z() + Z_CQ, F.wl(l, W_UQ), M, 768, 384, ZP, 128, 0}, pg8::EpiG<pg8::EM_SCALEQ, 0>{F.q(), 768, 768, F.ssqz(), 0, nullptr, nullptr, nullptr, nullptr}, G, c);
        run_gemm(F.ldsp, pg8::Gemm{F.z() + Z_CKV, F.wl(l, W_UKV), M, 1024, 256, ZP, 128, 0}, pg8::EpiG<pg8::EM_SCALEKV, 0>{F.kv(), 1024, 1024, F.ssqz(), 0, nullptr, nullptr, nullptr, nullptr}, G, c);
        job_krope(F);
#endif
        return;
    }
#ifdef NAIVE_ATTN
    if (s == 4) { phase_attn_naive(F); return; }
#else
    if (s == 4) { phase_attn_fast(F, l);
#ifdef DUP_ATT
        phase_attn_fast(F, l + 2);
#endif
        return; }
#endif
    if (s == 5) { run_gemm(F.ldsp, pg8::Gemm{F.mix(), F.wl(l, W_O), M, DM, 1024, DM, 128, 0}, pg8::EpiG<pg8::EM_RES, 1>{F.hb(), DM, DM, nullptr, 0, nullptr, F.h(), F.ssqh(), l == 0 ? F.gin(0) : (const float*)F.h()}, G, c); return; }
    if (s == 6 || s == 16) { phase_stat_h(F); return; }
    if (s == 7) {
#ifdef CONV256
        run_gemm(F.ldsp, pg8::Gemm{F.hb(), F.wl(l, W_UP), M, NUP, 1024, DM, 128, 0},
                 pg8::EpiConv<256>{F.gact(), F.ssqh(), F.gin(16) + (size_t)l * 3 * NUP, F.gin(17) + (size_t)l * NUP, (PG8_LAS float*)(F.ldsp + 131072)}, G, c);
        return;
#endif
        run_gemm(F.ldsp, pg8::Gemm{F.hb(), F.wl(l, W_UP), 68 * 256, NUP, 1024, DM, 128, 2},
                 pg8::EpiConv<254>{F.gact(), F.ssqh(), F.gin(16) + (size_t)l * 3 * NUP, F.gin(17) + (size_t)l * NUP, (PG8_LAS float*)(F.ldsp + 131072)}, G, c);
#ifdef DUP_UP
        run_gemm(F.ldsp, pg8::Gemm{F.hb(), F.wl(l, W_UP), 68 * 256, NUP, 1024, DM, 128, 2},
                 pg8::EpiConv<254>{F.gact(), F.ssqh(), F.gin(16) + (size_t)l * 3 * NUP, F.gin(17) + (size_t)l * NUP, (PG8_LAS float*)(F.ldsp + 131072)}, G, c);
#endif
        return;
    }
    if (s == 15 && l == 1) {
        run_gemm(F.ldsp, pg8::Gemm{F.gact(), F.wl(l, W_DN), M, DM, DFF, DFF, 128, 0},
                 pg8::EpiFinal{(const float*)F.h(), F.h(), F.gin(19), F.ssqh(), (unsigned*)(F.ws + WS_CTL + 32768), (PG8_LAS unsigned*)(F.ldsp + 131072)}, G, c);
        return;
    }
    if (s == 15) { run_gemm(F.ldsp, pg8::Gemm{F.gact(), F.wl(l, W_DN), M, DM, DFF, DFF, 128, 0}, pg8::EpiG<pg8::EM_RES, 1>{F.hb(), DM, DM, nullptr, 0, nullptr, F.h(), F.ssqh(), (const float*)F.h()}, G, c); return; }
}

__global__ void __launch_bounds__(NT, 2) mk(Params p) {
    extern __shared__ __attribute__((aligned(16))) unsigned char lds_raw[];
    float* smem = (float*)lds_raw;
    cg::grid_group grid = cg::this_grid();
    Frame F; F.kp = (const Params __attribute__((address_space(4)))*)__builtin_amdgcn_kernarg_segment_ptr(); F.ws = p.ws; F.smem = smem; F.ldsp = (PG8_LAS unsigned char*)lds_raw; F.tid = threadIdx.x; F.lane = F.tid & 63; F.wave = F.tid >> 6;
    F.gw = blockIdx.x * 8 + F.wave; F.ngw = gridDim.x * 8;
    if (threadIdx.x < 2) ((PG8_LAS unsigned*)(F.ldsp + LDS_ST))[threadIdx.x] = 0u;
    __syncthreads();
    XcdBarrier bar = xcd_barrier_post((unsigned*)(p.ws + WS_CTL + 1024), (volatile PG8_LAS unsigned*)(F.ldsp + LDS_ST));
    for (int ph = p.ph_lo; ph < p.ph_hi; ++ph) {
        { __attribute__((address_space(1))) unsigned char* wsg = (__attribute__((address_space(1))) unsigned char*)F.ws; asm volatile("" : "+s"(wsg), "+s"(F.kp)); F.ws = (unsigned char*)wsg; }
        { int t_ = threadIdx.x; asm volatile("" : "+v"(t_)); F.tid = t_; F.lane = t_ & 63; F.wave = t_ >> 6; F.gw = blockIdx.x * 8 + F.wave; }
        run_phase(F, ph);
        if (ph + 1 < p.ph_hi) {
            if (ph < 0) grid.sync();
            xcd_barrier(bar);
        }
    }
}

extern "C" void kernel_launch(void* const* d_in, const int* in_sizes, int n_in, void* d_out, int out_size, void* d_ws, size_t ws_size, hipStream_t stream) {
    if (n_in != 20 || ws_size < WS_ENDALL) { fprintf(stderr, "kernel_launch: unexpected n_in %d / ws %zu\n", n_in, ws_size); return; }
    static int grid_blocks = 0;
    if (!grid_blocks) {
        int dev = 0, cus = 0, per_cu = 0;
        hipGetDevice(&dev);
        hipDeviceGetAttribute(&cus, hipDeviceAttributeMultiprocessorCount, dev);
        hipFuncSetAttribute((const void*)mk, hipFuncAttributeMaxDynamicSharedMemorySize, LDS_BYTES);
        hipOccupancyMaxActiveBlocksPerMultiprocessor(&per_cu, mk, NT, LDS_BYTES);
        if (per_cu < 1) per_cu = 1;
        if (per_cu > 1) per_cu = 1;
        grid_blocks = cus * per_cu;
    }
    Params p{};
    for (int i = 0; i < 20; ++i) p.in[i] = (const float*)d_in[i];
    p.out = (float*)d_out; p.ws = (unsigned char*)d_ws;
    {
        p.ph_lo = 0; p.ph_hi = NPH;
        hipMemsetAsync((char*)d_ws + WS_CTL, 0, 65536, stream);
        void* args[] = {&p};
        hipError_t e = hipLaunchCooperativeKernel((void*)mk, dim3(grid_blocks), dim3(NT), args, LDS_BYTES, stream);
        if (e != hipSuccess) { fprintf(stderr, "cooperative launch failed: %s (grid %d)\n", hipGetErrorString(e), grid_blocks); }
    }
}
```

```cpp
#include <hip/hip_runtime.h>
#include <hip/hip_cooperative_groups.h>
#include <stdint.h>
#include <cstdio>
namespace cg = cooperative_groups;

#define DI __device__ __forceinline__
typedef unsigned short bf16_t;
typedef short bf16x8 __attribute__((ext_vector_type(8)));
typedef float f32x4 __attribute__((ext_vector_type(4)));
typedef float f32x16 __attribute__((ext_vector_type(16)));
typedef unsigned u32x2 __attribute__((ext_vector_type(2)));
typedef unsigned u32x4 __attribute__((ext_vector_type(4)));
#define MFMA32(a, b, c) __builtin_amdgcn_mfma_f32_32x32x16_bf16((a), (b), (c), 0, 0, 0)

constexpr int NB = 4, S = 4096, M = NB * S, DM = 1024, ZP = 2048, NT = 512;
constexpr int DFF = 2816, NUP = 2 * DFF;
constexpr float EPS = 1e-6f;
constexpr int LDS_BYTES = 147456, LDS_ST = LDS_BYTES - 64;
constexpr int Z_CQ = 0, Z_KR = 384, Z_GT = 416, Z_CKV = 512, Z_QN = 768, Z_KC = 1280, Z_KS = 1408, Z_KW = 1536, Z_VC = 1664, Z_VS = 1792, Z_VW = 1920;
constexpr size_t MiB = 1024 * 1024;
constexpr size_t W_IN = 0, W_UQ = W_IN + (size_t)2048 * 1024 * 2, W_UKV = W_UQ + (size_t)768 * 384 * 2, W_C1K = W_UKV + (size_t)1024 * 256 * 2,
                 W_C1V = W_C1K + (size_t)256 * 2048 * 2, W_C2K = W_C1V + (size_t)256 * 2048 * 2, W_C2V = W_C2K + (size_t)256 * 128 * 2,
                 W_O = W_C2V + (size_t)256 * 128 * 2, W_UP = W_O + (size_t)1024 * 1024 * 2, W_DN = W_UP + (size_t)NUP * 1024 * 2,
                 W_END = W_DN + (size_t)1024 * DFF * 2;
constexpr size_t WL_STRIDE = 26 * MiB;
static_assert(W_END <= WL_STRIDE, "weights per layer");
constexpr size_t WS_A = 52 * MiB;
constexpr size_t WS_Z = WS_A, WS_Q = WS_A + 64 * MiB + 256 * 1024, WS_GACT = WS_A;
constexpr size_t WS_KV = 141 * MiB, WS_MIX = 173 * MiB, WS_HU = WS_KV;
constexpr size_t WS_HB = 205 * MiB + 64 * 1024;
constexpr size_t WS_MISC = 238 * MiB;
constexpr size_t WS_SSQH = WS_MISC, WS_SSQZ = WS_SSQH + 1 * MiB, WS_KR = WS_SSQZ + 2 * MiB, WS_HIDK = WS_KR + 1 * MiB, WS_HIDV = WS_HIDK + 1 * MiB,
                 WS_KCMP = WS_HIDV + 1 * MiB, WS_VCMP = WS_KCMP + 1 * MiB, WS_ROPE = WS_VCMP + 1 * MiB, WS_B1 = WS_ROPE + 1 * MiB, WS_CTL = WS_B1 + 64 * 1024,
                 WS_ENDALL = WS_CTL + 64 * 1024;
static_assert(WS_ENDALL <= 256 * MiB, "workspace");

struct Params {
    const float* in[20];
    float* out;
    unsigned char* ws;
    int ph_lo, ph_hi;
};

DI bf16_t f2bf(float x) { unsigned u = __float_as_uint(x); u += 0x7fffu + ((u >> 16) & 1u); return (bf16_t)(u >> 16); }
DI int tid_now() { int t = threadIdx.x; asm volatile("" : "+v"(t)); return t; }
DI float bf2f(bf16_t b) { return __uint_as_float(((unsigned)b) << 16); }
DI unsigned pk2(float lo, float hi) { return (unsigned)f2bf(lo) | ((unsigned)f2bf(hi) << 16); }
DI float wave_sum(float v) {
#pragma unroll
    for (int o = 1; o < 64; o <<= 1) v += __shfl_xor(v, o);
    return v;
}
DI float wave_max(float v) {
#pragma unroll
    for (int o = 1; o < 64; o <<= 1) v = fmaxf(v, __shfl_xor(v, o));
    return v;
}
DI float gelu_tanh(float x) { return 0.5f * x * (1.f + tanhf(0.7978845608028654f * (x + 0.044715f * x * x * x))); }
DI float rstd_h(const float* ssqh, int row) {
    const f32x4* p = (const f32x4*)(ssqh + (size_t)row * 16); float s = 0.f;
#pragma unroll
    for (int i = 0; i < 4; ++i) { f32x4 v = p[i]; s += (v[0] + v[1]) + (v[2] + v[3]); }
    return rsqrtf(s * (1.f / 1024.f) + EPS);
}
DI float rstd_q(const float* ssqz, int row) {
    const f32x4* p = (const f32x4*)(ssqz + (size_t)row * 24); float s = 0.f;
#pragma unroll
    for (int i = 0; i < 3; ++i) { f32x4 v = p[i]; s += (v[0] + v[1]) + (v[2] + v[3]); }
    return rsqrtf(s * (1.f / 384.f) + EPS);
}
DI float rstd_kv(const float* ssqz, int row) {
    const f32x4* p = (const f32x4*)(ssqz + (size_t)row * 24 + 16); float s = 0.f;
#pragma unroll
    for (int i = 0; i < 2; ++i) { f32x4 v = p[i]; s += (v[0] + v[1]) + (v[2] + v[3]); }
    return rsqrtf(s * (1.f / 256.f) + EPS);
}

namespace pg8 {
#define PG8_LAS __attribute__((address_space(3)))
typedef unsigned short bf16_t;
typedef short bf16x8 __attribute__((ext_vector_type(8)));
typedef float f32x4 __attribute__((ext_vector_type(4)));
typedef unsigned u32x4 __attribute__((ext_vector_type(4)));
constexpr int BM = 256, BK = 64, HALF = 128, HTB = HALF * BK * 2  , STAGE_BYTES = 8 * HTB, NXCD = 8, WGM = 8;

__host__ __device__ __forceinline__ int lds_byte(int r, int c) { const int st = (r >> 4) * 2 + (c >> 5), rr = r & 15, cc = c & 31, ob = rr * 64 + cc * 2; return st * 1024 + (ob ^ (((ob >> 9) & 1) << 5)); }
__host__ __device__ __forceinline__ void stage_rc(int b, int& R, int& C) { const int st = b / 1024, sb = b % 1024, swz = sb ^ (((sb >> 9) & 1) << 5); R = (st >> 1) * 16 + swz / 64; C = (st & 1) * 32 + (swz % 64) / 2; }
__host__ __device__ __forceinline__ int perm32(int rho) { const int n = rho >> 4, i = rho & 15; return 8 * (i >> 2) + 4 * n + (i & 3); }

struct Unit { int pm, pn; };
struct Gemm { const bf16_t* A; const bf16_t* Bt; int M, N, K; int lda; int kstepA; int cmp; };
__device__ __forceinline__ long long tileA_off(const Gemm& g, int pm) {
    if (g.cmp == 1) return (long long)(pm >> 1) * ((long long)4096 * 2048 * 2) + (long long)(pm & 1) * 128;
    if (g.cmp == 2) return ((long long)(pm / 17) * 4096 + 254 * (pm % 17) - 2) * (long long)(g.lda * 2);
    return (long long)pm * ((long long)BM * g.lda * 2); }

struct StaticOrder {
    int nM, nN, nwg, G, c;
    __host__ __device__ void init(int M, int N, int G_, int c_) { nM = M / BM; nN = N / BM; nwg = nM * nN; G = G_; c = c_; }
    __host__ __device__ bool next(int i, Unit& u) const {
        const long L = (long)i * G + c; if (L >= nwg) return false;
        int wgid = (int)L; { const int q = nwg / NXCD, r = nwg % NXCD, xcd = wgid % NXCD, off = wgid / NXCD; wgid = (xcd < r ? xcd * (q + 1) : r * (q + 1) + (xcd - r) * q) + off; }
        const int nig = WGM * nN, gid = wgid / nig, fm = gid * WGM, gsz = (nM - fm) < WGM ? (nM - fm) : WGM;
        u.pm = fm + ((wgid % nig) % gsz); u.pn = (wgid % nig) / gsz; return true;
    }
    __device__ __forceinline__ void a_ready(const Unit&) const {}
    __device__ __forceinline__ void done(const Unit&) const {}
};
__device__ __forceinline__ unsigned cvt_pk_bf16(float lo, float hi) { unsigned r; asm volatile("v_cvt_pk_bf16_f32 %0, %1, %2" : "=v"(r) : "v"(lo), "v"(hi)); return r; }
template <class Epi, class Sched, bool ALIGN_EPI = false, bool SP2 = false>
__device__ __forceinline__ void gemm_phase(PG8_LAS unsigned char* lds, const Gemm g, const Sched& S, const Epi& E) {
    int tid_ = threadIdx.x; asm volatile("" : "+v"(tid_));
    const int tid = tid_, wid = __builtin_amdgcn_readfirstlane(tid >> 6), lane = tid & 63, wr = wid >> 2, wc = wid & 3, fr = lane & 15, fq = lane >> 4;
    const int K = g.K, nt = K / BK;
    unsigned voffA[2], voffB[2];
#pragma unroll
    for (int i = 0; i < 2; ++i) { int R, C; stage_rc(tid * 16 + i * 8192, R, C); const int Rb = Epi::PERM ? ((R & ~31) + perm32(R & 31)) : R;
        voffA[i] = (unsigned)(R * g.lda + C) * 2u; voffB[i] = (unsigned)(Rb * K + C) * 2u; }
    const size_t kstepB = (size_t)(BK * 2), kstepA = (size_t)g.kstepA;
    const size_t hstepB = (size_t)HALF * K * 2, hstepA = (size_t)HALF * g.lda * 2;
    const size_t tstepB = 2 * hstepB;
    const unsigned ldsw = (unsigned)wid * 1024u;
    const int aoff = lds_byte(wr * 64 + fr, fq * 8), boff = lds_byte(wc * 32 + fr, fq * 8);
#define PG8_SA(b, h) (((b) * 2 + (h)) * HTB)
#define PG8_SB(b, h) ((4 + (b) * 2 + (h)) * HTB)
#define PG8_STAGE(bufoff, gbase, voff) do { _Pragma("unroll") for (int _i = 0; _i < 2; ++_i) \
        __builtin_amdgcn_global_load_lds((const unsigned*)((const char*)(gbase) + (voff)[_i]), (PG8_LAS unsigned*)(lds + (bufoff) + ldsw + _i * 8192), 16, 0, 0); } while (0)
#define PG8_LDA(dst, b, h) do { _Pragma("unroll") for (int m = 0; m < 4; ++m) _Pragma("unroll") for (int k = 0; k < 2; ++k) dst[m][k] = *(const PG8_LAS bf16x8*)(lds + PG8_SA(b, h) + aoff + m * 2048 + k * 1024); } while (0)
#define PG8_LDB(dst, b, h) do { _Pragma("unroll") for (int n = 0; n < 2; ++n) _Pragma("unroll") for (int k = 0; k < 2; ++k) dst[n][k] = *(const PG8_LAS bf16x8*)(lds + PG8_SB(b, h) + boff + n * 2048 + k * 1024); } while (0)
#define PG8_MMA(ai, bj, At, Bt) do { __builtin_amdgcn_s_setprio(1); _Pragma("unroll") for (int m = 0; m < 4; ++m) _Pragma("unroll") for (int n = 0; n < 2; ++n) _Pragma("unroll") for (int k = 0; k < 2; ++k) \
        acc[ai][bj][m][n] = __builtin_amdgcn_mfma_f32_16x16x32_bf16(Bt[n][k], At[m][k], acc[ai][bj][m][n], 0, 0, 0); __builtin_amdgcn_s_setprio(0); } while (0)
#define PG8_WAIT_V(n) asm volatile("s_waitcnt vmcnt(" #n ")" ::: "memory")
#define PG8_WAIT_L(n) asm volatile("s_waitcnt lgkmcnt(" #n ")" ::: "memory")
#define PG8_BAR __builtin_amdgcn_s_barrier()
#define PG8_SCHED __builtin_amdgcn_sched_barrier(0)
    Unit cur, nxt; int ui = 0;
    if (!S.next(0, cur)) return;
    f32x4 acc[2][2][4][2];
#pragma unroll
    for (int a = 0; a < 2; ++a)
#pragma unroll
        for (int b = 0; b < 2; ++b)
#pragma unroll
            for (int m = 0; m < 4; ++m)
#pragma unroll
                for (int n = 0; n < 2; ++n) acc[a][b][m][n] = (f32x4){0.f, 0.f, 0.f, 0.f};
    bf16x8 At[4][2], B0[2][2], B1[2][2];
    const char* cA = (const char*)g.A + tileA_off(g, cur.pm); const char* cB = (const char*)g.Bt + (size_t)cur.pn * tstepB;
    S.a_ready(cur);
    if constexpr (SP2) {
        PG8_STAGE(PG8_SB(0, 0), cB, voffB); PG8_STAGE(PG8_SB(0, 1), cB + hstepB, voffB); PG8_STAGE(PG8_SA(0, 0), cA, voffA); PG8_STAGE(PG8_SA(0, 1), cA + hstepA, voffA);
        if (wr == 1) PG8_BAR;
        PG8_WAIT_V(2); PG8_BAR;
        PG8_STAGE(PG8_SB(1, 0), cB + kstepB, voffB); PG8_STAGE(PG8_SA(1, 0), cA + kstepA, voffA); PG8_STAGE(PG8_SB(1, 1), cB + hstepB + kstepB, voffB);
        PG8_WAIT_V(6); PG8_BAR;
    } else {
        PG8_STAGE(PG8_SB(0, 0), cB, voffB); PG8_STAGE(PG8_SA(0, 0), cA, voffA); PG8_STAGE(PG8_SB(0, 1), cB + hstepB, voffB); PG8_STAGE(PG8_SA(0, 1), cA + hstepA, voffA);
        if (wr == 1) PG8_BAR;
        PG8_WAIT_V(4); PG8_BAR;
        PG8_STAGE(PG8_SB(1, 0), cB + kstepB, voffB); PG8_STAGE(PG8_SA(1, 0), cA + kstepA, voffA); PG8_STAGE(PG8_SB(1, 1), cB + hstepB + kstepB, voffB);
        PG8_WAIT_V(6); PG8_BAR;
    }
    for (;;) {
        const bool has_next = S.next(ui + 1, nxt);
        const char* nA = has_next ? (const char*)g.A + tileA_off(g, nxt.pm) : cA; const char* nB = has_next ? (const char*)g.Bt + (size_t)nxt.pn * tstepB : cB;
        for (int t = 0; t < nt; t += 2) {
            const bool last = (t == nt - 2);
            const char* a1 = cA + (size_t)(t + 1) * kstepA;
            const char* a2 = last ? nA : cA + (size_t)(t + 2) * kstepA; const char* b2 = last ? nB : cB + (size_t)(t + 2) * kstepB;
            const char* a3 = a2 + kstepA; const char* b3 = b2 + kstepB;
            if (last && has_next) S.a_ready(nxt);
            if constexpr (SP2) {
            PG8_LDB(B0, 0, 0); PG8_LDB(B1, 0, 1); PG8_SCHED; PG8_LDA(At, 0, 0); PG8_STAGE(PG8_SA(1, 1), a1 + hstepA, voffA);
            PG8_WAIT_V(8); PG8_WAIT_L(0); PG8_BAR; PG8_MMA(0, 0, At, B0); PG8_MMA(0, 1, At, B1); PG8_BAR; PG8_SCHED;
            PG8_LDA(At, 0, 1); PG8_STAGE(PG8_SB(0, 0), b2, voffB); PG8_STAGE(PG8_SB(0, 1), b2 + hstepB, voffB); PG8_STAGE(PG8_SA(0, 0), a2, voffA);
            PG8_WAIT_V(8); PG8_WAIT_L(0); PG8_BAR; PG8_MMA(1, 0, At, B0); PG8_MMA(1, 1, At, B1); PG8_BAR; PG8_SCHED;
            PG8_LDB(B0, 1, 0); PG8_LDB(B1, 1, 1); PG8_SCHED; PG8_LDA(At, 1, 0); PG8_STAGE(PG8_SA(0, 1), a2 + hstepA, voffA);
            PG8_WAIT_V(8); PG8_WAIT_L(0); PG8_BAR; PG8_MMA(0, 0, At, B0); PG8_MMA(0, 1, At, B1); PG8_BAR; PG8_SCHED;
            PG8_LDA(At, 1, 1); PG8_STAGE(PG8_SB(1, 0), b3, voffB); PG8_STAGE(PG8_SB(1, 1), b3 + hstepB, voffB); PG8_STAGE(PG8_SA(1, 0), a3, voffA);
            PG8_WAIT_V(8); PG8_WAIT_L(0); PG8_BAR; PG8_MMA(1, 0, At, B0); PG8_MMA(1, 1, At, B1); PG8_BAR; PG8_SCHED;
            } else {
            PG8_LDB(B0, 0, 0); PG8_SCHED; PG8_LDA(At, 0, 0); PG8_STAGE(PG8_SA(1, 1), a1 + hstepA, voffA);
            PG8_WAIT_L(8); PG8_BAR; PG8_WAIT_L(0); PG8_MMA(0, 0, At, B0); PG8_BAR; PG8_SCHED;
            PG8_LDB(B1, 0, 1); PG8_STAGE(PG8_SB(0, 0), b2, voffB);
            PG8_BAR; PG8_WAIT_L(0); PG8_MMA(0, 1, At, B1); PG8_BAR;
            PG8_LDA(At, 0, 1); PG8_STAGE(PG8_SA(0, 0), a2, voffA);
            PG8_BAR; PG8_WAIT_L(0); PG8_MMA(1, 0, At, B0); PG8_BAR; PG8_SCHED;
            PG8_STAGE(PG8_SB(0, 1), b2 + hstepB, voffB);
            PG8_WAIT_V(6); PG8_BAR; PG8_MMA(1, 1, At, B1); PG8_BAR;
            PG8_LDB(B0, 1, 0); PG8_SCHED; PG8_LDA(At, 1, 0); PG8_STAGE(PG8_SA(0, 1), a2 + hstepA, voffA);
            PG8_WAIT_L(8); PG8_BAR; PG8_WAIT_L(0); PG8_MMA(0, 0, At, B0); PG8_BAR; PG8_SCHED;
            PG8_LDB(B1, 1, 1); PG8_STAGE(PG8_SB(1, 0), b3, voffB);
            PG8_BAR; PG8_WAIT_L(0); PG8_MMA(0, 1, At, B1); PG8_BAR;
            PG8_LDA(At, 1, 1); PG8_STAGE(PG8_SA(1, 0), a3, voffA);
            PG8_BAR; PG8_WAIT_L(0); PG8_MMA(1, 0, At, B0); PG8_BAR; PG8_SCHED;
            PG8_STAGE(PG8_SB(1, 1), b3 + hstepB, voffB);
            PG8_WAIT_V(6); PG8_BAR; PG8_MMA(1, 1, At, B1); PG8_BAR;
            }
        }
        if constexpr (ALIGN_EPI) { if (wr == 0) PG8_BAR; }
        if constexpr (!Epi::AFTER_DRAIN) { E(acc, cur, wr, wc, fr, fq); S.done(cur); }
        if (!has_next) break;
#pragma unroll
        for (int a = 0; a < 2; ++a)
#pragma unroll
            for (int b = 0; b < 2; ++b)
#pragma unroll
                for (int m = 0; m < 4; ++m)
#pragma unroll
                    for (int n = 0; n < 2; ++n) acc[a][b][m][n] = (f32x4){0.f, 0.f, 0.f, 0.f};
        cur = nxt; cA = nA; cB = nB; ++ui;
        if constexpr (ALIGN_EPI) { if (wr == 1) PG8_BAR; }
    }
    PG8_WAIT_V(0);
    if constexpr (!ALIGN_EPI) { if (wr == 0) PG8_BAR; }
    PG8_BAR;
    if constexpr (Epi::AFTER_DRAIN) { E.fused(acc, cur, wr, wc, fr, fq, lds, wid, lane); S.done(cur); }
#undef PG8_SA
#undef PG8_SB
#undef PG8_STAGE
#undef PG8_LDA
#undef PG8_LDB
#undef PG8_MMA
#undef PG8_WAIT_V
#undef PG8_WAIT_L
#undef PG8_BAR
#undef PG8_SCHED
}
}

namespace pg8 {
enum { EM_SCALEH = 0, EM_SCALEQ = 1, EM_SCALEKV = 2, EM_GELU = 3, EM_PLAIN = 4, EM_RES = 5 };
template <int MODE, int STATS  > struct EpiG {
    static constexpr bool PERM = true, AFTER_DRAIN = false;
    bf16_t* O; int ldc; int nvalid; const float* ssq_in; int rowoff; const float* bias; float* H; float* ssq_out; const float* Hin;
    __device__ __forceinline__ void operator()(const f32x4 (&acc)[2][2][4][2], const Unit& u, int wr, int wc, int fr, int fq) const {
        const int row0 = u.pm * BM + wr * 64 + fr, col0 = u.pn * BM + wc * 32 + 8 * fq;
#pragma unroll
        for (int ai = 0; ai < 2; ++ai)
#pragma unroll
            for (int m = 0; m < 4; ++m) {
                const int row = row0 + ai * HALF + m * 16;
                float sc = 1.f;
                if (MODE == EM_SCALEH) sc = ::rstd_h(ssq_in, row + rowoff);
                if (MODE == EM_SCALEQ) sc = ::rstd_q(ssq_in, row);
                if (MODE == EM_SCALEKV) sc = ::rstd_kv(ssq_in, row);
                float ss[2] = {0.f, 0.f};
#pragma unroll
                for (int bj = 0; bj < 2; ++bj) {
                    const int col = col0 + bj * HALF;
                    f32x4 v0 = acc[ai][bj][m][0] * sc, v1 = acc[ai][bj][m][1] * sc;
                    if (MODE == EM_GELU) { if (col < nvalid) { const f32x4 b0 = *(const f32x4*)(bias + col), b1 = *(const f32x4*)(bias + col + 4);
#pragma unroll
                        for (int i = 0; i < 4; ++i) { v0[i] = ::gelu_tanh(v0[i] + b0[i]); v1[i] = ::gelu_tanh(v1[i] + b1[i]); } } }
                    if (MODE == EM_RES) { const f32x4* hi = (const f32x4*)(Hin + (size_t)row * 1024 + col); f32x4* hp = (f32x4*)(H + (size_t)row * 1024 + col); v0 += hi[0]; v1 += hi[1]; hp[0] = v0; hp[1] = v1; }
                    if (STATS) ss[bj] = ((v0[0] * v0[0] + v0[1] * v0[1]) + (v0[2] * v0[2] + v0[3] * v0[3])) + ((v1[0] * v1[0] + v1[1] * v1[1]) + (v1[2] * v1[2] + v1[3] * v1[3]));
                    if (col < nvalid) { u32x4 w; w.x = cvt_pk_bf16(v0[0], v0[1]); w.y = cvt_pk_bf16(v0[2], v0[3]); w.z = cvt_pk_bf16(v1[0], v1[1]); w.w = cvt_pk_bf16(v1[2], v1[3]);
                        *(u32x4*)(O + (size_t)row * ldc + col) = w; }
                }
                if (STATS == 1) { float t = ss[0] + ss[1]; t += __shfl_xor(t, 16); t += __shfl_xor(t, 32); if (fq == 0) ssq_out[(size_t)row * 16 + u.pn * 4 + wc] = t; }
                if (STATS == 2) { if (u.pn <= 2) { float t0 = ss[0], t1 = ss[1]; t0 += __shfl_xor(t0, 16); t0 += __shfl_xor(t0, 32); t1 += __shfl_xor(t1, 16); t1 += __shfl_xor(t1, 32);
                    if (fq == 0) { ssq_out[(size_t)row * 24 + u.pn * 8 + wc] = t0; ssq_out[(size_t)row * 24 + u.pn * 8 + 4 + wc] = t1; } } }
            }
    }
};

typedef unsigned u32x2_t __attribute__((ext_vector_type(2)));
template <int CTRL> __device__ __forceinline__ float dppf(float v) { return __int_as_float(__builtin_amdgcn_update_dpp(0, __float_as_int(v), CTRL, 0xf, 0xf, true)); }
#define DPPF(v, ctrl) dppf<ctrl>(v)
template <int STRIDE> struct EpiConv {
    static constexpr bool PERM = true, AFTER_DRAIN = false;
    bf16_t* Gt; const float* ssqh; const float* cw; const float* cb; PG8_LAS float* xch;
    __device__ __forceinline__ void operator()(f32x4 (&acc)[2][2][4][2], const Unit& u, int wr, int wc, int fr_in, int fq_in) const {
        int fr = fr_in, fq = fq_in; asm volatile("" : "+v"(fr), "+v"(fq));
        const int b = STRIDE == 254 ? u.pm / 17 : u.pm / 16, tl0 = STRIDE == 254 ? 254 * (u.pm % 17) - 2 : 256 * (u.pm % 16), wid = wr * 4 + wc;
#pragma unroll
        for (int ai = 0; ai < 2; ++ai)
#pragma unroll
            for (int m = 0; m < 4; ++m) {
                const int tl = tl0 + ai * HALF + wr * 64 + m * 16 + fr; float sc = 0.f;
                if (tl >= 0 && tl < 4096) sc = ::rstd_h(ssqh, b * 4096 + tl);
#pragma unroll
                for (int bj = 0; bj < 2; ++bj)
#pragma unroll
                    for (int n = 0; n < 2; ++n) acc[ai][bj][m][n] *= sc;
            }
        if (fr >= 14) {
#pragma unroll
            for (int ai = 0; ai < 2; ++ai)
#pragma unroll
                for (int bj = 0; bj < 2; ++bj)
#pragma unroll
                    for (int n = 0; n < 2; ++n) *(PG8_LAS f32x4*)(xch + ((((wid * 2 + ai) * 4 + fq) * 2 + (fr - 14)) * 4 + bj * 2 + n) * 4) = acc[ai][bj][3][n];
        }
        asm volatile("s_waitcnt lgkmcnt(0)" ::: "memory"); __builtin_amdgcn_s_barrier(); asm volatile("" ::: "memory");
        const int chl = u.pn * 128 + wc * 32 + 8 * fq;
#pragma unroll
        for (int n = 0; n < 2; ++n) {
            const int ch = chl + 4 * n;
            const float* cwv = cw + ch; const float* cbv = cb + ch; asm volatile("" : "+v"(cwv), "+v"(cbv));
            const f32x4 wg0 = *(const f32x4*)(cwv), wg1 = *(const f32x4*)(cwv + 5632), wg2 = *(const f32x4*)(cwv + 2 * 5632), bg = *(const f32x4*)(cbv);
            const f32x4 wu0 = *(const f32x4*)(cwv + 2816), wu1 = *(const f32x4*)(cwv + 5632 + 2816), wu2 = *(const f32x4*)(cwv + 2 * 5632 + 2816), bu = *(const f32x4*)(cbv + 2816);
#pragma unroll
            for (int ai = 0; ai < 2; ++ai)
#pragma unroll
                for (int m = 0; m < 4; ++m) {
                    f32x4 pg = {0.f, 0.f, 0.f, 0.f}, pu = {0.f, 0.f, 0.f, 0.f};
                    if (m > 0) { pg = acc[ai][0][m - 1][n]; pu = acc[ai][1][m - 1][n]; }
                    else if (wr == 1 || ai == 1) {
                        const int sw = (wr == 1 ? 0 : 4) + wc, sai = wr == 1 ? ai : 0;
                        if (fr >= 14) { const PG8_LAS float* xp = xch + ((((sw * 2 + sai) * 4 + fq) * 2 + (fr - 14)) * 4 + n) * 4; pg = *(const PG8_LAS f32x4*)xp; pu = *(const PG8_LAS f32x4*)(xp + 8); }
                    }
                    const f32x4 cg = acc[ai][0][m][n], cu = acc[ai][1][m][n];
                    f32x4 o;
#pragma unroll
                    for (int k = 0; k < 4; ++k) {
                        float hg = fmaf(wg2[k], cg[k], bg[k]), hu = fmaf(wu2[k], cu[k], bu[k]);
                        {
                            const float cgk = cg[k], pgk = pg[k], cuk = cu[k], puk = pu[k], g1w = wg1[k], g0w = wg0[k], u1w = wu1[k], u0w = wu0[k];
                            asm volatile("s_nop 1\n\t"
                                         "v_fmac_f32_dpp %0, %2, %4 row_shr:1 row_mask:0xf bank_mask:0xf bound_ctrl:1\n\t"
                                         "v_fmac_f32_dpp %1, %6, %8 row_shr:1 row_mask:0xf bank_mask:0xf bound_ctrl:1\n\t"
                                         "v_fmac_f32_dpp %0, %3, %4 row_shl:15 row_mask:0xf bank_mask:0xf bound_ctrl:1\n\t"
                                         "v_fmac_f32_dpp %1, %7, %8 row_shl:15 row_mask:0xf bank_mask:0xf bound_ctrl:1\n\t"
                                         "v_fmac_f32_dpp %0, %2, %5 row_shr:2 row_mask:0xf bank_mask:0xf bound_ctrl:1\n\t"
                                         "v_fmac_f32_dpp %1, %6, %9 row_shr:2 row_mask:0xf bank_mask:0xf bound_ctrl:1\n\t"
                                         "v_fmac_f32_dpp %0, %3, %5 row_shl:14 row_mask:0xf bank_mask:0xf bound_ctrl:1\n\t"
                                         "v_fmac_f32_dpp %1, %7, %9 row_shl:14 row_mask:0xf bank_mask:0xf bound_ctrl:1"
                                         : "+v"(hg), "+v"(hu) : "v"(cgk), "v"(pgk), "v"(g1w), "v"(g0w), "v"(cuk), "v"(puk), "v"(u1w), "v"(u0w));
                        }
                        o[k] = hg * __builtin_amdgcn_rcpf(1.f + __builtin_amdgcn_exp2f(-1.4426950408889634f * hg)) * hu;
                    }
                    const int lr = ai * HALF + wr * 64 + m * 16 + fr, tl = tl0 + lr;
                    if (lr >= (STRIDE == 254 ? 2 : 0) && tl < 4096) { u32x2_t w; w.x = cvt_pk_bf16(o[0], o[1]); w.y = cvt_pk_bf16(o[2], o[3]); *(u32x2_t*)(Gt + (size_t)(b * 4096 + tl) * 2816 + ch) = w; }
                }
        }
    }
};

struct EpiFinal {
    static constexpr bool PERM = true, AFTER_DRAIN = false;
    const float* Hin; float* Out; const float* gain; float* part; unsigned* cnt; PG8_LAS unsigned* flag;
    __device__ __forceinline__ void operator()(f32x4 (&acc)[2][2][4][2], const Unit& u, int wr, int wc, int fr, int fq) const {
        const int row0 = u.pm * BM + wr * 64 + fr, col0 = u.pn * BM + wc * 32 + 8 * fq;
#pragma unroll
        for (int ai = 0; ai < 2; ++ai)
#pragma unroll
            for (int m = 0; m < 4; ++m) {
                const int row = row0 + ai * HALF + m * 16; float ss = 0.f;
#pragma unroll
                for (int bj = 0; bj < 2; ++bj) { const f32x4* hi = (const f32x4*)(Hin + (size_t)row * 1024 + col0 + bj * HALF);
                    const f32x4 v0 = acc[ai][bj][m][0] + hi[0], v1 = acc[ai][bj][m][1] + hi[1]; acc[ai][bj][m][0] = v0; acc[ai][bj][m][1] = v1;
                    ss += ((v0[0] * v0[0] + v0[1] * v0[1]) + (v0[2] * v0[2] + v0[3] * v0[3])) + ((v1[0] * v1[0] + v1[1] * v1[1]) + (v1[2] * v1[2] + v1[3] * v1[3])); }
                ss += __shfl_xor(ss, 16); ss += __shfl_xor(ss, 32);
                if (fq == 0) __hip_atomic_store(part + (size_t)row * 16 + u.pn * 4 + wc, ss, __ATOMIC_RELAXED, __HIP_MEMORY_SCOPE_AGENT);
            }
        asm volatile("s_waitcnt vmcnt(0)" ::: "memory");
        unsigned* pc = cnt + 16 * u.pm;
        if (fr == 0 && fq == 0) __hip_atomic_fetch_add(pc, 1u, __ATOMIC_RELAXED, __HIP_MEMORY_SCOPE_AGENT);
        if (wr == 0 && wc == 0) {
            unsigned spins = 0;
            while (__hip_atomic_load(pc, __ATOMIC_RELAXED, __HIP_MEMORY_SCOPE_AGENT) < 32u && ++spins < (1u << 22)) __builtin_amdgcn_s_sleep(2);
        }
        asm volatile("s_waitcnt vmcnt(0) lgkmcnt(0)" ::: "memory"); __builtin_amdgcn_s_barrier(); asm volatile("" ::: "memory");
        __builtin_amdgcn_fence(__ATOMIC_ACQUIRE, "agent");
#pragma unroll
        for (int ai = 0; ai < 2; ++ai)
#pragma unroll
            for (int m = 0; m < 4; ++m) {
                const int row = row0 + ai * HALF + m * 16; float sq = 0.f;
#pragma unroll
                for (int i = 0; i < 4; ++i) sq += __hip_atomic_load(part + (size_t)row * 16 + 4 * fq + i, __ATOMIC_RELAXED, __HIP_MEMORY_SCOPE_AGENT);
                sq += __shfl_xor(sq, 16); sq += __shfl_xor(sq, 32);
                const float rs = rsqrtf(sq * (1.f / 1024.f) + 1e-6f);
#pragma unroll
                for (int bj = 0; bj < 2; ++bj) { const int col = col0 + bj * HALF; const f32x4 g0 = *(const f32x4*)(gain + col), g1 = *(const f32x4*)(gain + col + 4);
                    f32x4* op = (f32x4*)(Out + (size_t)row * 1024 + col); op[0] = acc[ai][bj][m][0] * rs * g0; op[1] = acc[ai][bj][m][1] * rs * g1; }
            }
    }
};
}
template <class Epi> __device__ __forceinline__ void run_gemm(PG8_LAS unsigned char* lds, const pg8::Gemm& g, const Epi& E, int G, int c) {
    pg8::StaticOrder So; So.init(g.M, g.N, G, c);
    pg8::gemm_phase<Epi, pg8::StaticOrder, true, true>(lds, g, So, E);
}

struct MapZ { DI int operator()(int n) const {
    if (n < 384) return n; if (n < 416) return 640 + (n - 384); if (n < 440) return 1952 + (n - 416); if (n < 512) return -1;
    if (n < 768) return 384 + (n - 512); if (n < 1280) return 672 + (n - 768); if (n < 1408) return 1184 + (n - 1280);
    if (n < 1536) return 1440 + (n - 1408); if (n < 1664) return 1696 + (n - 1536); if (n < 1792) return 1312 + (n - 1664);
    if (n < 1920) return 1568 + (n - 1792); return 1824 + (n - 1920); } };
struct MapUQ { DI int operator()(int n) const { if (n < 512) return (n >> 6) * 96 + (n & 63); n -= 512; return (n >> 5) * 96 + 64 + (n & 31); } };
struct MapUKV { DI int operator()(int n) const { if (n < 512) return (n >> 6) * 128 + (n & 63); n -= 512; return (n >> 6) * 128 + 64 + (n & 63); } };
struct MapUP { DI int operator()(int n) const { const int pn = n >> 8, j = n & 255; return j < 128 ? 128 * pn + j : DFF + 128 * pn + (j - 128); } };
struct MapId { int nvalid; DI int operator()(int n) const { return n < nvalid ? n : -1; } };

template <class Map>
DI void wconv(const float* __restrict__ W, int K, int Nsrc, const float* __restrict__ gain, bf16_t* __restrict__ dst, int Ndst, Map map, float* tile) {
    const int nkt = K / 64, ntiles = nkt * (Ndst / 64); const int tid = tid_now();
    const int kk0 = tid >> 4, nn4 = (tid & 15) * 4, nw = tid >> 3, cw = tid & 7;
    int it = blockIdx.x; if (it >= ntiles) return;
    f32x4 a0, a1, b0 = {0.f, 0.f, 0.f, 0.f}, b1 = {0.f, 0.f, 0.f, 0.f};
#define WCONV_LOAD(IT, R0, R1) do { const int kt_ = (IT) % nkt, nt_ = (IT) / nkt, k0_ = kt_ * 64, n0_ = nt_ * 64; const int src_ = map(n0_ + nn4); \
        R0 = (f32x4){0.f, 0.f, 0.f, 0.f}; R1 = R0; \
        if (src_ >= 0) { R0 = *(const f32x4*)(W + (size_t)(k0_ + kk0) * Nsrc + src_); R1 = *(const f32x4*)(W + (size_t)(k0_ + kk0 + 32) * Nsrc + src_); \
            if (gain) { R0 *= gain[k0_ + kk0]; R1 *= gain[k0_ + kk0 + 32]; } } } while (0)
    WCONV_LOAD(it, a0, a1);
    for (;;) {
        const int nit = it + gridDim.x;
        __syncthreads();
#pragma unroll
        for (int e = 0; e < 4; ++e) { tile[kk0 * 65 + nn4 + e] = a0[e]; tile[(kk0 + 32) * 65 + nn4 + e] = a1[e]; }
        if (nit < ntiles) WCONV_LOAD(nit, b0, b1);
        __syncthreads();
        { const int kt = it % nkt, nt = it / nkt, k0 = kt * 64, n0 = nt * 64;
          const float* tp = tile + (8 * cw) * 65 + nw;
          u32x4 w; w.x = pk2(tp[0], tp[65]); w.y = pk2(tp[2 * 65], tp[3 * 65]); w.z = pk2(tp[4 * 65], tp[5 * 65]); w.w = pk2(tp[6 * 65], tp[7 * 65]);
          *(u32x4*)(dst + (size_t)(n0 + nw) * K + k0 + 8 * cw) = w; }
        if (nit >= ntiles) break;
        a0 = b0; a1 = b1; it = nit;
    }
#undef WCONV_LOAD
}

template <class AF, class Epi>
DI void ngemm(AF af, const bf16_t* __restrict__ Bt, int ldb, int Mr, int N, int K, Epi epi, bool local = false) {
    const int tid = tid_now(), lane = tid & 63, wv = tid >> 6, r = lane & 31, h = lane >> 5;
    const int ntn = N / 64, ntm = Mr / 64; const int gw = local ? wv : blockIdx.x * 8 + wv, ngw = local ? 8 : gridDim.x * 8;
    for (int t = gw; t < ntn * ntm; t += ngw) {
        const int tn = t % ntn, tm = t / ntn, m0 = tm * 64, n0 = tn * 64;
        f32x16 acc[2][2];
#pragma unroll
        for (int a = 0; a < 2; ++a)
#pragma unroll
            for (int b = 0; b < 2; ++b)
#pragma unroll
                for (int i = 0; i < 16; ++i) acc[a][b][i] = 0.f;
        for (int k0 = 0; k0 < K; k0 += 16) {
            bf16x8 a[2], b[2];
#pragma unroll
            for (int mi = 0; mi < 2; ++mi) a[mi] = *(const bf16x8*)af(m0 + mi * 32 + r, k0 + 8 * h);
#pragma unroll
            for (int ni = 0; ni < 2; ++ni) b[ni] = *(const bf16x8*)(Bt + (size_t)(n0 + ni * 32 + r) * ldb + k0 + 8 * h);
#pragma unroll
            for (int mi = 0; mi < 2; ++mi)
#pragma unroll
                for (int ni = 0; ni < 2; ++ni) acc[mi][ni] = MFMA32(b[ni], a[mi], acc[mi][ni]);
        }
#pragma unroll
        for (int mi = 0; mi < 2; ++mi) {
            const int row = m0 + mi * 32 + r; const float ctx = epi.prep(row);
#pragma unroll
            for (int ni = 0; ni < 2; ++ni)
#pragma unroll
                for (int g = 0; g < 4; ++g) {
                    f32x4 v = {acc[mi][ni][4 * g], acc[mi][ni][4 * g + 1], acc[mi][ni][4 * g + 2], acc[mi][ni][4 * g + 3]};
                    epi.store(row, n0 + ni * 32 + 8 * g + 4 * h, v, ctx);
                }
        }
    }
}
struct APlain { const bf16_t* A; size_t lda; DI const bf16_t* operator()(int row, int k) const { return A + (size_t)row * lda + k; } };
struct ACmp { const bf16_t* z; int col0; DI const bf16_t* operator()(int row, int k) const {
    const int bg = row >> 8, n = row & 255, b = bg >> 1, g = bg & 1; return z + (size_t)(b * S + 16 * n + (k >> 6)) * ZP + col0 + g * 64 + (k & 63); } };

DI void st_bf4(bf16_t* p, f32x4 v) { u32x2 w; w.x = pk2(v[0], v[1]); w.y = pk2(v[2], v[3]); *(u32x2*)p = w; }
struct EpiScaleH { bf16_t* O; int ldc; const float* ssqh; int rowoff;
    DI float prep(int row) const { return rstd_h(ssqh, row + rowoff); }
    DI void store(int row, int col, f32x4 v, float c) const { st_bf4(O + (size_t)row * ldc + col, v * c); } };
struct EpiScaleQ { bf16_t* O; int ldc; const float* ssqz; int kv;
    DI float prep(int row) const { return kv ? rstd_kv(ssqz, row) : rstd_q(ssqz, row); }
    DI void store(int row, int col, f32x4 v, float c) const { st_bf4(O + (size_t)row * ldc + col, v * c); } };
struct EpiGelu { bf16_t* O; int ldc; const float* bias;
    DI float prep(int) const { return 0.f; }
    DI void store(int row, int col, f32x4 v, float) const { f32x4 o; for (int i = 0; i < 4; ++i) o[i] = gelu_tanh(v[i] + bias[col + i]); st_bf4(O + (size_t)row * ldc + col, o); } };
struct EpiPlain { bf16_t* O; int ldc;
    DI float prep(int) const { return 0.f; }
    DI void store(int row, int col, f32x4 v, float) const { st_bf4(O + (size_t)row * ldc + col, v); } };
struct EpiRes { float* H; bf16_t* HB;
    DI float prep(int) const { return 0.f; }
    DI void store(int row, int col, f32x4 v, float) const { f32x4* hp = (f32x4*)(H + (size_t)row * DM + col); f32x4 o = *hp + v; *hp = o; st_bf4(HB + (size_t)row * DM + col, o); } };

#define LAS PG8_LAS
#define XB_TMO      128
#define XB_XCNT(j)  (256  + 64 * (j))
#define XB_XSUB(j)  (1280 + 64 * (j))
#define XB_XGEN(j)  (2304 + 64 * (j))
#define XB_TOP      3328
#define XB_TOPGEN   3392
#define XCD_BAR_WORDS 3456
#define XB_SPIN_CAP (1u << 22)

__device__ __forceinline__ unsigned xb_ld(unsigned* p)              { return __hip_atomic_load(p, __ATOMIC_RELAXED, __HIP_MEMORY_SCOPE_AGENT); }
__device__ __forceinline__ unsigned xb_add(unsigned* p, unsigned v) { return __hip_atomic_fetch_add(p, v, __ATOMIC_RELAXED, __HIP_MEMORY_SCOPE_AGENT); }
__device__ __forceinline__ unsigned xb_xcc_id() { return (unsigned)__builtin_amdgcn_s_getreg((3 << 11) | 20) & 0xFu; }
#define XB_SPIN(cond, bar) do { unsigned _sp = 0; while (cond) { __builtin_amdgcn_s_sleep(1); \
    if ((++_sp & 255u) == 0u) { if (xb_ld(&(bar)[XB_TMO])) break; if (_sp > XB_SPIN_CAP) { atomicAdd(&(bar)[XB_TMO], 1u); break; } } } } while (0)

struct XcdBarrier {
    unsigned* bar; unsigned x;
    volatile LAS unsigned* st;
};

__device__ __forceinline__ XcdBarrier xcd_barrier_post(unsigned* bar, volatile LAS unsigned* st) {
    XcdBarrier b; b.bar = bar; b.x = xb_xcc_id(); b.st = st;
    if (threadIdx.x == 0) (void)xb_add(&bar[XB_XCNT(b.x)], 1u);
    return b;
}
__device__ __forceinline__ void xcd_barrier_complete(unsigned* bar, unsigned x, unsigned& nloc, unsigned& nx) {
    const unsigned G = gridDim.x * gridDim.y * gridDim.z;
    unsigned sum, cnt, mine, sp = 0u;
    for (;;) {
        sum = 0u; cnt = 0u; mine = 0u;
#pragma unroll
        for (unsigned j = 0; j < 16; ++j) { const unsigned c = xb_ld(&bar[XB_XCNT(j)]); sum += c; cnt += (c > 0u) ? 1u : 0u; mine = (j == x) ? c : mine; }
        if (sum == G) break;
        __builtin_amdgcn_s_sleep(1);
        if ((++sp & 255u) == 0u) { if (xb_ld(&bar[XB_TMO])) break; if (sp > XB_SPIN_CAP) { atomicAdd(&bar[XB_TMO], 1u); break; } }
    }
    nloc = mine > 0u ? mine : 1u; nx = cnt > 0u ? cnt : 1u;
}

__device__ __forceinline__ void xcd_barrier(const XcdBarrier& b) {
    asm volatile("s_waitcnt vmcnt(0)" ::: "memory");
    __syncthreads();
    if (threadIdx.x == 0) {
        unsigned* bar = b.bar;
        __builtin_amdgcn_s_waitcnt(0);
        unsigned nloc = b.st[0], nx = b.st[1];
        if (nloc == 0u) { xcd_barrier_complete(bar, b.x, nloc, nx); b.st[0] = nloc; b.st[1] = nx; }
        const unsigned old = xb_add(&bar[XB_XSUB(b.x)], 1u);
        const unsigned gen = old / nloc;
        if (old + 1u == (gen + 1u) * nloc) {
            __builtin_amdgcn_fence(__ATOMIC_RELEASE, "agent");
            asm volatile("s_waitcnt vmcnt(0)" ::: "memory");
            const unsigned og = xb_add(&bar[XB_TOP], 1u);
            const unsigned tg = og / nx;
            if (og + 1u == (tg + 1u) * nx) xb_add(&bar[XB_TOPGEN], 1u);
            else XB_SPIN(xb_ld(&bar[XB_TOPGEN]) == tg, bar);
            __builtin_amdgcn_fence(__ATOMIC_ACQUIRE, "agent");
            xb_add(&bar[XB_XGEN(b.x)], 1u);
            asm volatile("s_waitcnt vmcnt(0)" ::: "memory");
        } else {
            XB_SPIN(xb_ld(&bar[XB_XGEN(b.x)]) == gen, bar);
            __builtin_amdgcn_fence(__ATOMIC_ACQUIRE, "agent");
            asm volatile("s_waitcnt vmcnt(0)" ::: "memory");
        }
    }
    __syncthreads();
}
struct Frame {
    const Params __attribute__((address_space(4)))* kp; unsigned char* ws; float* smem; PG8_LAS unsigned char* ldsp;
    int tid, lane, wave, gw, ngw;
    DI bf16_t* wl(int l, size_t off) const { return (bf16_t*)(ws + (size_t)l * WL_STRIDE + off); }
    DI bf16_t* z() const { return (bf16_t*)(ws + WS_Z); }
    DI bf16_t* q() const { return (bf16_t*)(ws + WS_Q); }
    DI bf16_t* kv() const { return (bf16_t*)(ws + WS_KV); }
    DI bf16_t* mix() const { return (bf16_t*)(ws + WS_MIX); }
    DI bf16_t* hu() const { return (bf16_t*)(ws + WS_HU); }
    DI bf16_t* gact() const { return (bf16_t*)(ws + WS_GACT); }
    DI bf16_t* hb() const { return (bf16_t*)(ws + WS_HB); }
    DI float* ssqh() const { return (float*)(ws + WS_SSQH); }
    DI float* ssqz() const { return (float*)(ws + WS_SSQZ); }
    DI bf16_t* kr() const { return (bf16_t*)(ws + WS_KR); }
    DI bf16_t* hidk() const { return (bf16_t*)(ws + WS_HIDK); }
    DI bf16_t* hidv() const { return (bf16_t*)(ws + WS_HIDV); }
    DI bf16_t* kcmp() const { return (bf16_t*)(ws + WS_KCMP); }
    DI bf16_t* vcmp() const { return (bf16_t*)(ws + WS_VCMP); }
    DI float* rope() const { return (float*)(ws + WS_ROPE); }
    DI float* b1(int l, int v) const { return (float*)(ws + WS_B1) + (l * 2 + v) * 128; }
    DI float* h() const { return (float*)(__attribute__((address_space(1))) float*)kp->out; }
    DI const float* gin(int i) const { return (const float*)(const __attribute__((address_space(1))) float*)kp->in[i]; }
};

DI void phase_prep(Frame& F) {
    for (int l = 0; l < 2; ++l) {
        wconv(F.gin(2) + (size_t)l * 1024 * 1976, 1024, 1976, F.gin(1) + l * 1024, F.wl(l, W_IN), 2048, MapZ(), F.smem);
        wconv(F.gin(5) + (size_t)l * 384 * 768, 384, 768, F.gin(3) + l * 384, F.wl(l, W_UQ), 768, MapUQ(), F.smem);
        wconv(F.gin(6) + (size_t)l * 256 * 1024, 256, 1024, F.gin(4) + l * 256, F.wl(l, W_UKV), 1024, MapUKV(), F.smem);
        wconv(F.gin(9) + (size_t)l * 2048 * 128, 2048, 128, nullptr, F.wl(l, W_C1K), 256, MapId{128}, F.smem);
        wconv(F.gin(11) + (size_t)l * 2048 * 128, 2048, 128, nullptr, F.wl(l, W_C1V), 256, MapId{128}, F.smem);
        wconv(F.gin(10) + (size_t)l * 128 * 64, 128, 64, nullptr, F.wl(l, W_C2K), 256, MapId{64}, F.smem);
        wconv(F.gin(12) + (size_t)l * 128 * 64, 128, 64, nullptr, F.wl(l, W_C2V), 256, MapId{64}, F.smem);
        wconv(F.gin(13) + (size_t)l * 1024 * 1024, 1024, 1024, nullptr, F.wl(l, W_O), 1024, MapId{1024}, F.smem);
        wconv(F.gin(15) + (size_t)l * 1024 * NUP, 1024, NUP, F.gin(14) + l * 1024, F.wl(l, W_UP), NUP, MapUP(), F.smem);
        wconv(F.gin(18) + (size_t)l * DFF * 1024, DFF, 1024, nullptr, F.wl(l, W_DN), 1024, MapId{1024}, F.smem);
    }
    if (blockIdx.x >= gridDim.x - 64) {
        const int bb = blockIdx.x - (gridDim.x - 64), lv = bb >> 4, kp = bb & 15, l = lv >> 1, v = lv & 1, e = F.tid & 127, sub = F.tid >> 7;
        const float* pos = (v ? F.gin(8) : F.gin(7)) + l * 2048; const float* w1 = (v ? F.gin(11) : F.gin(9)) + (size_t)l * 2048 * 128;
        float s = 0.f; const int k0 = kp * 128 + sub * 32;
#pragma unroll 8
        for (int k = k0; k < k0 + 32; ++k) s += pos[k] * w1[(size_t)k * 128 + e];
        __syncthreads(); F.smem[F.tid] = s; __syncthreads();
        if (F.tid < 128) ((float*)(F.ws + WS_B1))[1024 + (lv * 16 + kp) * 128 + e] = (F.smem[e] + F.smem[128 + e]) + (F.smem[256 + e] + F.smem[384 + e]);
        __syncthreads();
    }
    for (int i = blockIdx.x * NT + F.tid; i < S * 16; i += gridDim.x * NT) {
        const int t = i >> 4, j = i & 15; const float inv = 1.0f / powf(10000.0f, (float)(2 * j) / 32.0f); const float ang = (float)t * inv;
        F.rope()[i] = cosf(ang); F.rope()[S * 16 + i] = sinf(ang);
    }
    for (int row = F.gw; row < M; row += F.ngw) {
        const f32x4* xr = (const f32x4*)(F.gin(0) + (size_t)row * DM) + F.lane; float s = 0.f;
#pragma unroll
        for (int j = 0; j < 4; ++j) { f32x4 v = xr[64 * j]; s += (v[0] * v[0] + v[1] * v[1]) + (v[2] * v[2] + v[3] * v[3]);
            st_bf4(F.hb() + (size_t)row * DM + 4 * (F.lane + 64 * j), v); }
        s = wave_sum(s);
        if (F.lane < 16) F.ssqh()[(size_t)row * 16 + F.lane] = F.lane == 0 ? s : 0.f;
    }
}
DI void phase_stat_h(Frame& F) {
    for (int row = F.gw; row < M; row += F.ngw) {
        const f32x4* hr = (const f32x4*)(F.h() + (size_t)row * DM) + F.lane; float s = 0.f;
#pragma unroll
        for (int j = 0; j < 4; ++j) { f32x4 v = hr[64 * j]; s += (v[0] * v[0] + v[1] * v[1]) + (v[2] * v[2] + v[3] * v[3]); }
        s = wave_sum(s);
        if (F.lane < 16) F.ssqh()[(size_t)row * 16 + F.lane] = F.lane == 0 ? s : 0.f;
    }
}
DI void phase_stat_z(Frame& F) {
    for (int row = F.gw; row < M; row += F.ngw) {
        const bf16_t* zr = F.z() + (size_t)row * ZP; float sq = 0.f, sk = 0.f;
        for (int j = 0; j < 6; ++j) { float v = bf2f(zr[Z_CQ + F.lane + 64 * j]); sq += v * v; }
        for (int j = 0; j < 4; ++j) { float v = bf2f(zr[Z_CKV + F.lane + 64 * j]); sk += v * v; }
        sq = wave_sum(sq); sk = wave_sum(sk);
        if (F.lane < 24) F.ssqz()[(size_t)row * 24 + F.lane] = F.lane == 0 ? sq : (F.lane == 16 ? sk : 0.f);
    }
}
DI void job_krope(Frame& F) {
    for (int i = blockIdx.x * NT + F.tid; i < M * 16; i += gridDim.x * NT) {
        const int row = i >> 4, j = i & 15, t = row & (S - 1);
        const float c = F.rope()[t * 16 + j], s = F.rope()[S * 16 + t * 16 + j];
        const float x1 = bf2f(F.z()[(size_t)row * ZP + Z_KR + j]), x2 = bf2f(F.z()[(size_t)row * ZP + Z_KR + 16 + j]);
        F.kr()[(size_t)row * 32 + j] = f2bf(x1 * c - x2 * s); F.kr()[(size_t)row * 32 + 16 + j] = f2bf(x2 * c + x1 * s);
    }
}

struct OS { float m, l, o; };
DI void os_init(OS& s) { s.m = -INFINITY; s.l = 0.f; s.o = 0.f; }
DI void os_chunk(OS& st, float s, bool valid, const bf16_t* vbase, size_t vstride, int lane) {
    unsigned long long bal = __ballot(valid);
    if (!bal) return;
    const float cm = wave_max(valid ? s : -INFINITY);
    const float mn = fmaxf(st.m, cm);
    const float alpha = __expf(st.m - mn);
    const float p = valid ? __expf(s - mn) : 0.f;
    st.l = st.l * alpha + wave_sum(p);
    float acc = st.o * alpha;
    while (bal) { const int kk = __ffsll((long long)bal) - 1; bal &= bal - 1; const float pk = __shfl(p, kk); acc += pk * bf2f(vbase[(size_t)kk * vstride + lane]); }
    st.o = acc; st.m = mn;
}
DI float dot_bf(const float* q, const bf16_t* k, int n) {
    float s = 0.f;
    for (int d = 0; d < n; d += 8) { bf16x8 kv = *(const bf16x8*)(k + d);
#pragma unroll
        for (int j = 0; j < 8; ++j) s += q[d + j] * bf2f((bf16_t)kv[j]); }
    return s;
}
DI void phase_attn_naive(Frame& F) {
    float* wq = F.smem + F.wave * 640;
    float* pl = wq + 128;
    const bf16_t* q = F.q(); const bf16_t* kv = F.kv(); const bf16_t* kr = F.kr(); const bf16_t* z = F.z(); bf16_t* mix = F.mix();
    const int lane = F.lane;
    for (int task = F.gw; task < M * 8; task += F.ngw) {
        const int hd = task & 7, row = task >> 3, b = row >> 12, t = row & (S - 1);
        wq[lane] = bf2f(q[(size_t)row * 768 + hd * 64 + lane]);
        if (lane < 16) { const float c = F.rope()[t * 16 + lane], s = F.rope()[S * 16 + t * 16 + lane];
            const float x1 = bf2f(q[(size_t)row * 768 + 512 + hd * 32 + lane]), x2 = bf2f(q[(size_t)row * 768 + 512 + hd * 32 + 16 + lane]);
            wq[64 + lane] = x1 * c - x2 * s; wq[80 + lane] = x2 * c + x1 * s; }
        __builtin_amdgcn_wave_barrier();
        OS st; os_init(st);
        const float scale = 0.10206207261596575f;
        for (int k0 = 0; k0 <= t; k0 += 64) {
            const int key = k0 + lane; const bool valid = key <= t; const size_t kro = (size_t)(b * S + (valid ? key : t));
            const float s = (dot_bf(wq, kv + kro * 1024 + hd * 64, 64) + dot_bf(wq + 64, kr + kro * 32, 32)) * scale;
            os_chunk(st, s, valid, kv + (size_t)(b * S + k0) * 1024 + 512 + hd * 64, 1024, lane);
        }
        mix[(size_t)row * DM + hd * 64 + lane] = f2bf(st.o / st.l);
        __builtin_amdgcn_wave_barrier();
    }
    for (int task = F.gw; task < M * 2; task += F.ngw) {
        const int g = task & 1, row = task >> 1, b = row >> 12, t = row & (S - 1), bg = b * 2 + g, cur = t >> 6;
        const int nvis = t >= 31 ? ((t - 31) >> 4) + 1 : 0;
        float* ocs = wq + 384; float imp = 0.f;
        const bf16_t* kc = F.kcmp() + (size_t)bg * 256 * 64; const bf16_t* vc = F.vcmp() + (size_t)bg * 256 * 64;
        for (int r = 0; r < 4; ++r) {
            const int hd = g * 4 + r; const float slope = exp2f(-(float)(hd + 1));
            wq[lane] = bf2f(z[(size_t)row * ZP + Z_QN + hd * 64 + lane]);
            __builtin_amdgcn_wave_barrier();
            float sc[4]; float mx = -INFINITY;
#pragma unroll
            for (int i = 0; i < 4; ++i) { const int n = lane + 64 * i; const bool valid = n < nvis;
                sc[i] = valid ? dot_bf(wq, kc + (size_t)n * 64, 64) * 0.125f - slope * (float)(t - (16 * n + 31)) : -INFINITY; mx = fmaxf(mx, sc[i]); }
            mx = wave_max(mx);
            float ps[4]; float l = 0.f;
#pragma unroll
            for (int i = 0; i < 4; ++i) { ps[i] = (lane + 64 * i) < nvis ? __expf(sc[i] - mx) : 0.f; l += ps[i]; }
            l = wave_sum(l); const float il = nvis > 0 ? 1.f / l : 0.f;
            float o = 0.f;
#pragma unroll
            for (int i = 0; i < 4; ++i) { ps[i] *= il; pl[lane + 64 * i] = ps[i];
                const int cnt = nvis - 64 * i; for (int kk = 0; kk < 64 && kk < cnt; ++kk) { const float pk = __shfl(ps[i], kk); o += pk * bf2f(vc[(size_t)(64 * i + kk) * 64 + lane]); } }
            ocs[r * 64 + lane] = o;
            __builtin_amdgcn_wave_barrier();
            { const int j = lane; float a = 0.f; for (int n = 4 * j - 1; n <= 4 * j + 3; ++n) if (n >= 0 && n < 255) a += pl[n]; imp += a; }
            __builtin_amdgcn_wave_barrier();
        }
        float v = imp; if (lane > cur) v = -INFINITY; if (lane == 0 || lane == cur || lane == cur - 1) v = INFINITY;
        int rank = 0;
        for (int j = 0; j < 64; ++j) { const float vj = __shfl(v, j); rank += (vj > v || (vj == v && j < lane)) ? 1 : 0; }
        const unsigned long long selmask = __ballot(rank < 16 && lane <= cur);
        for (int r = 0; r < 4; ++r) {
            const int hd = g * 4 + r; const float slope = exp2f(-(float)(hd + 1));
            wq[lane] = bf2f(z[(size_t)row * ZP + Z_QN + hd * 64 + lane]);
            __builtin_amdgcn_wave_barrier();
            OS ss; os_init(ss);
            unsigned long long mm = selmask;
            while (mm) { const int j = __ffsll((long long)mm) - 1; mm &= mm - 1; const int key = 64 * j + lane; const bool valid = key <= t;
                const size_t kro = (size_t)(b * S + (valid ? key : t));
                const float s = dot_bf(wq, z + kro * ZP + Z_KS + g * 64, 64) * 0.125f - slope * (float)(t - key);
                os_chunk(ss, s, valid, z + (size_t)(b * S + 64 * j) * ZP + Z_VS + g * 64, ZP, lane); }
            OS sw; os_init(sw);
            for (int c = 0; c < 9; ++c) { const int j = cur - 8 + c; if (j < 0) continue; const int key = 64 * j + lane; const bool valid = key <= t && (t - key) < 512;
                const size_t kro = (size_t)(b * S + (key <= t ? key : t));
                const float s = dot_bf(wq, z + kro * ZP + Z_KW + g * 64, 64) * 0.125f - slope * (float)(t - key);
                os_chunk(sw, s, valid, z + (size_t)(b * S + 64 * j) * ZP + Z_VW + g * 64, ZP, lane); }
            const bf16_t* gt = z + (size_t)row * ZP + Z_GT + hd * 3;
            const float g0 = 1.f / (1.f + __expf(-bf2f(gt[0]))), g1 = 1.f / (1.f + __expf(-bf2f(gt[1]))), g2 = 1.f / (1.f + __expf(-bf2f(gt[2])));
            const float o = g0 * ocs[r * 64 + lane] + g1 * (ss.o / ss.l) + g2 * (sw.o / sw.l);
            mix[(size_t)row * DM + 512 + hd * 64 + lane] = f2bf(o);
            __builtin_amdgcn_wave_barrier();
        }
    }
}

typedef PG8_LAS bf16_t* lbf;
typedef short s16x4 __attribute__((ext_vector_type(4)));
typedef __bf16 bfv2 __attribute__((ext_vector_type(2)));
typedef float f32x2 __attribute__((ext_vector_type(2)));
constexpr int A_KSZ = 64 * 104, A_VLD = 72, A_VSZ = 64 * A_VLD;
constexpr int A_KOFF = 0, A_VOFF = 2 * A_KSZ * 2, A_IMP = A_VOFF + 2 * A_VSZ * 2, A_IMPLD = 65, A_SELM = A_IMP + 4 * 64 * A_IMPLD * 4, A_UNI = A_SELM + 512, A_IL = A_UNI + 16, A_QIDX = A_IL + 1024, A_END = A_QIDX + 16;
static_assert(A_END <= LDS_BYTES, "attention LDS");
constexpr float LOG2E = 1.4426950408889634f;
DI unsigned cvt2(float lo, float hi) { f32x2 f = {lo, hi}; bfv2 b = __builtin_convertvector(f, bfv2); return __builtin_bit_cast(unsigned, b); }
DI int crow_(int i, int h) { return (i & 3) + 8 * (i >> 2) + 4 * h; }
struct TileRegs { u32x4 k, v, k2; };
template <bool MLA> DI void tile_gload(TileRegs& R, const bf16_t* kp, size_t kst, const bf16_t* vp, size_t vst, const bf16_t* k2p, int kb, int tid) {
    const int key = tid >> 3, c = tid & 7;
    R.k = *(const u32x4*)(kp + (size_t)(kb + key) * kst + 8 * c);
    R.v = *(const u32x4*)(vp + (size_t)(kb + (tid & 63)) * vst + 8 * (tid >> 6));
    if (MLA) R.k2 = *(const u32x4*)(k2p + (size_t)(kb + ((tid & 255) >> 2)) * 32 + 8 * (tid & 3));
}
template <bool MLA> DI void tile_lstore(const TileRegs& R, lbf Ks, lbf Vt, int tid) {
    constexpr int KLD = MLA ? 104 : 72;
    const int key = tid >> 3, c = tid & 7;
    *(PG8_LAS u32x4*)(Ks + key * KLD + 8 * c) = R.k;
    if (MLA) { if (tid < 256) *(PG8_LAS u32x4*)(Ks + (tid >> 2) * KLD + 64 + 8 * (tid & 3)) = R.k2; }
    { const int kv = tid & 63, cv = tid >> 6, kp = (kv & ~12) | ((kv & 4) << 1) | ((kv & 8) >> 1);
#pragma unroll
      for (int j = 0; j < 8; ++j) Vt[(8 * cv + j) * A_VLD + kp] = (bf16_t)(R.v[j >> 1] >> (16 * (j & 1))); }
}
template <int KS> DI void qk_tile(lbf Ks, const bf16x8 (&Q)[KS], f32x16& s0, f32x16& s1, int r, int h) {
    constexpr int KLD = KS == 6 ? 104 : 72;
#pragma unroll
    for (int i = 0; i < 16; ++i) { s0[i] = 0.f; s1[i] = 0.f; }
    const PG8_LAS bf16x8* p0 = (const PG8_LAS bf16x8*)(Ks + r * KLD + 8 * h); const PG8_LAS bf16x8* p1 = (const PG8_LAS bf16x8*)(Ks + (32 + r) * KLD + 8 * h);
    bf16x8 a0 = p0[0], a1 = p1[0], b0, b1;
#pragma unroll
    for (int ks = 0; ks < KS; ks += 2) {
        b0 = p0[2 * (ks + 1)]; b1 = p1[2 * (ks + 1)];
        __builtin_amdgcn_sched_barrier(0);
        s0 = MFMA32(a0, Q[ks], s0); s1 = MFMA32(a1, Q[ks], s1);
        __builtin_amdgcn_sched_barrier(0);
        if (ks + 2 < KS) { a0 = p0[2 * (ks + 2)]; a1 = p1[2 * (ks + 2)]; }
        __builtin_amdgcn_sched_barrier(0);
        s0 = MFMA32(b0, Q[ks + 1], s0); s1 = MFMA32(b1, Q[ks + 1], s1);
        __builtin_amdgcn_sched_barrier(0);
    }
}
DI bf16x8 pack8(const f32x16& p, int s) {
    u32x4 w; w.x = cvt2(p[8 * s], p[8 * s + 1]); w.y = cvt2(p[8 * s + 2], p[8 * s + 3]); w.z = cvt2(p[8 * s + 4], p[8 * s + 5]); w.w = cvt2(p[8 * s + 6], p[8 * s + 7]);
    return __builtin_bit_cast(bf16x8, w);
}
DI void pv_load(lbf Vt, int g, int r, int h, bf16x8& v0, bf16x8& v1) {
    const int col = 32 * (g >> 1) + 16 * (g & 1) + 8 * h;
    v0 = *(const PG8_LAS bf16x8*)(Vt + r * A_VLD + col); v1 = *(const PG8_LAS bf16x8*)(Vt + (32 + r) * A_VLD + col);
}
DI void pv_tile(lbf Vt, const f32x16& p0, const f32x16& p1, f32x16 (&O)[2], int r, int h) {
    bf16x8 va0, va1, vb0, vb1;
    pv_load(Vt, 0, r, h, va0, va1);
#pragma unroll
    for (int g = 0; g < 4; g += 2) {
        pv_load(Vt, g + 1, r, h, vb0, vb1);
        const bf16x8 pa = pack8(g >> 1 ? p1 : p0, 0);
        __builtin_amdgcn_sched_barrier(0);
        O[0] = MFMA32(va0, pa, O[0]); O[1] = MFMA32(va1, pa, O[1]);
        __builtin_amdgcn_sched_barrier(0);
        if (g + 2 < 4) pv_load(Vt, g + 2, r, h, va0, va1);
        const bf16x8 pb = pack8(g >> 1 ? p1 : p0, 1);
        __builtin_amdgcn_sched_barrier(0);
        O[0] = MFMA32(vb0, pb, O[0]); O[1] = MFMA32(vb1, pb, O[1]);
        __builtin_amdgcn_sched_barrier(0);
    }
}
DI float row_max(const f32x16& x0, const f32x16& x1) {
    float mx = fmaxf(x0[0], x1[0]);
#pragma unroll
    for (int i = 1; i < 16; ++i) mx = fmaxf(mx, fmaxf(x0[i], x1[i]));
    return fmaxf(mx, __shfl_xor(mx, 32));
}
template <bool PV> DI void online_step_mx(f32x16& x0, f32x16& x1, float mx, float& m, float& l, f32x16 (&O)[2]);
template <bool PV> DI void online_step(f32x16& x0, f32x16& x1, float& m, float& l, f32x16 (&O)[2]) { online_step_mx<PV>(x0, x1, row_max(x0, x1), m, l, O); }
template <bool PV> DI void online_step_mx(f32x16& x0, f32x16& x1, float mx, float& m, float& l, f32x16 (&O)[2]) {
    const float mn = fmaxf(m, mx), alpha = __builtin_amdgcn_exp2f(m - mn);
    float ls = 0.f;
#pragma unroll
    for (int i = 0; i < 16; ++i) { x0[i] = __builtin_amdgcn_exp2f(x0[i] - mn); x1[i] = __builtin_amdgcn_exp2f(x1[i] - mn); ls += x0[i] + x1[i]; }
    ls += __shfl_xor(ls, 32);
    l = l * alpha + ls; m = mn;
    if (PV) { if (__any(alpha != 1.f)) {
#pragma unroll
        for (int i = 0; i < 16; ++i) { O[0][i] *= alpha; O[1][i] *= alpha; } } }
}
DI void online_raw(f32x16& s0, f32x16& s1, float c1, float& m, float& l, f32x16 (&O)[2]) {
    float mx = fmaxf(s0[0], s1[0]);
#pragma unroll
    for (int i = 1; i < 16; ++i) mx = fmaxf(mx, fmaxf(s0[i], s1[i]));
    mx = fmaxf(mx, __shfl_xor(mx, 32));
    const float mn = fmaxf(m, mx * c1), alpha = __builtin_amdgcn_exp2f(m - mn), nmn = -mn;
    float ls = 0.f;
#pragma unroll
    for (int i = 0; i < 16; ++i) { s0[i] = __builtin_amdgcn_exp2f(fmaf(s0[i], c1, nmn)); s1[i] = __builtin_amdgcn_exp2f(fmaf(s1[i], c1, nmn)); ls += s0[i] + s1[i]; }
    ls += __shfl_xor(ls, 32);
    l = l * alpha + ls; m = mn;
    if (__any(alpha != 1.f)) {
#pragma unroll
        for (int i = 0; i < 16; ++i) { O[0][i] *= alpha; O[1][i] *= alpha; } }
}
struct TlRange { int lo, hi; DI int first() const { return lo <= hi ? lo * 64 : -1; } DI int next(int kb) const { return kb + 64 <= hi * 64 ? kb + 64 : -1; } };
struct TlRangeDesc { int lo, hi; DI int first() const { return lo <= hi ? hi * 64 : -1; } DI int next(int kb) const { return kb - 64 >= lo * 64 ? kb - 64 : -1; } };
struct TlMaskDesc { unsigned long long mask; DI int first() const { return mask ? (63 - __clzll((long long)mask)) * 64 : -1; }
    DI int next(int kb) const { const int j = kb >> 6; const unsigned long long rest = j == 0 ? 0ull : (mask & ((1ull << j) - 1ull)); return rest ? (63 - __clzll((long long)rest)) * 64 : -1; } };
struct TlMask { unsigned long long mask; DI int first() const { return mask ? (__ffsll((long long)mask) - 1) * 64 : -1; }
    DI int next(int kb) const { const int j = kb >> 6; const unsigned long long rest = j >= 63 ? 0ull : (mask >> (j + 1)); return rest ? (j + 1 + __ffsll((long long)rest) - 1) * 64 : -1; } };
template <bool MLA, class TL, class CF>
DI void att_pipe(lbf KB, lbf VB, const bf16_t* kp, size_t kst, const bf16_t* vp, size_t vst, const bf16_t* k2p, const TL& tl, CF& cf, int) {
    int kb = tl.first(); if (kb < 0) return;
    const int tid = tid_now();
    TileRegs R0, R1; tile_gload<MLA>(R0, kp, kst, vp, vst, k2p, kb, tid);
    int nk = tl.next(kb);
    tile_gload<MLA>(R1, kp, kst, vp, vst, k2p, nk >= 0 ? nk : kb, tid);
    __syncthreads();
    tile_lstore<MLA>(R0, KB, VB, tid);
    __syncthreads();
    int cb = 0;
#define ATT_STEP(RA, RB) { const int nn = nk >= 0 ? tl.next(nk) : -1; \
        tile_gload<MLA>(RA, kp, kst, vp, vst, k2p, nn >= 0 ? nn : kb, tid);     \
        cf(KB + cb * A_KSZ, VB + cb * A_VSZ, kb); \
        if (nk >= 0) tile_lstore<MLA>(RB, KB + (cb ^ 1) * A_KSZ, VB + (cb ^ 1) * A_VSZ, tid); \
        __syncthreads(); \
        if (nk < 0) break; \
        kb = nk; nk = nn; cb ^= 1; }
    for (;;) {
        ATT_STEP(R0, R1)
        ATT_STEP(R1, R0)
    }
#undef ATT_STEP
}
struct CfMla { const bf16x8 (&Q)[6]; f32x16 (&O)[2]; float& m; float& l; int t, tq0, r, h;
    DI void operator()(lbf Ks, lbf Vt, int kb) {
        if (kb > __builtin_amdgcn_readfirstlane(tq0) + 31) return;
        f32x16 x0, x1; qk_tile<6>(Ks, Q, x0, x1, r, h);
        const float c1 = 0.10206207261596575f * LOG2E;
        if (kb + 63 > __builtin_amdgcn_readfirstlane(tq0)) {
            const int dt = t - kb - 4 * h;
#pragma unroll
            for (int i = 0; i < 16; ++i) { const int ci = (i & 3) + 8 * (i >> 2); x0[i] = ci <= dt ? x0[i] : -INFINITY; x1[i] = ci + 32 <= dt ? x1[i] : -INFINITY; }
        }
        online_raw(x0, x1, c1, m, l, O); pv_tile(Vt, x0, x1, O, r, h);
    } };
template <bool SEL> struct CfNsa { const bf16x8 (&Q)[4]; f32x16 (&O)[2]; float& m; float& l; int t, r, h; float sl2; unsigned long long qsel;
    DI void operator()(lbf Ks, lbf Vt, int kb) {
        f32x16 x0, x1; qk_tile<4>(Ks, Q, x0, x1, r, h);
        const float c1 = 0.125f * LOG2E; const bool on = !SEL || ((qsel >> (kb >> 6)) & 1ull);
        const int tq0 = __builtin_amdgcn_readfirstlane(t - r);
        const float base = on ? sl2 * (float)(kb + 4 * h - t) : -INFINITY;
#pragma unroll
        for (int i = 0; i < 16; ++i) { const int ci = (i & 3) + 8 * (i >> 2); x0[i] = fmaf(x0[i], c1, fmaf(sl2, (float)ci, base)); x1[i] = fmaf(x1[i], c1, fmaf(sl2, (float)(ci + 32), base)); }
        if (kb + 63 > tq0 || (!SEL && tq0 + 31 - kb >= 512)) {
            const int dt = t - kb - 4 * h;
#pragma unroll
            for (int i = 0; i < 16; ++i) { const int ci = (i & 3) + 8 * (i >> 2);
                const bool v0 = ci <= dt && (SEL || dt - ci < 512), v1 = ci + 32 <= dt && (SEL || dt - ci - 32 < 512);
                x0[i] = v0 ? x0[i] : -INFINITY; x1[i] = v1 ? x1[i] : -INFINITY; }
        }
        {
            const float mx = row_max(x0, x1);
            if (!__any(mx - m > -160.f)) return;
            online_step_mx<true>(x0, x1, mx, m, l, O);
        }
        pv_tile(Vt, x0, x1, O, r, h);
    } };
struct CfCmp { const bf16x8 (&Q)[4]; f32x16 (&O)[2]; float& m; float& l; int t, r, h; float sl2; int nvis; PG8_LAS float* imp; int nvmin;
    DI void operator()(lbf Ks, lbf Vt, int kb) {
        f32x16 x0, x1; qk_tile<4>(Ks, Q, x0, x1, r, h);
        const float c1 = 0.125f * LOG2E;
        const int dn = nvis - kb - 4 * h;
        const float df = sl2 * (float)(16 * (kb + 4 * h) + 31 - t), s16 = 16.f * sl2;
#pragma unroll
        for (int i = 0; i < 16; ++i) { const int ci = (i & 3) + 8 * (i >> 2); const float bi = fmaf(s16, (float)ci, df); x0[i] = fmaf(x0[i], c1, bi); x1[i] = fmaf(x1[i], c1, bi + 32.f * s16); }
        if (kb + 64 > __builtin_amdgcn_readfirstlane(nvmin)) {
#pragma unroll
            for (int i = 0; i < 16; ++i) { const int ci = (i & 3) + 8 * (i >> 2); x0[i] = ci < dn ? x0[i] : -INFINITY; x1[i] = ci + 32 < dn ? x1[i] : -INFINITY; }
        }
        const float mold = m, mxr = row_max(x0, x1);
        if (!__any(mxr - m > -160.f)) return;
        online_step_mx<true>(x0, x1, mxr, m, l, O);
        const float alpha = __builtin_amdgcn_exp2f(mold - m);
        if (__any(alpha != 1.f && mold > -1e29f)) {
#pragma unroll 4
            for (int k = 0; k < 32; ++k) imp[2 * k + h] *= alpha;
        }
        pv_tile(Vt, x0, x1, O, r, h);
#pragma unroll
        for (int kh = 0; kh < 2; ++kh)
#pragma unroll
            for (int g4 = 0; g4 < 4; ++g4) { const f32x16& p = kh ? x1 : x0; const int a = (kb >> 2) + 8 * kh + 2 * g4 + h;
                imp[a] += (p[4 * g4] + p[4 * g4 + 1]) + (p[4 * g4 + 2] + p[4 * g4 + 3]); asm volatile("" ::: "memory");
                if (a + 1 < 64) imp[a + 1] += p[4 * g4 + 3];
                asm volatile("" ::: "memory"); }
    } };
DI void write_o(bf16_t* dst, const f32x16 (&O)[2], float sc, int h) {
#pragma unroll
    for (int dh = 0; dh < 2; ++dh)
#pragma unroll
        for (int g4 = 0; g4 < 4; ++g4) { u32x2 w; w.x = cvt2(O[dh][4 * g4] * sc, O[dh][4 * g4 + 1] * sc); w.y = cvt2(O[dh][4 * g4 + 2] * sc, O[dh][4 * g4 + 3] * sc);
            *(u32x2*)(dst + 32 * dh + 8 * g4 + 4 * h) = w; }
}
DI void zero_o(f32x16 (&O)[2]) {
#pragma unroll
    for (int i = 0; i < 16; ++i) { O[0][i] = 0.f; O[1][i] = 0.f; }
}
DI void unit_mla(Frame& F, int b, int hd, int qb, int tid) {
    const int lane = tid & 63, w = tid >> 6, r = lane & 31, h = lane >> 5, tq0 = qb * 256 + 32 * w, t = tq0 + r; const size_t row = (size_t)b * S + t;
    lbf KB = (lbf)(F.ldsp + A_KOFF), VB = (lbf)(F.ldsp + A_VOFF);
    bf16x8 Q[6];
    const bf16_t* qr = F.q() + row * 768;
#pragma unroll
    for (int ks = 0; ks < 4; ++ks) Q[ks] = *(const bf16x8*)(qr + hd * 64 + 16 * ks + 8 * h);
    { const bf16x8 x1 = *(const bf16x8*)(qr + 512 + hd * 32 + 8 * h), x2 = *(const bf16x8*)(qr + 512 + hd * 32 + 16 + 8 * h);
      int ro = t * 16 + 8 * h; asm volatile("" : "+v"(ro));
      const f32x4* cs = (const f32x4*)(F.rope() + ro); const f32x4* sn = (const f32x4*)(F.rope() + S * 16 + ro);
      const f32x4 c0 = cs[0], c1 = cs[1], s0 = sn[0], s1 = sn[1];
#pragma unroll
      for (int j = 0; j < 8; ++j) { const float a = bf2f((bf16_t)x1[j]), bb = bf2f((bf16_t)x2[j]), c = j < 4 ? c0[j & 3] : c1[j & 3], s = j < 4 ? s0[j & 3] : s1[j & 3]; Q[4][j] = (short)f2bf(a * c - bb * s); Q[5][j] = (short)f2bf(bb * c + a * s); } }
    __builtin_amdgcn_sched_barrier(0);
    f32x16 O[2]; zero_o(O); float m = -1e30f, l = 0.f;
    CfMla cf{Q, O, m, l, t, tq0, r, h};
    const bf16_t* kvb = F.kv() + (size_t)b * S * 1024;
    att_pipe<true>(KB, VB, kvb + hd * 64, 1024, kvb + 512 + hd * 64, 1024, F.kr() + (size_t)b * S * 32, TlRange{0, 4 * qb + 3}, cf, tid);
    write_o(F.mix() + row * DM + hd * 64, O, 1.f / l, h);
}
DI void unit_nsa(Frame& F, int b, int g, int qt, int tid) {
    const int lane = tid & 63, w = tid >> 6, r = lane & 31, h = lane >> 5, rh = w >> 1, sub = w & 1, hd = 4 * g + rh, ql = 32 * sub + r, t = qt * 64 + ql, bg = b * 2 + g;
    const size_t row = (size_t)b * S + t;
    lbf KB = (lbf)(F.ldsp + A_KOFF), VB = (lbf)(F.ldsp + A_VOFF);
    PG8_LAS float* impr = (PG8_LAS float*)(F.ldsp + A_IMP) + (rh * 64 + ql) * A_IMPLD;
    PG8_LAS unsigned* selm = (PG8_LAS unsigned*)(F.ldsp + A_SELM); PG8_LAS unsigned* uni = (PG8_LAS unsigned*)(F.ldsp + A_UNI);
    const bf16_t* zb = F.z() + (size_t)b * S * ZP;
    bf16x8 Q[4];
#pragma unroll
    for (int ks = 0; ks < 4; ++ks) Q[ks] = *(const bf16x8*)(F.z() + row * ZP + Z_QN + hd * 64 + 16 * ks + 8 * h);
    const float sl2 = exp2f(-(float)(hd + 1)) * LOG2E;
    const bf16_t* gt = F.z() + row * ZP + Z_GT + hd * 3;
    const float g0 = 1.f / (1.f + __expf(-bf2f(gt[0]))), g1 = 1.f / (1.f + __expf(-bf2f(gt[1]))), g2 = 1.f / (1.f + __expf(-bf2f(gt[2])));
    f32x16 O[2], Of[2]; float m, l;
    const int tmax = qt * 64 + 63, nvmax = tmax >= 31 ? ((tmax - 31) >> 4) + 1 : 0, ntc = (nvmax + 63) >> 6, nvis = t >= 31 ? ((t - 31) >> 4) + 1 : 0;
    const int tw0 = t - r, nvmin = tw0 >= 31 ? ((tw0 - 31) >> 4) + 1 : 0;
    const bf16_t* kc = F.kcmp() + (size_t)bg * 256 * 64; const bf16_t* vc = F.vcmp() + (size_t)bg * 256 * 64;
    if (tid < 2) uni[tid] = 0u;
#pragma unroll
    for (int i = 0; i < 32; ++i) impr[32 * h + i] = 0.f;
    zero_o(O); m = -1e30f; l = 0.f;
    PG8_LAS float* ilq = (PG8_LAS float*)(F.ldsp + A_IL);
    { CfCmp c1{Q, O, m, l, t, r, h, sl2, nvis, impr, nvmin}; att_pipe<false>(KB, VB, kc, 64, vc, 64, nullptr, TlRangeDesc{0, ntc - 1}, c1, tid); }
    { const float il = l > 0.f ? 1.f / l : 0.f; if (h == 0) ilq[rh * 64 + ql] = il;
#pragma unroll
      for (int i = 0; i < 16; ++i) { Of[0][i] = (g0 * il) * O[0][i]; Of[1][i] = (g0 * il) * O[1][i]; } }
    __syncthreads();
#ifndef X_TOPK
    __builtin_amdgcn_sched_barrier(0);
    { const int tid = tid_now();
        PG8_LAS float* ib = (PG8_LAS float*)(F.ldsp + A_IMP);
        const int q = tid >> 3, jj = tid & 7;
        float mine[8];
#pragma unroll
        for (int k = 0; k < 8; ++k) { const int j = 8 * jj + k; const int o = q * A_IMPLD + j;
            float v = ((ib[o] * ilq[q] + ib[64 * A_IMPLD + o] * ilq[64 + q]) + ib[2 * 64 * A_IMPLD + o] * ilq[128 + q]) + ib[3 * 64 * A_IMPLD + o] * ilq[192 + q];
            if (j > qt) v = -INFINITY; if (j == 0 || j == qt || j == qt - 1) v = INFINITY; mine[k] = v; }
        __syncthreads();
#pragma unroll
        for (int k = 0; k < 8; ++k) ib[q * A_IMPLD + 8 * jj + k] = mine[k];
        __syncthreads();
        int rank[8];
#pragma unroll
        for (int k = 0; k < 8; ++k) rank[k] = 0;
        for (int j2 = 0; j2 <= qt; ++j2) { const float v2 = ib[q * A_IMPLD + j2];
#pragma unroll
            for (int k = 0; k < 8; ++k) rank[k] += (v2 > mine[k] || (v2 == mine[k] && j2 < 8 * jj + k)) ? 1 : 0; }
        unsigned bits = 0u;
#pragma unroll
        for (int k = 0; k < 8; ++k) if (rank[k] < 16 && 8 * jj + k <= qt) bits |= 1u << k;
        unsigned lo = jj < 4 ? bits << (8 * jj) : 0u, hi = jj >= 4 ? bits << (8 * (jj - 4)) : 0u;
#pragma unroll
        for (int o = 1; o < 8; o <<= 1) { lo |= __shfl_xor(lo, o); hi |= __shfl_xor(hi, o); }
        if (jj == 0) { selm[2 * q] = lo; selm[2 * q + 1] = hi; __hip_atomic_fetch_or(uni, lo, __ATOMIC_RELAXED, __HIP_MEMORY_SCOPE_WORKGROUP); __hip_atomic_fetch_or(uni + 1, hi, __ATOMIC_RELAXED, __HIP_MEMORY_SCOPE_WORKGROUP); }
        __syncthreads();
    }
#endif
    const unsigned long long qsel = (unsigned long long)selm[2 * ql] | ((unsigned long long)selm[2 * ql + 1] << 32);
    const unsigned long long umask = (unsigned long long)uni[0] | ((unsigned long long)uni[1] << 32);
    zero_o(O); m = -1e30f; l = 0.f;
#ifndef X_SEL
    __builtin_amdgcn_sched_barrier(0);
    { const int r = tid_now() & 31, h = (tid_now() >> 5) & 1; CfNsa<true> cs{Q, O, m, l, t, r, h, sl2, qsel}; att_pipe<false>(KB, VB, zb + Z_KS + g * 64, ZP, zb + Z_VS + g * 64, ZP, nullptr, TlMaskDesc{umask}, cs, tid); }
#endif
    { const float sc = g1 / l;
#pragma unroll
      for (int i = 0; i < 16; ++i) { Of[0][i] += sc * O[0][i]; Of[1][i] += sc * O[1][i]; } }
    zero_o(O); m = -1e30f; l = 0.f;
#ifndef X_WIN
    __builtin_amdgcn_sched_barrier(0);
    { const int r = tid_now() & 31, h = (tid_now() >> 5) & 1; CfNsa<false> cw{Q, O, m, l, t, r, h, sl2, 0ull}; att_pipe<false>(KB, VB, zb + Z_KW + g * 64, ZP, zb + Z_VW + g * 64, ZP, nullptr, TlRangeDesc{qt >= 8 ? qt - 8 : 0, qt}, cw, tid); }
#endif
    { const float sc = g2 / l;
#pragma unroll
      for (int i = 0; i < 16; ++i) { Of[0][i] += sc * O[0][i]; Of[1][i] += sc * O[1][i]; } }
    write_o(F.mix() + row * DM + 512 + hd * 64, Of, 1.f, h);
}
DI void phase_attn_fast(Frame& F, int l) {
    const int tid = tid_now();
    PG8_LAS int* qidx = (PG8_LAS int*)(F.ldsp + A_QIDX);
    unsigned* ctr = (unsigned*)(F.ws + WS_CTL) + (l & 3);
    unsigned* done = (unsigned*)(F.ws + WS_CTL) + 8 + (l & 1);
    if (blockIdx.x < 16 && l < 2) {
        const int c = blockIdx.x, G = gridDim.x, v = c >> 3, u = c & 7;
        if (v == 0) run_gemm(F.ldsp, pg8::Gemm{F.z() + Z_KC, F.wl(l, W_C1K), 2048, 256, 2048, 16 * ZP, ZP * 2, 1}, pg8::EpiG<pg8::EM_GELU, 0>{F.hidk(), 256, 128, nullptr, 0, F.b1(l, 0), nullptr, nullptr, nullptr}, G, u);
        else run_gemm(F.ldsp, pg8::Gemm{F.z() + Z_VC, F.wl(l, W_C1V), 2048, 256, 2048, 16 * ZP, ZP * 2, 1}, pg8::EpiG<pg8::EM_GELU, 0>{F.hidv(), 256, 128, nullptr, 0, F.b1(l, 1), nullptr, nullptr, nullptr}, G, u);
        __threadfence(); __syncthreads(); __builtin_amdgcn_fence(__ATOMIC_ACQUIRE, "agent");
        if (v == 0) ngemm(APlain{F.hidk() + (size_t)u * 256 * 256, 256}, F.wl(l, W_C2K), 128, 256, 64, 128, EpiPlain{F.kcmp() + (size_t)u * 256 * 64, 64}, true);
        else ngemm(APlain{F.hidv() + (size_t)u * 256 * 256, 256}, F.wl(l, W_C2V), 128, 256, 64, 128, EpiPlain{F.vcmp() + (size_t)u * 256 * 64, 64}, true);
        __threadfence(); __syncthreads();
        if (tid == 0) __hip_atomic_fetch_add(done, 1u, __ATOMIC_RELEASE, __HIP_MEMORY_SCOPE_AGENT);
    }
    bool cmp_ok = false;
    for (;;) {
        __syncthreads();
        if (tid == 0) qidx[0] = (int)atomicAdd(ctr, 1u);
        __syncthreads();
        const int i = qidx[0];
        if (i >= 1024) break;
        int tidu = tid; asm volatile("" : "+v"(tidu));
        if (i < 512) { const int k = i & 31; unit_mla(F, k >> 3, k & 7, 15 - (i >> 5), tidu); }
        else {
            if (!cmp_ok) {
                if (tid == 0) { while (__hip_atomic_load(done, __ATOMIC_RELAXED, __HIP_MEMORY_SCOPE_AGENT) < 16u) __builtin_amdgcn_s_sleep(8); }
                __syncthreads(); __builtin_amdgcn_fence(__ATOMIC_ACQUIRE, "agent"); cmp_ok = true;
            }
            const int j = i - 512; unit_nsa(F, (j & 7) >> 1, j & 1, 63 - (j >> 3), tidu);
        }
    }
}
DI void phase_conv(Frame& F, int l, int b) {
    const float* cw = F.gin(16) + (size_t)l * 3 * NUP; const float* cb = F.gin(17) + (size_t)l * NUP;
    const bf16_t* hu = F.hu(); bf16_t* ga = F.gact() + (size_t)b * S * DFF;
    for (size_t i = (size_t)blockIdx.x * NT + F.tid; i < (size_t)S * DFF; i += (size_t)gridDim.x * NT) {
        const int t = (int)(i / DFF), c = (int)(i % DFF), pn = c >> 7, j = c & 127, colg = pn * 256 + j, colu = colg + 128, cu = DFF + c;
        float hg = cb[c], hup = cb[cu];
#pragma unroll
        for (int k = 0; k < 3; ++k) { const int tt = t - 2 + k; if (tt >= 0) { hg += cw[k * NUP + c] * bf2f(hu[(size_t)tt * NUP + colg]); hup += cw[k * NUP + cu] * bf2f(hu[(size_t)tt * NUP + colu]); } }
        ga[(size_t)t * DFF + c] = f2bf(hg / (1.f + __expf(-hg)) * hup);
    }
}
DI void phase_final(Frame& F) {
    const float* fn = F.gin(19);
    for (int row = F.gw; row < M; row += F.ngw) {
        const float rs = rstd_h(F.ssqh(), row); f32x4* hr = (f32x4*)(F.h() + (size_t)row * DM) + F.lane; const f32x4* gn = (const f32x4*)fn + F.lane;
#pragma unroll
        for (int j = 0; j < 4; ++j) hr[64 * j] = hr[64 * j] * rs * gn[64 * j];
    }
}

constexpr int NPH = 13;
DI void run_phase(Frame& F, int ph) {
    if (ph == 0) { phase_prep(F);
#ifdef DUP_PREP
        __syncthreads(); phase_prep(F);
#endif
        return; }
    const int l = (ph - 1) / 6, s0_ = (ph - 1) % 6;
    const int s = s0_ == 0 ? 0 : (s0_ == 1 ? 2 : (s0_ == 2 ? 4 : (s0_ == 3 ? 5 : (s0_ == 4 ? 7 : 15))));
#ifdef ONLY_S
    if (s != ONLY_S) return;
#endif
    int G = gridDim.x, c = blockIdx.x; asm volatile("" : "+s"(G), "+s"(c));
    if (s == 0) { run_gemm(F.ldsp, pg8::Gemm{F.hb(), F.wl(l, W_IN), M, ZP, 1024, DM, 128, 0}, pg8::EpiG<pg8::EM_SCALEH, 2>{F.z(), ZP, ZP, F.ssqh(), 0, nullptr, nullptr, F.ssqz(), nullptr}, G, c);
#ifdef DUP_ZP
        run_gemm(F.ldsp, pg8::Gemm{F.hb(), F.wl(l, W_IN), M, ZP, 1024, DM, 128, 0}, pg8::EpiG<pg8::EM_SCALEH, 2>{F.z(), ZP, ZP, F.ssqh(), 0, nullptr, nullptr, F.ssqz(), nullptr}, G, c);
#endif
        return; }
    if (s == 1) { phase_stat_z(F); return; }
    if (s == 2) {
        run_gemm(F.ldsp, pg8::Gemm{F.z() + Z_CQ, F.wl(l, W_UQ), M, 768, 384, ZP, 128, 0}, pg8::EpiG<pg8::EM_SCALEQ, 0>{F.q(), 768, 768, F.ssqz(), 0, nullptr, nullptr, nullptr, nullptr}, G, c);
        run_gemm(F.ldsp, pg8::Gemm{F.z() + Z_CKV, F.wl(l, W_UKV), M, 1024, 256, ZP, 128, 0}, pg8::EpiG<pg8::EM_SCALEKV, 0>{F.kv(), 1024, 1024, F.ssqz(), 0, nullptr, nullptr, nullptr, nullptr}, G, c);
        job_krope(F);
        if (blockIdx.x == gridDim.x - 1 && F.tid < 256) {
            const int v = F.tid >> 7, e = F.tid & 127; const float* pp = (const float*)(F.ws + WS_B1) + 1024 + ((l * 2 + v) * 16) * 128 + e; float s = 0.f;
            for (int kp = 0; kp < 16; ++kp) s += pp[kp * 128];
            F.b1(l, v)[e] = s;
        }
#ifdef DUP_ZP
        run_gemm(F.ldsp, pg8::Gemm{F.z() + Z_CQ, F.wl(l, W_UQ), M, 768, 384, ZP, 128, 0}, pg8::EpiG<pg8::EM_SCALEQ, 0>{F.q(), 768, 768, F.ssqz(), 0, nullptr, nullptr, nullptr, nullptr}, G, c);
        run_gemm(F.ldsp, pg8::Gemm{F.z() + Z_CKV, F.wl(l, W_UKV), M, 1024, 256, ZP, 128, 0}, pg8::EpiG<pg8::EM_SCALEKV, 0>{F.kv(), 1024, 1024, F.ssqz(), 0, nullptr, nullptr, nullptr, nullptr}, G, c);
        job_krope(F);
#endif
        return;
    }
#ifdef NAIVE_ATTN
    if (s == 4) { phase_attn_naive(F); return; }
#else
    if (s == 4) { phase_attn_fast(F, l);
#ifdef DUP_ATT
        phase_attn_fast(F, l + 2);
#endif
        return; }
#endif
    if (s == 5) { run_gemm(F.ldsp, pg8::Gemm{F.mix(), F.wl(l, W_O), M, DM, 1024, DM, 128, 0}, pg8::EpiG<pg8::EM_RES, 1>{F.hb(), DM, DM, nullptr, 0, nullptr, F.h(), F.ssqh(), l == 0 ? F.gin(0) : (const float*)F.h()}, G, c); return; }
    if (s == 6 || s == 16) { phase_stat_h(F); return; }
    if (s == 7) {
#ifdef CONV256
        run_gemm(F.ldsp, pg8::Gemm{F.hb(), F.wl(l, W_UP), M, NUP, 1024, DM, 128, 0},
                 pg8::EpiConv<256>{F.gact(), F.ssqh(), F.gin(16) + (size_t)l * 3 * NUP, F.gin(17) + (size_t)l * NUP, (PG8_LAS float*)(F.ldsp + 131072)}, G, c);
        return;
#endif
        run_gemm(F.ldsp, pg8::Gemm{F.hb(), F.wl(l, W_UP), 68 * 256, NUP, 1024, DM, 128, 2},
                 pg8::EpiConv<254>{F.gact(), F.ssqh(), F.gin(16) + (size_t)l * 3 * NUP, F.gin(17) + (size_t)l * NUP, (PG8_LAS float*)(F.ldsp + 131072)}, G, c);
#ifdef DUP_UP
        run_gemm(F.ldsp, pg8::Gemm{F.hb(), F.wl(l, W_UP), 68 * 256, NUP, 1024, DM, 128, 2},
                 pg8::EpiConv<254>{F.gact(), F.ssqh(), F.gin(16) + (size_t)l * 3 * NUP, F.gin(17) + (size_t)l * NUP, (PG8_LAS float*)(F.ldsp + 131072)}, G, c);
#endif
        return;
    }
    if (s == 15 && l == 1) {
        run_gemm(F.ldsp, pg8::Gemm{F.gact(), F.wl(l, W_DN), M, DM, DFF, DFF, 128, 0},
                 pg8::EpiFinal{(const float*)F.h(), F.h(), F.gin(19), F.ssqh(), (unsigned*)(F.ws + WS_CTL + 32768), (PG8_LAS unsigned*)(F.ldsp + 131072)}, G, c);
        return;
    }
    if (s == 15) { run_gemm(F.ldsp, pg8::Gemm{F.gact(), F.wl(l, W_DN), M, DM, DFF, DFF, 128, 0}, pg8::EpiG<pg8::EM_RES, 1>{F.hb(), DM, DM, nullptr, 0, nullptr, F.h(), F.ssqh(), (const float*)F.h()}, G, c); return; }
}

__global__ void __launch_bounds__(NT, 2) mk(Params p) {
    extern __shared__ __attribute__((aligned(16))) unsigned char lds_raw[];
    float* smem = (float*)lds_raw;
    cg::grid_group grid = cg::this_grid();
    Frame F; F.kp = (const Params __attribute__((address_space(4)))*)__builtin_amdgcn_kernarg_segment_ptr(); F.ws = p.ws; F.smem = smem; F.ldsp = (PG8_LAS unsigned char*)lds_raw; F.tid = threadIdx.x; F.lane = F.tid & 63; F.wave = F.tid >> 6;
    F.gw = blockIdx.x * 8 + F.wave; F.ngw = gridDim.x * 8;
    if (threadIdx.x < 2) ((PG8_LAS unsigned*)(F.ldsp + LDS_ST))[threadIdx.x] = 0u;
    __syncthreads();
    XcdBarrier bar = xcd_barrier_post((unsigned*)(p.ws + WS_CTL + 1024), (volatile PG8_LAS unsigned*)(F.ldsp + LDS_ST));
    for (int ph = p.ph_lo; ph < p.ph_hi; ++ph) {
        { __attribute__((address_space(1))) unsigned char* wsg = (__attribute__((address_space(1))) unsigned char*)F.ws; asm volatile("" : "+s"(wsg), "+s"(F.kp)); F.ws = (unsigned char*)wsg; }
        { int t_ = threadIdx.x; asm volatile("" : "+v"(t_)); F.tid = t_; F.lane = t_ & 63; F.wave = t_ >> 6; F.gw = blockIdx.x * 8 + F.wave; }
        run_phase(F, ph);
        if (ph + 1 < p.ph_hi) {
            if (ph < 0) grid.sync();
            xcd_barrier(bar);
        }
    }
}

extern "C" void kernel_launch(void* const* d_in, const int* in_sizes, int n_in, void* d_out, int out_size, void* d_ws, size_t ws_size, hipStream_t stream) {
    if (n_in != 20 || ws_size < WS_ENDALL) { fprintf(stderr, "kernel_launch: unexpected n_in %d / ws %zu\n", n_in, ws_size); return; }
    static int grid_blocks = 0;
    if (!grid_blocks) {
        int dev = 0, cus = 0, per_cu = 0;
        hipGetDevice(&dev);
        hipDeviceGetAttribute(&cus, hipDeviceAttributeMultiprocessorCount, dev);
        hipFuncSetAttribute((const void*)mk, hipFuncAttributeMaxDynamicSharedMemorySize, LDS_BYTES);
        hipOccupancyMaxActiveBlocksPerMultiprocessor(&per_cu, mk, NT, LDS_BYTES);
        if (per_cu < 1) per_cu = 1;
        if (per_cu > 1) per_cu = 1;
        grid_blocks = cus * per_cu;
    }
    Params p{};
    for (int i = 0; i < 20; ++i) p.in[i] = (const float*)d_in[i];
    p.out = (float*)d_out; p.ws = (unsigned char*)d_ws;
    {
        p.ph_lo = 0; p.ph_hi = NPH;
        hipMemsetAsync((char*)d_ws + WS_CTL, 0, 65536, stream);
        void* args[] = {&p};
        hipError_t e = hipLaunchCooperativeKernel((void*)mk, dim3(grid_blocks), dim3(NT), args, LDS_BYTES, stream);
        if (e != hipSuccess) { fprintf(stderr, "cooperative launch failed: %s (grid %d)\n", hipGetErrorString(e), grid_blocks); }
    }
}
```

```cpp
#include <hip/hip_runtime.h>
#include <hip/hip_cooperative_groups.h>
#include <stdint.h>
#include <cstdio>
namespace cg = cooperative_groups;

#define DI __device__ __forceinline__
typedef unsigned short bf16_t;
typedef short bf16x8 __attribute__((ext_vector_type(8)));
typedef float f32x4 __attribute__((ext_vector_type(4)));
typedef float f32x16 __attribute__((ext_vector_type(16)));
typedef unsigned u32x2 __attribute__((ext_vector_type(2)));
typedef unsigned u32x4 __attribute__((ext_vector_type(4)));
#define MFMA32(a, b, c) __builtin_amdgcn_mfma_f32_32x32x16_bf16((a), (b), (c), 0, 0, 0)

constexpr int NB = 4, S = 4096, M = NB * S, DM = 1024, ZP = 2048, NT = 512;
constexpr int DFF = 2816, NUP = 2 * DFF;
constexpr float EPS = 1e-6f;
constexpr int LDS_BYTES = 147456, LDS_ST = LDS_BYTES - 64;
constexpr int Z_CQ = 0, Z_KR = 384, Z_GT = 416, Z_CKV = 512, Z_QN = 768, Z_KC = 1280, Z_KS = 1408, Z_KW = 1536, Z_VC = 1664, Z_VS = 1792, Z_VW = 1920;
constexpr size_t MiB = 1024 * 1024;
constexpr size_t W_IN = 0, W_UQ = W_IN + (size_t)2048 * 1024 * 2, W_UKV = W_UQ + (size_t)768 * 384 * 2, W_C1K = W_UKV + (size_t)1024 * 256 * 2,
                 W_C1V = W_C1K + (size_t)256 * 2048 * 2, W_C2K = W_C1V + (size_t)256 * 2048 * 2, W_C2V = W_C2K + (size_t)256 * 128 * 2,
                 W_O = W_C2V + (size_t)256 * 128 * 2, W_UP = W_O + (size_t)1024 * 1024 * 2, W_DN = W_UP + (size_t)NUP * 1024 * 2,
                 W_END = W_DN + (size_t)1024 * DFF * 2;
constexpr size_t WL_STRIDE = 26 * MiB;
static_assert(W_END <= WL_STRIDE, "weights per layer");
constexpr size_t WS_A = 52 * MiB;
constexpr size_t WS_Z = WS_A, WS_Q = WS_A + 64 * MiB + 256 * 1024, WS_GACT = WS_A;
constexpr size_t WS_KV = 141 * MiB, WS_MIX = 173 * MiB, WS_HU = WS_KV;
constexpr size_t WS_HB = 205 * MiB + 64 * 1024;
constexpr size_t WS_MISC = 238 * MiB;
constexpr size_t WS_SSQH = WS_MISC, WS_SSQZ = WS_SSQH + 1 * MiB, WS_KR = WS_SSQZ + 2 * MiB, WS_HIDK = WS_KR + 1 * MiB, WS_HIDV = WS_HIDK + 1 * MiB,
                 WS_KCMP = WS_HIDV + 1 * MiB, WS_VCMP = WS_KCMP + 1 * MiB, WS_ROPE = WS_VCMP + 1 * MiB, WS_B1 = WS_ROPE + 1 * MiB, WS_CTL = WS_B1 + 64 * 1024,
                 WS_ENDALL = WS_CTL + 64 * 1024;
static_assert(WS_ENDALL <= 256 * MiB, "workspace");

struct Params {
    const float* in[20];
    float* out;
    unsigned char* ws;
    int ph_lo, ph_hi;
};

DI bf16_t f2bf(float x) { unsigned u = __float_as_uint(x); u += 0x7fffu + ((u >> 16) & 1u); return (bf16_t)(u >> 16); }
DI int tid_now() { int t = threadIdx.x; asm volatile("" : "+v"(t)); return t; }
DI float bf2f(bf16_t b) { return __uint_as_float(((unsigned)b) << 16); }
DI unsigned pk2(float lo, float hi) { return (unsigned)f2bf(lo) | ((unsigned)f2bf(hi) << 16); }
DI float wave_sum(float v) {
#pragma unroll
    for (int o = 1; o < 64; o <<= 1) v += __shfl_xor(v, o);
    return v;
}
DI float wave_max(float v) {
#pragma unroll
    for (int o = 1; o < 64; o <<= 1) v = fmaxf(v, __shfl_xor(v, o));
    return v;
}
DI float gelu_tanh(float x) { return 0.5f * x * (1.f + tanhf(0.7978845608028654f * (x + 0.044715f * x * x * x))); }
DI float rstd_h(const float* ssqh, int row) {
    const f32x4* p = (const f32x4*)(ssqh + (size_t)row * 16); float s = 0.f;
#pragma unroll
    for (int i = 0; i < 4; ++i) { f32x4 v = p[i]; s += (v[0] + v[1]) + (v[2] + v[3]); }
    return rsqrtf(s * (1.f / 1024.f) + EPS);
}
DI float rstd_q(const float* ssqz, int row) {
    const f32x4* p = (const f32x4*)(ssqz + (size_t)row * 24); float s = 0.f;
#pragma unroll
    for (int i = 0; i < 3; ++i) { f32x4 v = p[i]; s += (v[0] + v[1]) + (v[2] + v[3]); }
    return rsqrtf(s * (1.f / 384.f) + EPS);
}
DI float rstd_kv(const float* ssqz, int row) {
    const f32x4* p = (const f32x4*)(ssqz + (size_t)row * 24 + 16); float s = 0.f;
#pragma unroll
    for (int i = 0; i < 2; ++i) { f32x4 v = p[i]; s += (v[0] + v[1]) + (v[2] + v[3]); }
    return rsqrtf(s * (1.f / 256.f) + EPS);
}

namespace pg8 {
#define PG8_LAS __attribute__((address_space(3)))
typedef unsigned short bf16_t;
typedef short bf16x8 __attribute__((ext_vector_type(8)));
typedef float f32x4 __attribute__((ext_vector_type(4)));
typedef unsigned u32x4 __attribute__((ext_vector_type(4)));
constexpr int BM = 256, BK = 64, HALF = 128, HTB = HALF * BK * 2  , STAGE_BYTES = 8 * HTB, NXCD = 8, WGM = 8;

__host__ __device__ __forceinline__ int lds_byte(int r, int c) { const int st = (r >> 4) * 2 + (c >> 5), rr = r & 15, cc = c & 31, ob = rr * 64 + cc * 2; return st * 1024 + (ob ^ (((ob >> 9) & 1) << 5)); }
__host__ __device__ __forceinline__ void stage_rc(int b, int& R, int& C) { const int st = b / 1024, sb = b % 1024, swz = sb ^ (((sb >> 9) & 1) << 5); R = (st >> 1) * 16 + swz / 64; C = (st & 1) * 32 + (swz % 64) / 2; }
__host__ __device__ __forceinline__ int perm32(int rho) { const int n = rho >> 4, i = rho & 15; return 8 * (i >> 2) + 4 * n + (i & 3); }

struct Unit { int pm, pn; };
struct Gemm { const bf16_t* A; const bf16_t* Bt; int M, N, K; int lda; int kstepA; int cmp; };
__device__ __forceinline__ long long tileA_off(const Gemm& g, int pm) {
    if (g.cmp == 1) return (long long)(pm >> 1) * ((long long)4096 * 2048 * 2) + (long long)(pm & 1) * 128;
    if (g.cmp == 2) return ((long long)(pm / 17) * 4096 + 254 * (pm % 17) - 2) * (long long)(g.lda * 2);
    return (long long)pm * ((long long)BM * g.lda * 2); }

struct StaticOrder {
    int nM, nN, nwg, G, c;
    __host__ __device__ void init(int M, int N, int G_, int c_) { nM = M / BM; nN = N / BM; nwg = nM * nN; G = G_; c = c_; }
    __host__ __device__ bool next(int i, Unit& u) const {
        const long L = (long)i * G + c; if (L >= nwg) return false;
        int wgid = (int)L; { const int q = nwg / NXCD, r = nwg % NXCD, xcd = wgid % NXCD, off = wgid / NXCD; wgid = (xcd < r ? xcd * (q + 1) : r * (q + 1) + (xcd - r) * q) + off; }
        const int nig = WGM * nN, gid = wgid / nig, fm = gid * WGM, gsz = (nM - fm) < WGM ? (nM - fm) : WGM;
        u.pm = fm + ((wgid % nig) % gsz); u.pn = (wgid % nig) / gsz; return true;
    }
    __device__ __forceinline__ void a_ready(const Unit&) const {}
    __device__ __forceinline__ void done(const Unit&) const {}
};
__device__ __forceinline__ unsigned cvt_pk_bf16(float lo, float hi) { unsigned r; asm volatile("v_cvt_pk_bf16_f32 %0, %1, %2" : "=v"(r) : "v"(lo), "v"(hi)); return r; }
template <class Epi, class Sched, bool ALIGN_EPI = false, bool SP2 = false>
__device__ __forceinline__ void gemm_phase(PG8_LAS unsigned char* lds, const Gemm g, const Sched& S, const Epi& E) {
    int tid_ = threadIdx.x; asm volatile("" : "+v"(tid_));
    const int tid = tid_, wid = __builtin_amdgcn_readfirstlane(tid >> 6), lane = tid & 63, wr = wid >> 2, wc = wid & 3, fr = lane & 15, fq = lane >> 4;
    const int K = g.K, nt = K / BK;
    unsigned voffA[2], voffB[2];
#pragma unroll
    for (int i = 0; i < 2; ++i) { int R, C; stage_rc(tid * 16 + i * 8192, R, C); const int Rb = Epi::PERM ? ((R & ~31) + perm32(R & 31)) : R;
        voffA[i] = (unsigned)(R * g.lda + C) * 2u; voffB[i] = (unsigned)(Rb * K + C) * 2u; }
    const size_t kstepB = (size_t)(BK * 2), kstepA = (size_t)g.kstepA;
    const size_t hstepB = (size_t)HALF * K * 2, hstepA = (size_t)HALF * g.lda * 2;
    const size_t tstepB = 2 * hstepB;
    const unsigned ldsw = (unsigned)wid * 1024u;
    const int aoff = lds_byte(wr * 64 + fr, fq * 8), boff = lds_byte(wc * 32 + fr, fq * 8);
#define PG8_SA(b, h) (((b) * 2 + (h)) * HTB)
#define PG8_SB(b, h) ((4 + (b) * 2 + (h)) * HTB)
#define PG8_STAGE(bufoff, gbase, voff) do { _Pragma("unroll") for (int _i = 0; _i < 2; ++_i) \
        __builtin_amdgcn_global_load_lds((const unsigned*)((const char*)(gbase) + (voff)[_i]), (PG8_LAS unsigned*)(lds + (bufoff) + ldsw + _i * 8192), 16, 0, 0); } while (0)
#define PG8_LDA(dst, b, h) do { _Pragma("unroll") for (int m = 0; m < 4; ++m) _Pragma("unroll") for (int k = 0; k < 2; ++k) dst[m][k] = *(const PG8_LAS bf16x8*)(lds + PG8_SA(b, h) + aoff + m * 2048 + k * 1024); } while (0)
#define PG8_LDB(dst, b, h) do { _Pragma("unroll") for (int n = 0; n < 2; ++n) _Pragma("unroll") for (int k = 0; k < 2; ++k) dst[n][k] = *(const PG8_LAS bf16x8*)(lds + PG8_SB(b, h) + boff + n * 2048 + k * 1024); } while (0)
#define PG8_MMA(ai, bj, At, Bt) do { __builtin_amdgcn_s_setprio(1); _Pragma("unroll") for (int m = 0; m < 4; ++m) _Pragma("unroll") for (int n = 0; n < 2; ++n) _Pragma("unroll") for (int k = 0; k < 2; ++k) \
        acc[ai][bj][m][n] = __builtin_amdgcn_mfma_f32_16x16x32_bf16(Bt[n][k], At[m][k], acc[ai][bj][m][n], 0, 0, 0); __builtin_amdgcn_s_setprio(0); } while (0)
#define PG8_WAIT_V(n) asm volatile("s_waitcnt vmcnt(" #n ")" ::: "memory")
#define PG8_WAIT_L(n) asm volatile("s_waitcnt lgkmcnt(" #n ")" ::: "memory")
#define PG8_BAR __builtin_amdgcn_s_barrier()
#define PG8_SCHED __builtin_amdgcn_sched_barrier(0)
    Unit cur, nxt; int ui = 0;
    if (!S.next(0, cur)) return;
    f32x4 acc[2][2][4][2];
#pragma unroll
    for (int a = 0; a < 2; ++a)
#pragma unroll
        for (int b = 0; b < 2; ++b)
#pragma unroll
            for (int m = 0; m < 4; ++m)
#pragma unroll
                for (int n = 0; n < 2; ++n) acc[a][b][m][n] = (f32x4){0.f, 0.f, 0.f, 0.f};
    bf16x8 At[4][2], B0[2][2], B1[2][2];
    const char* cA = (const char*)g.A + tileA_off(g, cur.pm); const char* cB = (const char*)g.Bt + (size_t)cur.pn * tstepB;
    S.a_ready(cur);
    if constexpr (SP2) {
        PG8_STAGE(PG8_SB(0, 0), cB, voffB); PG8_STAGE(PG8_SB(0, 1), cB + hstepB, voffB); PG8_STAGE(PG8_SA(0, 0), cA, voffA); PG8_STAGE(PG8_SA(0, 1), cA + hstepA, voffA);
        if (wr == 1) PG8_BAR;
        PG8_WAIT_V(2); PG8_BAR;
        PG8_STAGE(PG8_SB(1, 0), cB + kstepB, voffB); PG8_STAGE(PG8_SA(1, 0), cA + kstepA, voffA); PG8_STAGE(PG8_SB(1, 1), cB + hstepB + kstepB, voffB);
        PG8_WAIT_V(6); PG8_BAR;
    } else {
        PG8_STAGE(PG8_SB(0, 0), cB, voffB); PG8_STAGE(PG8_SA(0, 0), cA, voffA); PG8_STAGE(PG8_SB(0, 1), cB + hstepB, voffB); PG8_STAGE(PG8_SA(0, 1), cA + hstepA, voffA);
        if (wr == 1) PG8_BAR;
        PG8_WAIT_V(4); PG8_BAR;
        PG8_STAGE(PG8_SB(1, 0), cB + kstepB, voffB); PG8_STAGE(PG8_SA(1, 0), cA + kstepA, voffA); PG8_STAGE(PG8_SB(1, 1), cB + hstepB + kstepB, voffB);
        PG8_WAIT_V(6); PG8_BAR;
    }
    for (;;) {
        const bool has_next = S.next(ui + 1, nxt);
        const char* nA = has_next ? (const char*)g.A + tileA_off(g, nxt.pm) : cA; const char* nB = has_next ? (const char*)g.Bt + (size_t)nxt.pn * tstepB : cB;
        for (int t = 0; t < nt; t += 2) {
            const bool last = (t == nt - 2);
            const char* a1 = cA + (size_t)(t + 1) * kstepA;
            const char* a2 = last ? nA : cA + (size_t)(t + 2) * kstepA; const char* b2 = last ? nB : cB + (size_t)(t + 2) * kstepB;
            const char* a3 = a2 + kstepA; const char* b3 = b2 + kstepB;
            if (last && has_next) S.a_ready(nxt);
            if constexpr (SP2) {
            PG8_LDB(B0, 0, 0); PG8_LDB(B1, 0, 1); PG8_SCHED; PG8_LDA(At, 0, 0); PG8_STAGE(PG8_SA(1, 1), a1 + hstepA, voffA);
            PG8_WAIT_V(8); PG8_WAIT_L(0); PG8_BAR; PG8_MMA(0, 0, At, B0); PG8_MMA(0, 1, At, B1); PG8_BAR; PG8_SCHED;
            PG8_LDA(At, 0, 1); PG8_STAGE(PG8_SB(0, 0), b2, voffB); PG8_STAGE(PG8_SB(0, 1), b2 + hstepB, voffB); PG8_STAGE(PG8_SA(0, 0), a2, voffA);
            PG8_WAIT_V(8); PG8_WAIT_L(0); PG8_BAR; PG8_MMA(1, 0, At, B0); PG8_MMA(1, 1, At, B1); PG8_BAR; PG8_SCHED;
            PG8_LDB(B0, 1, 0); PG8_LDB(B1, 1, 1); PG8_SCHED; PG8_LDA(At, 1, 0); PG8_STAGE(PG8_SA(0, 1), a2 + hstepA, voffA);
            PG8_WAIT_V(8); PG8_WAIT_L(0); PG8_BAR; PG8_MMA(0, 0, At, B0); PG8_MMA(0, 1, At, B1); PG8_BAR; PG8_SCHED;
            PG8_LDA(At, 1, 1); PG8_STAGE(PG8_SB(1, 0), b3, voffB); PG8_STAGE(PG8_SB(1, 1), b3 + hstepB, voffB); PG8_STAGE(PG8_SA(1, 0), a3, voffA);
            PG8_WAIT_V(8); PG8_WAIT_L(0); PG8_BAR; PG8_MMA(1, 0, At, B0); PG8_MMA(1, 1, At, B1); PG8_BAR; PG8_SCHED;
            } else {
            PG8_LDB(B0, 0, 0); PG8_SCHED; PG8_LDA(At, 0, 0); PG8_STAGE(PG8_SA(1, 1), a1 + hstepA, voffA);
            PG8_WAIT_L(8); PG8_BAR; PG8_WAIT_L(0); PG8_MMA(0, 0, At, B0); PG8_BAR; PG8_SCHED;
            PG8_LDB(B1, 0, 1); PG8_STAGE(PG8_SB(0, 0), b2, voffB);
            PG8_BAR; PG8_WAIT_L(0); PG8_MMA(0, 1, At, B1); PG8_BAR;
            PG8_LDA(At, 0, 1); PG8_STAGE(PG8_SA(0, 0), a2, voffA);
            PG8_BAR; PG8_WAIT_L(0); PG8_MMA(1, 0, At, B0); PG8_BAR; PG8_SCHED;
            PG8_STAGE(PG8_SB(0, 1), b2 + hstepB, voffB);
            PG8_WAIT_V(6); PG8_BAR; PG8_MMA(1, 1, At, B1); PG8_BAR;
            PG8_LDB(B0, 1, 0); PG8_SCHED; PG8_LDA(At, 1, 0); PG8_STAGE(PG8_SA(0, 1), a2 + hstepA, voffA);
            PG8_WAIT_L(8); PG8_BAR; PG8_WAIT_L(0); PG8_MMA(0, 0, At, B0); PG8_BAR; PG8_SCHED;
            PG8_LDB(B1, 1, 1); PG8_STAGE(PG8_SB(1, 0), b3, voffB);
            PG8_BAR; PG8_WAIT_L(0); PG8_MMA(0, 1, At, B1); PG8_BAR;
            PG8_LDA(At, 1, 1); PG8_STAGE(PG8_SA(1, 0), a3, voffA);
            PG8_BAR; PG8_WAIT_L(0); PG8_MMA(1, 0, At, B0); PG8_BAR; PG8_SCHED;
            PG8_STAGE(PG8_SB(1, 1), b3 + hstepB, voffB);
            PG8_WAIT_V(6); PG8_BAR; PG8_MMA(1, 1, At, B1); PG8_BAR;
            }
        }
        if constexpr (ALIGN_EPI) { if (wr == 0) PG8_BAR; }
        if constexpr (!Epi::AFTER_DRAIN) { E(acc, cur, wr, wc, fr, fq); S.done(cur); }
        if (!has_next) break;
#pragma unroll
        for (int a = 0; a < 2; ++a)
#pragma unroll
            for (int b = 0; b < 2; ++b)
#pragma unroll
                for (int m = 0; m < 4; ++m)
#pragma unroll
                    for (int n = 0; n < 2; ++n) acc[a][b][m][n] = (f32x4){0.f, 0.f, 0.f, 0.f};
        cur = nxt; cA = nA; cB = nB; ++ui;
        if constexpr (ALIGN_EPI) { if (wr == 1) PG8_BAR; }
    }
    PG8_WAIT_V(0);
    if constexpr (!ALIGN_EPI) { if (wr == 0) PG8_BAR; }
    PG8_BAR;
    if constexpr (Epi::AFTER_DRAIN) { E.fused(acc, cur, wr, wc, fr, fq, lds, wid, lane); S.done(cur); }
#undef PG8_SA
#undef PG8_SB
#undef PG8_STAGE
#undef PG8_LDA
#undef PG8_LDB
#undef PG8_MMA
#undef PG8_WAIT_V
#undef PG8_WAIT_L
#undef PG8_BAR
#undef PG8_SCHED
}
}

namespace pg8 {
enum { EM_SCALEH = 0, EM_SCALEQ = 1, EM_SCALEKV = 2, EM_GELU = 3, EM_PLAIN = 4, EM_RES = 5 };
template <int MODE, int STATS  > struct EpiG {
    static constexpr bool PERM = true, AFTER_DRAIN = false;
    bf16_t* O; int ldc; int nvalid; const float* ssq_in; int rowoff; const float* bias; float* H; float* ssq_out; const float* Hin;
    __device__ __forceinline__ void operator()(const f32x4 (&acc)[2][2][4][2], const Unit& u, int wr, int wc, int fr, int fq) const {
        const int row0 = u.pm * BM + wr * 64 + fr, col0 = u.pn * BM + wc * 32 + 8 * fq;
#pragma unroll
        for (int ai = 0; ai < 2; ++ai)
#pragma unroll
            for (int m = 0; m < 4; ++m) {
                const int row = row0 + ai * HALF + m * 16;
                float sc = 1.f;
                if (MODE == EM_SCALEH) sc = ::rstd_h(ssq_in, row + rowoff);
                if (MODE == EM_SCALEQ) sc = ::rstd_q(ssq_in, row);
                if (MODE == EM_SCALEKV) sc = ::rstd_kv(ssq_in, row);
                float ss[2] = {0.f, 0.f};
#pragma unroll
                for (int bj = 0; bj < 2; ++bj) {
                    const int col = col0 + bj * HALF;
                    f32x4 v0 = acc[ai][bj][m][0] * sc, v1 = acc[ai][bj][m][1] * sc;
                    if (MODE == EM_GELU) { if (col < nvalid) { const f32x4 b0 = *(const f32x4*)(bias + col), b1 = *(const f32x4*)(bias + col + 4);
#pragma unroll
                        for (int i = 0; i < 4; ++i) { v0[i] = ::gelu_tanh(v0[i] + b0[i]); v1[i] = ::gelu_tanh(v1[i] + b1[i]); } } }
                    if (MODE == EM_RES) { const f32x4* hi = (const f32x4*)(Hin + (size_t)row * 1024 + col); f32x4* hp = (f32x4*)(H + (size_t)row * 1024 + col); v0 += hi[0]; v1 += hi[1]; hp[0] = v0; hp[1] = v1; }
                    if (STATS) ss[bj] = ((v0[0] * v0[0] + v0[1] * v0[1]) + (v0[2] * v0[2] + v0[3] * v0[3])) + ((v1[0] * v1[0] + v1[1] * v1[1]) + (v1[2] * v1[2] + v1[3] * v1[3]));
                    if (col < nvalid) { u32x4 w; w.x = cvt_pk_bf16(v0[0], v0[1]); w.y = cvt_pk_bf16(v0[2], v0[3]); w.z = cvt_pk_bf16(v1[0], v1[1]); w.w = cvt_pk_bf16(v1[2], v1[3]);
                        *(u32x4*)(O + (size_t)row * ldc + col) = w; }
                }
                if (STATS == 1) { float t = ss[0] + ss[1]; t += __shfl_xor(t, 16); t += __shfl_xor(t, 32); if (fq == 0) ssq_out[(size_t)row * 16 + u.pn * 4 + wc] = t; }
                if (STATS == 2) { if (u.pn <= 2) { float t0 = ss[0], t1 = ss[1]; t0 += __shfl_xor(t0, 16); t0 += __shfl_xor(t0, 32); t1 += __shfl_xor(t1, 16); t1 += __shfl_xor(t1, 32);
                    if (fq == 0) { ssq_out[(size_t)row * 24 + u.pn * 8 + wc] = t0; ssq_out[(size_t)row * 24 + u.pn * 8 + 4 + wc] = t1; } } }
            }
    }
};

typedef unsigned u32x2_t __attribute__((ext_vector_type(2)));
template <int CTRL> __device__ __forceinline__ float dppf(float v) { return __int_as_float(__builtin_amdgcn_update_dpp(0, __float_as_int(v), CTRL, 0xf, 0xf, true)); }
#define DPPF(v, ctrl) dppf<ctrl>(v)
template <int STRIDE> struct EpiConv {
    static constexpr bool PERM = true, AFTER_DRAIN = false;
    bf16_t* Gt; const float* ssqh; const float* cw; const float* cb; PG8_LAS float* xch;
    __device__ __forceinline__ void operator()(f32x4 (&acc)[2][2][4][2], const Unit& u, int wr, int wc, int fr_in, int fq_in) const {
        int fr = fr_in, fq = fq_in; asm volatile("" : "+v"(fr), "+v"(fq));
        const int b = STRIDE == 254 ? u.pm / 17 : u.pm / 16, tl0 = STRIDE == 254 ? 254 * (u.pm % 17) - 2 : 256 * (u.pm % 16), wid = wr * 4 + wc;
#pragma unroll
        for (int ai = 0; ai < 2; ++ai)
#pragma unroll
            for (int m = 0; m < 4; ++m) {
                const int tl = tl0 + ai * HALF + wr * 64 + m * 16 + fr; float sc = 0.f;
                if (tl >= 0 && tl < 4096) sc = ::rstd_h(ssqh, b * 4096 + tl);
#pragma unroll
                for (int bj = 0; bj < 2; ++bj)
#pragma unroll
                    for (int n = 0; n < 2; ++n) acc[ai][bj][m][n] *= sc;
            }
        if (fr >= 14) {
#pragma unroll
            for (int ai = 0; ai < 2; ++ai)
#pragma unroll
                for (int bj = 0; bj < 2; ++bj)
#pragma unroll
                    for (int n = 0; n < 2; ++n) *(PG8_LAS f32x4*)(xch + ((((wid * 2 + ai) * 4 + fq) * 2 + (fr - 14)) * 4 + bj * 2 + n) * 4) = acc[ai][bj][3][n];
        }
        asm volatile("s_waitcnt lgkmcnt(0)" ::: "memory"); __builtin_amdgcn_s_barrier(); asm volatile("" ::: "memory");
        const int chl = u.pn * 128 + wc * 32 + 8 * fq;
#pragma unroll
        for (int n = 0; n < 2; ++n) {
            const int ch = chl + 4 * n;
            const float* cwv = cw + ch; const float* cbv = cb + ch; asm volatile("" : "+v"(cwv), "+v"(cbv));
            const f32x4 wg0 = *(const f32x4*)(cwv), wg1 = *(const f32x4*)(cwv + 5632), wg2 = *(const f32x4*)(cwv + 2 * 5632), bg = *(const f32x4*)(cbv);
            const f32x4 wu0 = *(const f32x4*)(cwv + 2816), wu1 = *(const f32x4*)(cwv + 5632 + 2816), wu2 = *(const f32x4*)(cwv + 2 * 5632 + 2816), bu = *(const f32x4*)(cbv + 2816);
#pragma unroll
            for (int ai = 0; ai < 2; ++ai)
#pragma unroll
                for (int m = 0; m < 4; ++m) {
                    f32x4 pg = {0.f, 0.f, 0.f, 0.f}, pu = {0.f, 0.f, 0.f, 0.f};
                    if (m > 0) { pg = acc[ai][0][m - 1][n]; pu = acc[ai][1][m - 1][n]; }
                    else if (wr == 1 || ai == 1) {
                        const int sw = (wr == 1 ? 0 : 4) + wc, sai = wr == 1 ? ai : 0;
                        if (fr >= 14) { const PG8_LAS float* xp = xch + ((((sw * 2 + sai) * 4 + fq) * 2 + (fr - 14)) * 4 + n) * 4; pg = *(const PG8_LAS f32x4*)xp; pu = *(const PG8_LAS f32x4*)(xp + 8); }
                    }
                    const f32x4 cg = acc[ai][0][m][n], cu = acc[ai][1][m][n];
                    f32x4 o;
#pragma unroll
                    for (int k = 0; k < 4; ++k) {
                        float hg = fmaf(wg2[k], cg[k], bg[k]), hu = fmaf(wu2[k], cu[k], bu[k]);
                        {
                            const float cgk = cg[k], pgk = pg[k], cuk = cu[k], puk = pu[k], g1w = wg1[k], g0w = wg0[k], u1w = wu1[k], u0w = wu0[k];
                            asm volatile("s_nop 1\n\t"
                                         "v_fmac_f32_dpp %0, %2, %4 row_shr:1 row_mask:0xf bank_mask:0xf bound_ctrl:1\n\t"
                                         "v_fmac_f32_dpp %1, %6, %8 row_shr:1 row_mask:0xf bank_mask:0xf bound_ctrl:1\n\t"
                                         "v_fmac_f32_dpp %0, %3, %4 row_shl:15 row_mask:0xf bank_mask:0xf bound_ctrl:1\n\t"
                                         "v_fmac_f32_dpp %1, %7, %8 row_shl:15 row_mask:0xf bank_mask:0xf bound_ctrl:1\n\t"
                                         "v_fmac_f32_dpp %0, %2, %5 row_shr:2 row_mask:0xf bank_mask:0xf bound_ctrl:1\n\t"
                                         "v_fmac_f32_dpp %1, %6, %9 row_shr:2 row_mask:0xf bank_mask:0xf bound_ctrl:1\n\t"
                                         "v_fmac_f32_dpp %0, %3, %5 row_shl:14 row_mask:0xf bank_mask:0xf bound_ctrl:1\n\t"
                                         "v_fmac_f32_dpp %1, %7, %9 row_shl:14 row_mask:0xf bank_mask:0xf bound_ctrl:1"
                                         : "+v"(hg), "+v"(hu) : "v"(cgk), "v"(pgk), "v"(g1w), "v"(g0w), "v"(cuk), "v"(puk), "v"(u1w), "v"(u0w));
                        }
                        o[k] = hg * __builtin_amdgcn_rcpf(1.f + __builtin_amdgcn_exp2f(-1.4426950408889634f * hg)) * hu;
                    }
                    const int lr = ai * HALF + wr * 64 + m * 16 + fr, tl = tl0 + lr;
                    if (lr >= (STRIDE == 254 ? 2 : 0) && tl < 4096) { u32x2_t w; w.x = cvt_pk_bf16(o[0], o[1]); w.y = cvt_pk_bf16(o[2], o[3]); *(u32x2_t*)(Gt + (size_t)(b * 4096 + tl) * 2816 + ch) = w; }
                }
        }
    }
};

struct EpiFinal {
    static constexpr bool PERM = true, AFTER_DRAIN = false;
    const float* Hin; float* Out; const float* gain; float* part; unsigned* cnt; PG8_LAS unsigned* flag;
    __device__ __forceinline__ void operator()(f32x4 (&acc)[2][2][4][2], const Unit& u, int wr, int wc, int fr, int fq) const {
        const int row0 = u.pm * BM + wr * 64 + fr, col0 = u.pn * BM + wc * 32 + 8 * fq;
#pragma unroll
        for (int ai = 0; ai < 2; ++ai)
#pragma unroll
            for (int m = 0; m < 4; ++m) {
                const int row = row0 + ai * HALF + m * 16; float ss = 0.f;
#pragma unroll
                for (int bj = 0; bj < 2; ++bj) { const f32x4* hi = (const f32x4*)(Hin + (size_t)row * 1024 + col0 + bj * HALF);
                    const f32x4 v0 = acc[ai][bj][m][0] + hi[0], v1 = acc[ai][bj][m][1] + hi[1]; acc[ai][bj][m][0] = v0; acc[ai][bj][m][1] = v1;
                    ss += ((v0[0] * v0[0] + v0[1] * v0[1]) + (v0[2] * v0[2] + v0[3] * v0[3])) + ((v1[0] * v1[0] + v1[1] * v1[1]) + (v1[2] * v1[2] + v1[3] * v1[3])); }
                ss += __shfl_xor(ss, 16); ss += __shfl_xor(ss, 32);
                if (fq == 0) __hip_atomic_store(part + (size_t)row * 16 + u.pn * 4 + wc, ss, __ATOMIC_RELAXED, __HIP_MEMORY_SCOPE_AGENT);
            }
        asm volatile("s_waitcnt vmcnt(0)" ::: "memory");
        unsigned* pc = cnt + 16 * u.pm;
        if (fr == 0 && fq == 0) __hip_atomic_fetch_add(pc, 1u, __ATOMIC_RELAXED, __HIP_MEMORY_SCOPE_AGENT);
        if (wr == 0 && wc == 0) {
            unsigned spins = 0;
            while (__hip_atomic_load(pc, __ATOMIC_RELAXED, __HIP_MEMORY_SCOPE_AGENT) < 32u && ++spins < (1u << 22)) __builtin_amdgcn_s_sleep(2);
        }
        asm volatile("s_waitcnt vmcnt(0) lgkmcnt(0)" ::: "memory"); __builtin_amdgcn_s_barrier(); asm volatile("" ::: "memory");
        __builtin_amdgcn_fence(__ATOMIC_ACQUIRE, "agent");
#pragma unroll
        for (int ai = 0; ai < 2; ++ai)
#pragma unroll
            for (int m = 0; m < 4; ++m) {
                const int row = row0 + ai * HALF + m * 16; float sq = 0.f;
#pragma unroll
                for (int i = 0; i < 4; ++i) sq += __hip_atomic_load(part + (size_t)row * 16 + 4 * fq + i, __ATOMIC_RELAXED, __HIP_MEMORY_SCOPE_AGENT);
                sq += __shfl_xor(sq, 16); sq += __shfl_xor(sq, 32);
                const float rs = rsqrtf(sq * (1.f / 1024.f) + 1e-6f);
#pragma unroll
                for (int bj = 0; bj < 2; ++bj) { const int col = col0 + bj * HALF; const f32x4 g0 = *(const f32x4*)(gain + col), g1 = *(const f32x4*)(gain + col + 4);
                    f32x4* op = (f32x4*)(Out + (size_t)row * 1024 + col); op[0] = acc[ai][bj][m][0] * rs * g0; op[1] = acc[ai][bj][m][1] * rs * g1; }
            }
    }
};
}
template <class Epi> __device__ __forceinline__ void run_gemm(PG8_LAS unsigned char* lds, const pg8::Gemm& g, const Epi& E, int G, int c) {
    pg8::StaticOrder So; So.init(g.M, g.N, G, c);
    pg8::gemm_phase<Epi, pg8::StaticOrder, true, true>(lds, g, So, E);
}

struct MapZ { DI int operator()(int n) const {
    if (n < 384) return n; if (n < 416) return 640 + (n - 384); if (n < 440) return 1952 + (n - 416); if (n < 512) return -1;
    if (n < 768) return 384 + (n - 512); if (n < 1280) return 672 + (n - 768); if (n < 1408) return 1184 + (n - 1280);
    if (n < 1536) return 1440 + (n - 1408); if (n < 1664) return 1696 + (n - 1536); if (n < 1792) return 1312 + (n - 1664);
    if (n < 1920) return 1568 + (n - 1792); return 1824 + (n - 1920); } };
struct MapUQ { DI int operator()(int n) const { if (n < 512) return (n >> 6) * 96 + (n & 63); n -= 512; return (n >> 5) * 96 + 64 + (n & 31); } };
struct MapUKV { DI int operator()(int n) const { if (n < 512) return (n >> 6) * 128 + (n & 63); n -= 512; return (n >> 6) * 128 + 64 + (n & 63); } };
struct MapUP { DI int operator()(int n) const { const int pn = n >> 8, j = n & 255; return j < 128 ? 128 * pn + j : DFF + 128 * pn + (j - 128); } };
struct MapId { int nvalid; DI int operator()(int n) const { return n < nvalid ? n : -1; } };

template <class Map>
DI void wconv(const float* __restrict__ W, int K, int Nsrc, const float* __restrict__ gain, bf16_t* __restrict__ dst, int Ndst, Map map, float* tile) {
    const int nkt = K / 64, ntiles = nkt * (Ndst / 64); const int tid = tid_now();
    const int kk0 = tid >> 4, nn4 = (tid & 15) * 4, nw = tid >> 3, cw = tid & 7;
    int it = blockIdx.x; if (it >= ntiles) return;
    f32x4 a0, a1, b0 = {0.f, 0.f, 0.f, 0.f}, b1 = {0.f, 0.f, 0.f, 0.f};
#define WCONV_LOAD(IT, R0, R1) do { const int kt_ = (IT) % nkt, nt_ = (IT) / nkt, k0_ = kt_ * 64, n0_ = nt_ * 64; const int src_ = map(n0_ + nn4); \
        R0 = (f32x4){0.f, 0.f, 0.f, 0.f}; R1 = R0; \
        if (src_ >= 0) { R0 = *(const f32x4*)(W + (size_t)(k0_ + kk0) * Nsrc + src_); R1 = *(const f32x4*)(W + (size_t)(k0_ + kk0 + 32) * Nsrc + src_); \
            if (gain) { R0 *= gain[k0_ + kk0]; R1 *= gain[k0_ + kk0 + 32]; } } } while (0)
    WCONV_LOAD(it, a0, a1);
    for (;;) {
        const int nit = it + gridDim.x;
        __syncthreads();
#pragma unroll
        for (int e = 0; e < 4; ++e) { tile[kk0 * 65 + nn4 + e] = a0[e]; tile[(kk0 + 32) * 65 + nn4 + e] = a1[e]; }
        if (nit < ntiles) WCONV_LOAD(nit, b0, b1);
        __syncthreads();
        { const int kt = it % nkt, nt = it / nkt, k0 = kt * 64, n0 = nt * 64;
          const float* tp = tile + (8 * cw) * 65 + nw;
          u32x4 w; w.x = pk2(tp[0], tp[65]); w.y = pk2(tp[2 * 65], tp[3 * 65]); w.z = pk2(tp[4 * 65], tp[5 * 65]); w.w = pk2(tp[6 * 65], tp[7 * 65]);
          *(u32x4*)(dst + (size_t)(n0 + nw) * K + k0 + 8 * cw) = w; }
        if (nit >= ntiles) break;
        a0 = b0; a1 = b1; it = nit;
    }
#undef WCONV_LOAD
}

template <class AF, class Epi>
DI void ngemm(AF af, const bf16_t* __restrict__ Bt, int ldb, int Mr, int N, int K, Epi epi, bool local = false) {
    const int tid = tid_now(), lane = tid & 63, wv = tid >> 6, r = lane & 31, h = lane >> 5;
    const int ntn = N / 64, ntm = Mr / 64; const int gw = local ? wv : blockIdx.x * 8 + wv, ngw = local ? 8 : gridDim.x * 8;
    for (int t = gw; t < ntn * ntm; t += ngw) {
        const int tn = t % ntn, tm = t / ntn, m0 = tm * 64, n0 = tn * 64;
        f32x16 acc[2][2];
#pragma unroll
        for (int a = 0; a < 2; ++a)
#pragma unroll
            for (int b = 0; b < 2; ++b)
#pragma unroll
                for (int i = 0; i < 16; ++i) acc[a][b][i] = 0.f;
        for (int k0 = 0; k0 < K; k0 += 16) {
            bf16x8 a[2], b[2];
#pragma unroll
            for (int mi = 0; mi < 2; ++mi) a[mi] = *(const bf16x8*)af(m0 + mi * 32 + r, k0 + 8 * h);
#pragma unroll
            for (int ni = 0; ni < 2; ++ni) b[ni] = *(const bf16x8*)(Bt + (size_t)(n0 + ni * 32 + r) * ldb + k0 + 8 * h);
#pragma unroll
            for (int mi = 0; mi < 2; ++mi)
#pragma unroll
                for (int ni = 0; ni < 2; ++ni) acc[mi][ni] = MFMA32(b[ni], a[mi], acc[mi][ni]);
        }
#pragma unroll
        for (int mi = 0; mi < 2; ++mi) {
            const int row = m0 + mi * 32 + r; const float ctx = epi.prep(row);
#pragma unroll
            for (int ni = 0; ni < 2; ++ni)
#pragma unroll
                for (int g = 0; g < 4; ++g) {
                    f32x4 v = {acc[mi][ni][4 * g], acc[mi][ni][4 * g + 1], acc[mi][ni][4 * g + 2], acc[mi][ni][4 * g + 3]};
                    epi.store(row, n0 + ni * 32 + 8 * g + 4 * h, v, ctx);
                }
        }
    }
}
struct APlain { const bf16_t* A; size_t lda; DI const bf16_t* operator()(int row, int k) const { return A + (size_t)row * lda + k; } };
struct ACmp { const bf16_t* z; int col0; DI const bf16_t* operator()(int row, int k) const {
    const int bg = row >> 8, n = row & 255, b = bg >> 1, g = bg & 1; return z + (size_t)(b * S + 16 * n + (k >> 6)) * ZP + col0 + g * 64 + (k & 63); } };

DI void st_bf4(bf16_t* p, f32x4 v) { u32x2 w; w.x = pk2(v[0], v[1]); w.y = pk2(v[2], v[3]); *(u32x2*)p = w; }
struct EpiScaleH { bf16_t* O; int ldc; const float* ssqh; int rowoff;
    DI float prep(int row) const { return rstd_h(ssqh, row + rowoff); }
    DI void store(int row, int col, f32x4 v, float c) const { st_bf4(O + (size_t)row * ldc + col, v * c); } };
struct EpiScaleQ { bf16_t* O; int ldc; const float* ssqz; int kv;
    DI float prep(int row) const { return kv ? rstd_kv(ssqz, row) : rstd_q(ssqz, row); }
    DI void store(int row, int col, f32x4 v, float c) const { st_bf4(O + (size_t)row * ldc + col, v * c); } };
struct EpiGelu { bf16_t* O; int ldc; const float* bias;
    DI float prep(int) const { return 0.f; }
    DI void store(int row, int col, f32x4 v, float) const { f32x4 o; for (int i = 0; i < 4; ++i) o[i] = gelu_tanh(v[i] + bias[col + i]); st_bf4(O + (size_t)row * ldc + col, o); } };
struct EpiPlain { bf16_t* O; int ldc;
    DI float prep(int) const { return 0.f; }
    DI void store(int row, int col, f32x4 v, float) const { st_bf4(O + (size_t)row * ldc + col, v); } };
struct EpiRes { float* H; bf16_t* HB;
    DI float prep(int) const { return 0.f; }
    DI void store(int row, int col, f32x4 v, float) const { f32x4* hp = (f32x4*)(H + (size_t)row * DM + col); f32x4 o = *hp + v; *hp = o; st_bf4(HB + (size_t)row * DM + col, o); } };

#define LAS PG8_LAS
#define XB_TMO      128
#define XB_XCNT(j)  (256  + 64 * (j))
#define XB_XSUB(j)  (1280 + 64 * (j))
#define XB_XGEN(j)  (2304 + 64 * (j))
#define XB_TOP      3328
#define XB_TOPGEN   3392
#define XCD_BAR_WORDS 3456
#define XB_SPIN_CAP (1u << 22)

__device__ __forceinline__ unsigned xb_ld(unsigned* p)              { return __hip_atomic_load(p, __ATOMIC_RELAXED, __HIP_MEMORY_SCOPE_AGENT); }
__device__ __forceinline__ unsigned xb_add(unsigned* p, unsigned v) { return __hip_atomic_fetch_add(p, v, __ATOMIC_RELAXED, __HIP_MEMORY_SCOPE_AGENT); }
__device__ __forceinline__ unsigned xb_xcc_id() { return (unsigned)__builtin_amdgcn_s_getreg((3 << 11) | 20) & 0xFu; }
#define XB_SPIN(cond, bar) do { unsigned _sp = 0; while (cond) { __builtin_amdgcn_s_sleep(1); \
    if ((++_sp & 255u) == 0u) { if (xb_ld(&(bar)[XB_TMO])) break; if (_sp > XB_SPIN_CAP) { atomicAdd(&(bar)[XB_TMO], 1u); break; } } } } while (0)

struct XcdBarrier {
    unsigned* bar; unsigned x;
    volatile LAS unsigned* st;
};

__device__ __forceinline__ XcdBarrier xcd_barrier_post(unsigned* bar, volatile LAS unsigned* st) {
    XcdBarrier b; b.bar = bar; b.x = xb_xcc_id(); b.st = st;
    if (threadIdx.x == 0) (void)xb_add(&bar[XB_XCNT(b.x)], 1u);
    return b;
}
__device__ __forceinline__ void xcd_barrier_complete(unsigned* bar, unsigned x, unsigned& nloc, unsigned& nx) {
    const unsigned G = gridDim.x * gridDim.y * gridDim.z;
    unsigned sum, cnt, mine, sp = 0u;
    for (;;) {
        sum = 0u; cnt = 0u; mine = 0u;
#pragma unroll
        for (unsigned j = 0; j < 16; ++j) { const unsigned c = xb_ld(&bar[XB_XCNT(j)]); sum += c; cnt += (c > 0u) ? 1u : 0u; mine = (j == x) ? c : mine; }
        if (sum == G) break;
        __builtin_amdgcn_s_sleep(1);
        if ((++sp & 255u) == 0u) { if (xb_ld(&bar[XB_TMO])) break; if (sp > XB_SPIN_CAP) { atomicAdd(&bar[XB_TMO], 1u); break; } }
    }
    nloc = mine > 0u ? mine : 1u; nx = cnt > 0u ? cnt : 1u;
}

__device__ __forceinline__ void xcd_barrier(const XcdBarrier& b) {
    asm volatile("s_waitcnt vmcnt(0)" ::: "memory");
    __syncthreads();
    if (threadIdx.x == 0) {
        unsigned* bar = b.bar;
        __builtin_amdgcn_s_waitcnt(0);
        unsigned nloc = b.st[0], nx = b.st[1];
        if (nloc == 0u) { xcd_barrier_complete(bar, b.x, nloc, nx); b.st[0] = nloc; b.st[1] = nx; }
        const unsigned old = xb_add(&bar[XB_XSUB(b.x)], 1u);
        const unsigned gen = old / nloc;
        if (old + 1u == (gen + 1u) * nloc) {
            __builtin_amdgcn_fence(__ATOMIC_RELEASE, "agent");
            asm volatile("s_waitcnt vmcnt(0)" ::: "memory");
            const unsigned og = xb_add(&bar[XB_TOP], 1u);
            const unsigned tg = og / nx;
            if (og + 1u == (tg + 1u) * nx) xb_add(&bar[XB_TOPGEN], 1u);
            else XB_SPIN(xb_ld(&bar[XB_TOPGEN]) == tg, bar);
            __builtin_amdgcn_fence(__ATOMIC_ACQUIRE, "agent");
            xb_add(&bar[XB_XGEN(b.x)], 1u);
            asm volatile("s_waitcnt vmcnt(0)" ::: "memory");
        } else {
            XB_SPIN(xb_ld(&bar[XB_XGEN(b.x)]) == gen, bar);
            __builtin_amdgcn_fence(__ATOMIC_ACQUIRE, "agent");
            asm volatile("s_waitcnt vmcnt(0)" ::: "memory");
        }
    }
    __syncthreads();
}
struct Frame {
    const Params __attribute__((address_space(4)))* kp; unsigned char* ws; float* smem; PG8_LAS unsigned char* ldsp;
    int tid, lane, wave, gw, ngw;
    DI bf16_t* wl(int l, size_t off) const { return (bf16_t*)(ws + (size_t)l * WL_STRIDE + off); }
    DI bf16_t* z() const { return (bf16_t*)(ws + WS_Z); }
    DI bf16_t* q() const { return (bf16_t*)(ws + WS_Q); }
    DI bf16_t* kv() const { return (bf16_t*)(ws + WS_KV); }
    DI bf16_t* mix() const { return (bf16_t*)(ws + WS_MIX); }
    DI bf16_t* hu() const { return (bf16_t*)(ws + WS_HU); }
    DI bf16_t* gact() const { return (bf16_t*)(ws + WS_GACT); }
    DI bf16_t* hb() const { return (bf16_t*)(ws + WS_HB); }
    DI float* ssqh() const { return (float*)(ws + WS_SSQH); }
    DI float* ssqz() const { return (float*)(ws + WS_SSQZ); }
    DI bf16_t* kr() const { return (bf16_t*)(ws + WS_KR); }
    DI bf16_t* hidk() const { return (bf16_t*)(ws + WS_HIDK); }
    DI bf16_t* hidv() const { return (bf16_t*)(ws + WS_HIDV); }
    DI bf16_t* kcmp() const { return (bf16_t*)(ws + WS_KCMP); }
    DI bf16_t* vcmp() const { return (bf16_t*)(ws + WS_VCMP); }
    DI float* rope() const { return (float*)(ws + WS_ROPE); }
    DI float* b1(int l, int v) const { return (float*)(ws + WS_B1) + (l * 2 + v) * 128; }
    DI float* h() const { return (float*)(__attribute__((address_space(1))) float*)kp->out; }
    DI const float* gin(int i) const { return (const float*)(const __attribute__((address_space(1))) float*)kp->in[i]; }
};

DI void phase_prep(Frame& F) {
    for (int l = 0; l < 2; ++l) {
        wconv(F.gin(2) + (size_t)l * 1024 * 1976, 1024, 1976, F.gin(1) + l * 1024, F.wl(l, W_IN), 2048, MapZ(), F.smem);
        wconv(F.gin(5) + (size_t)l * 384 * 768, 384, 768, F.gin(3) + l * 384, F.wl(l, W_UQ), 768, MapUQ(), F.smem);
        wconv(F.gin(6) + (size_t)l * 256 * 1024, 256, 1024, F.gin(4) + l * 256, F.wl(l, W_UKV), 1024, MapUKV(), F.smem);
        wconv(F.gin(9) + (size_t)l * 2048 * 128, 2048, 128, nullptr, F.wl(l, W_C1K), 256, MapId{128}, F.smem);
        wconv(F.gin(11) + (size_t)l * 2048 * 128, 2048, 128, nullptr, F.wl(l, W_C1V), 256, MapId{128}, F.smem);
        wconv(F.gin(10) + (size_t)l * 128 * 64, 128, 64, nullptr, F.wl(l, W_C2K), 256, MapId{64}, F.smem);
        wconv(F.gin(12) + (size_t)l * 128 * 64, 128, 64, nullptr, F.wl(l, W_C2V), 256, MapId{64}, F.smem);
        wconv(F.gin(13) + (size_t)l * 1024 * 1024, 1024, 1024, nullptr, F.wl(l, W_O), 1024, MapId{1024}, F.smem);
        wconv(F.gin(15) + (size_t)l * 1024 * NUP, 1024, NUP, F.gin(14) + l * 1024, F.wl(l, W_UP), NUP, MapUP(), F.smem);
        wconv(F.gin(18) + (size_t)l * DFF * 1024, DFF, 1024, nullptr, F.wl(l, W_DN), 1024, MapId{1024}, F.smem);
    }
    if (blockIdx.x >= gridDim.x - 64) {
        const int bb = blockIdx.x - (gridDim.x - 64), lv = bb >> 4, kp = bb & 15, l = lv >> 1, v = lv & 1, e = F.tid & 127, sub = F.tid >> 7;
        const float* pos = (v ? F.gin(8) : F.gin(7)) + l * 2048; const float* w1 = (v ? F.gin(11) : F.gin(9)) + (size_t)l * 2048 * 128;
        float s = 0.f; const int k0 = kp * 128 + sub * 32;
#pragma unroll 8
        for (int k = k0; k < k0 + 32; ++k) s += pos[k] * w1[(size_t)k * 128 + e];
        __syncthreads(); F.smem[F.tid] = s; __syncthreads();
        if (F.tid < 128) ((float*)(F.ws + WS_B1))[1024 + (lv * 16 + kp) * 128 + e] = (F.smem[e] + F.smem[128 + e]) + (F.smem[256 + e] + F.smem[384 + e]);
        __syncthreads();
    }
    for (int i = blockIdx.x * NT + F.tid; i < S * 16; i += gridDim.x * NT) {
        const int t = i >> 4, j = i & 15; const float inv = 1.0f / powf(10000.0f, (float)(2 * j) / 32.0f); const float ang = (float)t * inv;
        F.rope()[i] = cosf(ang); F.rope()[S * 16 + i] = sinf(ang);
    }
    for (int row = F.gw; row < M; row += F.ngw) {
        const f32x4* xr = (const f32x4*)(F.gin(0) + (size_t)row * DM) + F.lane; float s = 0.f;
#pragma unroll
        for (int j = 0; j < 4; ++j) { f32x4 v = xr[64 * j]; s += (v[0] * v[0] + v[1] * v[1]) + (v[2] * v[2] + v[3] * v[3]);
            st_bf4(F.hb() + (size_t)row * DM + 4 * (F.lane + 64 * j), v); }
        s = wave_sum(s);
        if (F.lane < 16) F.ssqh()[(size_t)row * 16 + F.lane] = F.lane == 0 ? s : 0.f;
    }
}
DI void phase_stat_h(Frame& F) {
    for (int row = F.gw; row < M; row += F.ngw) {
        const f32x4* hr = (const f32x4*)(F.h() + (size_t)row * DM) + F.lane; float s = 0.f;
#pragma unroll
        for (int j = 0; j < 4; ++j) { f32x4 v = hr[64 * j]; s += (v[0] * v[0] + v[1] * v[1]) + (v[2] * v[2] + v[3] * v[3]); }
        s = wave_sum(s);
        if (F.lane < 16) F.ssqh()[(size_t)row * 16 + F.lane] = F.lane == 0 ? s : 0.f;
    }
}
DI void phase_stat_z(Frame& F) {
    for (int row = F.gw; row < M; row += F.ngw) {
        const bf16_t* zr = F.z() + (size_t)row * ZP; float sq = 0.f, sk = 0.f;
        for (int j = 0; j < 6; ++j) { float v = bf2f(zr[Z_CQ + F.lane + 64 * j]); sq += v * v; }
        for (int j = 0; j < 4; ++j) { float v = bf2f(zr[Z_CKV + F.lane + 64 * j]); sk += v * v; }
        sq = wave_sum(sq); sk = wave_sum(sk);
        if (F.lane < 24) F.ssqz()[(size_t)row * 24 + F.lane] = F.lane == 0 ? sq : (F.lane == 16 ? sk : 0.f);
    }
}
DI void job_krope(Frame& F) {
    for (int i = blockIdx.x * NT + F.tid; i < M * 16; i += gridDim.x * NT) {
        const int row = i >> 4, j = i & 15, t = row & (S - 1);
        const float c = F.rope()[t * 16 + j], s = F.rope()[S * 16 + t * 16 + j];
        const float x1 = bf2f(F.z()[(size_t)row * ZP + Z_KR + j]), x2 = bf2f(F.z()[(size_t)row * ZP + Z_KR + 16 + j]);
        F.kr()[(size_t)row * 32 + j] = f2bf(x1 * c - x2 * s); F.kr()[(size_t)row * 32 + 16 + j] = f2bf(x2 * c + x1 * s);
    }
}

struct OS { float m, l, o; };
DI void os_init(OS& s) { s.m = -INFINITY; s.l = 0.f; s.o = 0.f; }
DI void os_chunk(OS& st, float s, bool valid, const bf16_t* vbase, size_t vstride, int lane) {
    unsigned long long bal = __ballot(valid);
    if (!bal) return;
    const float cm = wave_max(valid ? s : -INFINITY);
    const float mn = fmaxf(st.m, cm);
    const float alpha = __expf(st.m - mn);
    const float p = valid ? __expf(s - mn) : 0.f;
    st.l = st.l * alpha + wave_sum(p);
    float acc = st.o * alpha;
    while (bal) { const int kk = __ffsll((long long)bal) - 1; bal &= bal - 1; const float pk = __shfl(p, kk); acc += pk * bf2f(vbase[(size_t)kk * vstride + lane]); }
    st.o = acc; st.m = mn;
}
DI float dot_bf(const float* q, const bf16_t* k, int n) {
    float s = 0.f;
    for (int d = 0; d < n; d += 8) { bf16x8 kv = *(const bf16x8*)(k + d);
#pragma unroll
        for (int j = 0; j < 8; ++j) s += q[d + j] * bf2f((bf16_t)kv[j]); }
    return s;
}
DI void phase_attn_naive(Frame& F) {
    float* wq = F.smem + F.wave * 640;
    float* pl = wq + 128;
    const bf16_t* q = F.q(); const bf16_t* kv = F.kv(); const bf16_t* kr = F.kr(); const bf16_t* z = F.z(); bf16_t* mix = F.mix();
    const int lane = F.lane;
    for (int task = F.gw; task < M * 8; task += F.ngw) {
        const int hd = task & 7, row = task >> 3, b = row >> 12, t = row & (S - 1);
        wq[lane] = bf2f(q[(size_t)row * 768 + hd * 64 + lane]);
        if (lane < 16) { const float c = F.rope()[t * 16 + lane], s = F.rope()[S * 16 + t * 16 + lane];
            const float x1 = bf2f(q[(size_t)row * 768 + 512 + hd * 32 + lane]), x2 = bf2f(q[(size_t)row * 768 + 512 + hd * 32 + 16 + lane]);
            wq[64 + lane] = x1 * c - x2 * s; wq[80 + lane] = x2 * c + x1 * s; }
        __builtin_amdgcn_wave_barrier();
        OS st; os_init(st);
        const float scale = 0.10206207261596575f;
        for (int k0 = 0; k0 <= t; k0 += 64) {
            const int key = k0 + lane; const bool valid = key <= t; const size_t kro = (size_t)(b * S + (valid ? key : t));
            const float s = (dot_bf(wq, kv + kro * 1024 + hd * 64, 64) + dot_bf(wq + 64, kr + kro * 32, 32)) * scale;
            os_chunk(st, s, valid, kv + (size_t)(b * S + k0) * 1024 + 512 + hd * 64, 1024, lane);
        }
        mix[(size_t)row * DM + hd * 64 + lane] = f2bf(st.o / st.l);
        __builtin_amdgcn_wave_barrier();
    }
    for (int task = F.gw; task < M * 2; task += F.ngw) {
        const int g = task & 1, row = task >> 1, b = row >> 12, t = row & (S - 1), bg = b * 2 + g, cur = t >> 6;
        const int nvis = t >= 31 ? ((t - 31) >> 4) + 1 : 0;
        float* ocs = wq + 384; float imp = 0.f;
        const bf16_t* kc = F.kcmp() + (size_t)bg * 256 * 64; const bf16_t* vc = F.vcmp() + (size_t)bg * 256 * 64;
        for (int r = 0; r < 4; ++r) {
            const int hd = g * 4 + r; const float slope = exp2f(-(float)(hd + 1));
            wq[lane] = bf2f(z[(size_t)row * ZP + Z_QN + hd * 64 + lane]);
            __builtin_amdgcn_wave_barrier();
            float sc[4]; float mx = -INFINITY;
#pragma unroll
            for (int i = 0; i < 4; ++i) { const int n = lane + 64 * i; const bool valid = n < nvis;
                sc[i] = valid ? dot_bf(wq, kc + (size_t)n * 64, 64) * 0.125f - slope * (float)(t - (16 * n + 31)) : -INFINITY; mx = fmaxf(mx, sc[i]); }
            mx = wave_max(mx);
            float ps[4]; float l = 0.f;
#pragma unroll
            for (int i = 0; i < 4; ++i) { ps[i] = (lane + 64 * i) < nvis ? __expf(sc[i] - mx) : 0.f; l += ps[i]; }
            l = wave_sum(l); const float il = nvis > 0 ? 1.f / l : 0.f;
            float o = 0.f;
#pragma unroll
            for (int i = 0; i < 4; ++i) { ps[i] *= il; pl[lane + 64 * i] = ps[i];
                const int cnt = nvis - 64 * i; for (int kk = 0; kk < 64 && kk < cnt; ++kk) { const float pk = __shfl(ps[i], kk); o += pk * bf2f(vc[(size_t)(64 * i + kk) * 64 + lane]); } }
            ocs[r * 64 + lane] = o;
            __builtin_amdgcn_wave_barrier();
            { const int j = lane; float a = 0.f; for (int n = 4 * j - 1; n <= 4 * j + 3; ++n) if (n >= 0 && n < 255) a += pl[n]; imp += a; }
            __builtin_amdgcn_wave_barrier();
        }
        float v = imp; if (lane > cur) v = -INFINITY; if (lane == 0 || lane == cur || lane == cur - 1) v = INFINITY;
        int rank = 0;
        for (int j = 0; j < 64; ++j) { const float vj = __shfl(v, j); rank += (vj > v || (vj == v && j < lane)) ? 1 : 0; }
        const unsigned long long selmask = __ballot(rank < 16 && lane <= cur);
        for (int r = 0; r < 4; ++r) {
            const int hd = g * 4 + r; const float slope = exp2f(-(float)(hd + 1));
            wq[lane] = bf2f(z[(size_t)row * ZP + Z_QN + hd * 64 + lane]);
            __builtin_amdgcn_wave_barrier();
            OS ss; os_init(ss);
            unsigned long long mm = selmask;
            while (mm) { const int j = __ffsll((long long)mm) - 1; mm &= mm - 1; const int key = 64 * j + lane; const bool valid = key <= t;
                const size_t kro = (size_t)(b * S + (valid ? key : t));
                const float s = dot_bf(wq, z + kro * ZP + Z_KS + g * 64, 64) * 0.125f - slope * (float)(t - key);
                os_chunk(ss, s, valid, z + (size_t)(b * S + 64 * j) * ZP + Z_VS + g * 64, ZP, lane); }
            OS sw; os_init(sw);
            for (int c = 0; c < 9; ++c) { const int j = cur - 8 + c; if (j < 0) continue; const int key = 64 * j + lane; const bool valid = key <= t && (t - key) < 512;
                const size_t kro = (size_t)(b * S + (key <= t ? key : t));
                const float s = dot_bf(wq, z + kro * ZP + Z_KW + g * 64, 64) * 0.125f - slope * (float)(t - key);
                os_chunk(sw, s, valid, z + (size_t)(b * S + 64 * j) * ZP + Z_VW + g * 64, ZP, lane); }
            const bf16_t* gt = z + (size_t)row * ZP + Z_GT + hd * 3;
            const float g0 = 1.f / (1.f + __expf(-bf2f(gt[0]))), g1 = 1.f / (1.f + __expf(-bf2f(gt[1]))), g2 = 1.f / (1.f + __expf(-bf2f(gt[2])));
            const float o = g0 * ocs[r * 64 + lane] + g1 * (ss.o / ss.l) + g2 * (sw.o / sw.l);
            mix[(size_t)row * DM + 512 + hd * 64 + lane] = f2bf(o);
            __builtin_amdgcn_wave_barrier();
        }
    }
}

typedef PG8_LAS bf16_t* lbf;
typedef short s16x4 __attribute__((ext_vector_type(4)));
typedef __bf16 bfv2 __attribute__((ext_vector_type(2)));
typedef float f32x2 __attribute__((ext_vector_type(2)));
constexpr int A_KSZ = 64 * 104, A_VLD = 72, A_VSZ = 64 * A_VLD;
constexpr int A_KOFF = 0, A_VOFF = 2 * A_KSZ * 2, A_IMP = A_VOFF + 2 * A_VSZ * 2, A_IMPLD = 65, A_SELM = A_IMP + 4 * 64 * A_IMPLD * 4, A_UNI = A_SELM + 512, A_IL = A_UNI + 16, A_QIDX = A_IL + 1024, A_END = A_QIDX + 16;
static_assert(A_END <= LDS_BYTES, "attention LDS");
constexpr float LOG2E = 1.4426950408889634f;
DI unsigned cvt2(float lo, float hi) { f32x2 f = {lo, hi}; bfv2 b = __builtin_convertvector(f, bfv2); return __builtin_bit_cast(unsigned, b); }
DI int crow_(int i, int h) { return (i & 3) + 8 * (i >> 2) + 4 * h; }
struct TileRegs { u32x4 k, v, k2; };
template <bool MLA> DI void tile_gload(TileRegs& R, const bf16_t* kp, size_t kst, const bf16_t* vp, size_t vst, const bf16_t* k2p, int kb, int tid) {
    const int key = tid >> 3, c = tid & 7;
    R.k = *(const u32x4*)(kp + (size_t)(kb + key) * kst + 8 * c);
    R.v = *(const u32x4*)(vp + (size_t)(kb + (tid & 63)) * vst + 8 * (tid >> 6));
    if (MLA) R.k2 = *(const u32x4*)(k2p + (size_t)(kb + ((tid & 255) >> 2)) * 32 + 8 * (tid & 3));
}
template <bool MLA> DI void tile_lstore(const TileRegs& R, lbf Ks, lbf Vt, int tid) {
    constexpr int KLD = MLA ? 104 : 72;
    const int key = tid >> 3, c = tid & 7;
    *(PG8_LAS u32x4*)(Ks + key * KLD + 8 * c) = R.k;
    if (MLA) { if (tid < 256) *(PG8_LAS u32x4*)(Ks + (tid >> 2) * KLD + 64 + 8 * (tid & 3)) = R.k2; }
    { const int kv = tid & 63, cv = tid >> 6, kp = (kv & ~12) | ((kv & 4) << 1) | ((kv & 8) >> 1);
#pragma unroll
      for (int j = 0; j < 8; ++j) Vt[(8 * cv + j) * A_VLD + kp] = (bf16_t)(R.v[j >> 1] >> (16 * (j & 1))); }
}
template <int KS> DI void qk_tile(lbf Ks, const bf16x8 (&Q)[KS], f32x16& s0, f32x16& s1, int r, int h) {
    constexpr int KLD = KS == 6 ? 104 : 72;
#pragma unroll
    for (int i = 0; i < 16; ++i) { s0[i] = 0.f; s1[i] = 0.f; }
    const PG8_LAS bf16x8* p0 = (const PG8_LAS bf16x8*)(Ks + r * KLD + 8 * h); const PG8_LAS bf16x8* p1 = (const PG8_LAS bf16x8*)(Ks + (32 + r) * KLD + 8 * h);
    bf16x8 a0 = p0[0], a1 = p1[0], b0, b1;
#pragma unroll
    for (int ks = 0; ks < KS; ks += 2) {
        b0 = p0[2 * (ks + 1)]; b1 = p1[2 * (ks + 1)];
        __builtin_amdgcn_sched_barrier(0);
        s0 = MFMA32(a0, Q[ks], s0); s1 = MFMA32(a1, Q[ks], s1);
        __builtin_amdgcn_sched_barrier(0);
        if (ks + 2 < KS) { a0 = p0[2 * (ks + 2)]; a1 = p1[2 * (ks + 2)]; }
        __builtin_amdgcn_sched_barrier(0);
        s0 = MFMA32(b0, Q[ks + 1], s0); s1 = MFMA32(b1, Q[ks + 1], s1);
        __builtin_amdgcn_sched_barrier(0);
    }
}
DI bf16x8 pack8(const f32x16& p, int s) {
    u32x4 w; w.x = cvt2(p[8 * s], p[8 * s + 1]); w.y = cvt2(p[8 * s + 2], p[8 * s + 3]); w.z = cvt2(p[8 * s + 4], p[8 * s + 5]); w.w = cvt2(p[8 * s + 6], p[8 * s + 7]);
    return __builtin_bit_cast(bf16x8, w);
}
DI void pv_load(lbf Vt, int g, int r, int h, bf16x8& v0, bf16x8& v1) {
    const int col = 32 * (g >> 1) + 16 * (g & 1) + 8 * h;
    v0 = *(const PG8_LAS bf16x8*)(Vt + r * A_VLD + col); v1 = *(const PG8_LAS bf16x8*)(Vt + (32 + r) * A_VLD + col);
}
DI void pv_tile(lbf Vt, const f32x16& p0, const f32x16& p1, f32x16 (&O)[2], int r, int h) {
    bf16x8 va0, va1, vb0, vb1;
    pv_load(Vt, 0, r, h, va0, va1);
#pragma unroll
    for (int g = 0; g < 4; g += 2) {
        pv_load(Vt, g + 1, r, h, vb0, vb1);
        const bf16x8 pa = pack8(g >> 1 ? p1 : p0, 0);
        __builtin_amdgcn_sched_barrier(0);
        O[0] = MFMA32(va0, pa, O[0]); O[1] = MFMA32(va1, pa, O[1]);
        __builtin_amdgcn_sched_barrier(0);
        if (g + 2 < 4) pv_load(Vt, g + 2, r, h, va0, va1);
        const bf16x8 pb = pack8(g >> 1 ? p1 : p0, 1);
        __builtin_amdgcn_sched_barrier(0);
        O[0] = MFMA32(vb0, pb, O[0]); O[1] = MFMA32(vb1, pb, O[1]);
        __builtin_amdgcn_sched_barrier(0);
    }
}
DI float row_max(const f32x16& x0, const f32x16& x1) {
    float mx = fmaxf(x0[0], x1[0]);
#pragma unroll
    for (int i = 1; i < 16; ++i) mx = fmaxf(mx, fmaxf(x0[i], x1[i]));
    return fmaxf(mx, __shfl_xor(mx, 32));
}
template <bool PV> DI void online_step_mx(f32x16& x0, f32x16& x1, float mx, float& m, float& l, f32x16 (&O)[2]);
template <bool PV> DI void online_step(f32x16& x0, f32x16& x1, float& m, float& l, f32x16 (&O)[2]) { online_step_mx<PV>(x0, x1, row_max(x0, x1), m, l, O); }
template <bool PV> DI void online_step_mx(f32x16& x0, f32x16& x1, float mx, float& m, float& l, f32x16 (&O)[2]) {
    const float mn = fmaxf(m, mx), alpha = __builtin_amdgcn_exp2f(m - mn);
    float ls = 0.f;
#pragma unroll
    for (int i = 0; i < 16; ++i) { x0[i] = __builtin_amdgcn_exp2f(x0[i] - mn); x1[i] = __builtin_amdgcn_exp2f(x1[i] - mn); ls += x0[i] + x1[i]; }
    ls += __shfl_xor(ls, 32);
    l = l * alpha + ls; m = mn;
    if (PV) { if (__any(alpha != 1.f)) {
#pragma unroll
        for (int i = 0; i < 16; ++i) { O[0][i] *= alpha; O[1][i] *= alpha; } } }
}
DI void online_raw(f32x16& s0, f32x16& s1, float c1, float& m, float& l, f32x16 (&O)[2]) {
    float mx = fmaxf(s0[0], s1[0]);
#pragma unroll
    for (int i = 1; i < 16; ++i) mx = fmaxf(mx, fmaxf(s0[i], s1[i]));
    mx = fmaxf(mx, __shfl_xor(mx, 32));
    const float mxe = mx * c1;
    if (__any(mxe - m > 8.f)) {
        const float mn = fmaxf(m, mxe), alpha = __builtin_amdgcn_exp2f(m - mn);
        l *= alpha; m = mn;
#pragma unroll
        for (int i = 0; i < 16; ++i) { O[0][i] *= alpha; O[1][i] *= alpha; }
    }
    const float nmn = -m;
    float ls = 0.f;
#pragma unroll
    for (int i = 0; i < 16; ++i) { s0[i] = __builtin_amdgcn_exp2f(fmaf(s0[i], c1, nmn)); s1[i] = __builtin_amdgcn_exp2f(fmaf(s1[i], c1, nmn)); ls += s0[i] + s1[i]; }
    ls += __shfl_xor(ls, 32);
    l += ls;
}
struct TlRange { int lo, hi; DI int first() const { return lo <= hi ? lo * 64 : -1; } DI int next(int kb) const { return kb + 64 <= hi * 64 ? kb + 64 : -1; } };
struct TlRangeDesc { int lo, hi; DI int first() const { return lo <= hi ? hi * 64 : -1; } DI int next(int kb) const { return kb - 64 >= lo * 64 ? kb - 64 : -1; } };
struct TlMaskDesc { unsigned long long mask; DI int first() const { return mask ? (63 - __clzll((long long)mask)) * 64 : -1; }
    DI int next(int kb) const { const int j = kb >> 6; const unsigned long long rest = j == 0 ? 0ull : (mask & ((1ull << j) - 1ull)); return rest ? (63 - __clzll((long long)rest)) * 64 : -1; } };
struct TlMask { unsigned long long mask; DI int first() const { return mask ? (__ffsll((long long)mask) - 1) * 64 : -1; }
    DI int next(int kb) const { const int j = kb >> 6; const unsigned long long rest = j >= 63 ? 0ull : (mask >> (j + 1)); return rest ? (j + 1 + __ffsll((long long)rest) - 1) * 64 : -1; } };
template <bool MLA, class TL, class CF>
DI void att_pipe(lbf KB, lbf VB, const bf16_t* kp, size_t kst, const bf16_t* vp, size_t vst, const bf16_t* k2p, const TL& tl, CF& cf, int) {
    int kb = tl.first(); if (kb < 0) return;
    const int tid = tid_now();
    TileRegs R0, R1; tile_gload<MLA>(R0, kp, kst, vp, vst, k2p, kb, tid);
    int nk = tl.next(kb);
    tile_gload<MLA>(R1, kp, kst, vp, vst, k2p, nk >= 0 ? nk : kb, tid);
    __syncthreads();
    tile_lstore<MLA>(R0, KB, VB, tid);
    __syncthreads();
    int cb = 0;
#define ATT_STEP(RA, RB) { const int nn = nk >= 0 ? tl.next(nk) : -1; \
        tile_gload<MLA>(RA, kp, kst, vp, vst, k2p, nn >= 0 ? nn : kb, tid);     \
        cf(KB + cb * A_KSZ, VB + cb * A_VSZ, kb); \
        if (nk >= 0) tile_lstore<MLA>(RB, KB + (cb ^ 1) * A_KSZ, VB + (cb ^ 1) * A_VSZ, tid); \
        __syncthreads(); \
        if (nk < 0) break; \
        kb = nk; nk = nn; cb ^= 1; }
    for (;;) {
        ATT_STEP(R0, R1)
        ATT_STEP(R1, R0)
    }
#undef ATT_STEP
}
struct CfMla { const bf16x8 (&Q)[6]; f32x16 (&O)[2]; float& m; float& l; int t, tq0, r, h;
    DI void operator()(lbf Ks, lbf Vt, int kb) {
        if (kb > __builtin_amdgcn_readfirstlane(tq0) + 31) return;
        f32x16 x0, x1; qk_tile<6>(Ks, Q, x0, x1, r, h);
        const float c1 = 0.10206207261596575f * LOG2E;
        if (kb + 63 > __builtin_amdgcn_readfirstlane(tq0)) {
            const int dt = t - kb - 4 * h;
#pragma unroll
            for (int i = 0; i < 16; ++i) { const int ci = (i & 3) + 8 * (i >> 2); x0[i] = ci <= dt ? x0[i] : -INFINITY; x1[i] = ci + 32 <= dt ? x1[i] : -INFINITY; }
        }
        online_raw(x0, x1, c1, m, l, O); pv_tile(Vt, x0, x1, O, r, h);
    } };
template <bool SEL> struct CfNsa { const bf16x8 (&Q)[4]; f32x16 (&O)[2]; float& m; float& l; int t, r, h; float sl2; unsigned long long qsel;
    DI void operator()(lbf Ks, lbf Vt, int kb) {
        f32x16 x0, x1; qk_tile<4>(Ks, Q, x0, x1, r, h);
        const float c1 = 0.125f * LOG2E; const bool on = !SEL || ((qsel >> (kb >> 6)) & 1ull);
        const int tq0 = __builtin_amdgcn_readfirstlane(t - r);
        const float base = on ? sl2 * (float)(kb + 4 * h - t) : -INFINITY;
#pragma unroll
        for (int i = 0; i < 16; ++i) { const int ci = (i & 3) + 8 * (i >> 2); x0[i] = fmaf(x0[i], c1, fmaf(sl2, (float)ci, base)); x1[i] = fmaf(x1[i], c1, fmaf(sl2, (float)(ci + 32), base)); }
        if (kb + 63 > tq0 || (!SEL && tq0 + 31 - kb >= 512)) {
            const int dt = t - kb - 4 * h;
#pragma unroll
            for (int i = 0; i < 16; ++i) { const int ci = (i & 3) + 8 * (i >> 2);
                const bool v0 = ci <= dt && (SEL || dt - ci < 512), v1 = ci + 32 <= dt && (SEL || dt - ci - 32 < 512);
                x0[i] = v0 ? x0[i] : -INFINITY; x1[i] = v1 ? x1[i] : -INFINITY; }
        }
        {
            const float mx = row_max(x0, x1);
            if (!__any(mx - m > -160.f)) return;
            online_step_mx<true>(x0, x1, mx, m, l, O);
        }
        pv_tile(Vt, x0, x1, O, r, h);
    } };
struct CfCmp { const bf16x8 (&Q)[4]; f32x16 (&O)[2]; float& m; float& l; int t, r, h; float sl2; int nvis; PG8_LAS float* imp; int nvmin;
    DI void operator()(lbf Ks, lbf Vt, int kb) {
        f32x16 x0, x1; qk_tile<4>(Ks, Q, x0, x1, r, h);
        const float c1 = 0.125f * LOG2E;
        const int dn = nvis - kb - 4 * h;
        const float df = sl2 * (float)(16 * (kb + 4 * h) + 31 - t), s16 = 16.f * sl2;
#pragma unroll
        for (int i = 0; i < 16; ++i) { const int ci = (i & 3) + 8 * (i >> 2); const float bi = fmaf(s16, (float)ci, df); x0[i] = fmaf(x0[i], c1, bi); x1[i] = fmaf(x1[i], c1, bi + 32.f * s16); }
        if (kb + 64 > __builtin_amdgcn_readfirstlane(nvmin)) {
#pragma unroll
            for (int i = 0; i < 16; ++i) { const int ci = (i & 3) + 8 * (i >> 2); x0[i] = ci < dn ? x0[i] : -INFINITY; x1[i] = ci + 32 < dn ? x1[i] : -INFINITY; }
        }
        const float mold = m, mxr = row_max(x0, x1);
        if (!__any(mxr - m > -160.f)) return;
        online_step_mx<true>(x0, x1, mxr, m, l, O);
        const float alpha = __builtin_amdgcn_exp2f(mold - m);
        if (__any(alpha != 1.f && mold > -1e29f)) {
#pragma unroll 4
            for (int k = 0; k < 32; ++k) imp[2 * k + h] *= alpha;
        }
        pv_tile(Vt, x0, x1, O, r, h);
#pragma unroll
        for (int kh = 0; kh < 2; ++kh)
#pragma unroll
            for (int g4 = 0; g4 < 4; ++g4) { const f32x16& p = kh ? x1 : x0; const int a = (kb >> 2) + 8 * kh + 2 * g4 + h;
                imp[a] += (p[4 * g4] + p[4 * g4 + 1]) + (p[4 * g4 + 2] + p[4 * g4 + 3]); asm volatile("" ::: "memory");
                if (a + 1 < 64) imp[a + 1] += p[4 * g4 + 3];
                asm volatile("" ::: "memory"); }
    } };
DI void write_o(bf16_t* dst, const f32x16 (&O)[2], float sc, int h) {
#pragma unroll
    for (int dh = 0; dh < 2; ++dh)
#pragma unroll
        for (int g4 = 0; g4 < 4; ++g4) { u32x2 w; w.x = cvt2(O[dh][4 * g4] * sc, O[dh][4 * g4 + 1] * sc); w.y = cvt2(O[dh][4 * g4 + 2] * sc, O[dh][4 * g4 + 3] * sc);
            *(u32x2*)(dst + 32 * dh + 8 * g4 + 4 * h) = w; }
}
DI void zero_o(f32x16 (&O)[2]) {
#pragma unroll
    for (int i = 0; i < 16; ++i) { O[0][i] = 0.f; O[1][i] = 0.f; }
}
DI void unit_mla(Frame& F, int b, int hd, int qb, int tid) {
    const int lane = tid & 63, w = tid >> 6, r = lane & 31, h = lane >> 5, tq0 = qb * 256 + 32 * w, t = tq0 + r; const size_t row = (size_t)b * S + t;
    lbf KB = (lbf)(F.ldsp + A_KOFF), VB = (lbf)(F.ldsp + A_VOFF);
    bf16x8 Q[6];
    const bf16_t* qr = F.q() + row * 768;
#pragma unroll
    for (int ks = 0; ks < 4; ++ks) Q[ks] = *(const bf16x8*)(qr + hd * 64 + 16 * ks + 8 * h);
    { const bf16x8 x1 = *(const bf16x8*)(qr + 512 + hd * 32 + 8 * h), x2 = *(const bf16x8*)(qr + 512 + hd * 32 + 16 + 8 * h);
      int ro = t * 16 + 8 * h; asm volatile("" : "+v"(ro));
      const f32x4* cs = (const f32x4*)(F.rope() + ro); const f32x4* sn = (const f32x4*)(F.rope() + S * 16 + ro);
      const f32x4 c0 = cs[0], c1 = cs[1], s0 = sn[0], s1 = sn[1];
#pragma unroll
      for (int j = 0; j < 8; ++j) { const float a = bf2f((bf16_t)x1[j]), bb = bf2f((bf16_t)x2[j]), c = j < 4 ? c0[j & 3] : c1[j & 3], s = j < 4 ? s0[j & 3] : s1[j & 3]; Q[4][j] = (short)f2bf(a * c - bb * s); Q[5][j] = (short)f2bf(bb * c + a * s); } }
    __builtin_amdgcn_sched_barrier(0);
    f32x16 O[2]; zero_o(O); float m = -1e30f, l = 0.f;
    CfMla cf{Q, O, m, l, t, tq0, r, h};
    const bf16_t* kvb = F.kv() + (size_t)b * S * 1024;
    att_pipe<true>(KB, VB, kvb + hd * 64, 1024, kvb + 512 + hd * 64, 1024, F.kr() + (size_t)b * S * 32, TlRange{0, 4 * qb + 3}, cf, tid);
    write_o(F.mix() + row * DM + hd * 64, O, 1.f / l, h);
}
DI void unit_nsa(Frame& F, int b, int g, int qt, int tid) {
    const int lane = tid & 63, w = tid >> 6, r = lane & 31, h = lane >> 5, rh = w >> 1, sub = w & 1, hd = 4 * g + rh, ql = 32 * sub + r, t = qt * 64 + ql, bg = b * 2 + g;
    const size_t row = (size_t)b * S + t;
    lbf KB = (lbf)(F.ldsp + A_KOFF), VB = (lbf)(F.ldsp + A_VOFF);
    PG8_LAS float* impr = (PG8_LAS float*)(F.ldsp + A_IMP) + (rh * 64 + ql) * A_IMPLD;
    PG8_LAS unsigned* selm = (PG8_LAS unsigned*)(F.ldsp + A_SELM); PG8_LAS unsigned* uni = (PG8_LAS unsigned*)(F.ldsp + A_UNI);
    const bf16_t* zb = F.z() + (size_t)b * S * ZP;
    bf16x8 Q[4];
#pragma unroll
    for (int ks = 0; ks < 4; ++ks) Q[ks] = *(const bf16x8*)(F.z() + row * ZP + Z_QN + hd * 64 + 16 * ks + 8 * h);
    const float sl2 = exp2f(-(float)(hd + 1)) * LOG2E;
    const bf16_t* gt = F.z() + row * ZP + Z_GT + hd * 3;
    const float g0 = 1.f / (1.f + __expf(-bf2f(gt[0]))), g1 = 1.f / (1.f + __expf(-bf2f(gt[1]))), g2 = 1.f / (1.f + __expf(-bf2f(gt[2])));
    f32x16 O[2], Of[2]; float m, l;
    const int tmax = qt * 64 + 63, nvmax = tmax >= 31 ? ((tmax - 31) >> 4) + 1 : 0, ntc = (nvmax + 63) >> 6, nvis = t >= 31 ? ((t - 31) >> 4) + 1 : 0;
    const int tw0 = t - r, nvmin = tw0 >= 31 ? ((tw0 - 31) >> 4) + 1 : 0;
    const bf16_t* kc = F.kcmp() + (size_t)bg * 256 * 64; const bf16_t* vc = F.vcmp() + (size_t)bg * 256 * 64;
    if (tid < 2) uni[tid] = 0u;
#pragma unroll
    for (int i = 0; i < 32; ++i) impr[32 * h + i] = 0.f;
    zero_o(O); m = -1e30f; l = 0.f;
    PG8_LAS float* ilq = (PG8_LAS float*)(F.ldsp + A_IL);
    { CfCmp c1{Q, O, m, l, t, r, h, sl2, nvis, impr, nvmin}; att_pipe<false>(KB, VB, kc, 64, vc, 64, nullptr, TlRangeDesc{0, ntc - 1}, c1, tid); }
    { const float il = l > 0.f ? 1.f / l : 0.f; if (h == 0) ilq[rh * 64 + ql] = il;
#pragma unroll
      for (int i = 0; i < 16; ++i) { Of[0][i] = (g0 * il) * O[0][i]; Of[1][i] = (g0 * il) * O[1][i]; } }
    __syncthreads();
#ifndef X_TOPK
    __builtin_amdgcn_sched_barrier(0);
    { const int tid = tid_now();
        PG8_LAS float* ib = (PG8_LAS float*)(F.ldsp + A_IMP);
        const int q = tid >> 3, jj = tid & 7;
        float mine[8];
#pragma unroll
        for (int k = 0; k < 8; ++k) { const int j = 8 * jj + k; const int o = q * A_IMPLD + j;
            float v = ((ib[o] * ilq[q] + ib[64 * A_IMPLD + o] * ilq[64 + q]) + ib[2 * 64 * A_IMPLD + o] * ilq[128 + q]) + ib[3 * 64 * A_IMPLD + o] * ilq[192 + q];
            if (j > qt) v = -INFINITY; if (j == 0 || j == qt || j == qt - 1) v = INFINITY; mine[k] = v; }
        __syncthreads();
#pragma unroll
        for (int k = 0; k < 8; ++k) ib[q * A_IMPLD + 8 * jj + k] = mine[k];
        __syncthreads();
        int rank[8];
#pragma unroll
        for (int k = 0; k < 8; ++k) rank[k] = 0;
        for (int j2 = 0; j2 <= qt; ++j2) { const float v2 = ib[q * A_IMPLD + j2];
#pragma unroll
            for (int k = 0; k < 8; ++k) rank[k] += (v2 > mine[k] || (v2 == mine[k] && j2 < 8 * jj + k)) ? 1 : 0; }
        unsigned bits = 0u;
#pragma unroll
        for (int k = 0; k < 8; ++k) if (rank[k] < 16 && 8 * jj + k <= qt) bits |= 1u << k;
        unsigned lo = jj < 4 ? bits << (8 * jj) : 0u, hi = jj >= 4 ? bits << (8 * (jj - 4)) : 0u;
#pragma unroll
        for (int o = 1; o < 8; o <<= 1) { lo |= __shfl_xor(lo, o); hi |= __shfl_xor(hi, o); }
        if (jj == 0) { selm[2 * q] = lo; selm[2 * q + 1] = hi; __hip_atomic_fetch_or(uni, lo, __ATOMIC_RELAXED, __HIP_MEMORY_SCOPE_WORKGROUP); __hip_atomic_fetch_or(uni + 1, hi, __ATOMIC_RELAXED, __HIP_MEMORY_SCOPE_WORKGROUP); }
        __syncthreads();
    }
#endif
    const unsigned long long qsel = (unsigned long long)selm[2 * ql] | ((unsigned long long)selm[2 * ql + 1] << 32);
    const unsigned long long umask = (unsigned long long)uni[0] | ((unsigned long long)uni[1] << 32);
    zero_o(O); m = -1e30f; l = 0.f;
#ifndef X_SEL
    __builtin_amdgcn_sched_barrier(0);
    { const int r = tid_now() & 31, h = (tid_now() >> 5) & 1; CfNsa<true> cs{Q, O, m, l, t, r, h, sl2, qsel}; att_pipe<false>(KB, VB, zb + Z_KS + g * 64, ZP, zb + Z_VS + g * 64, ZP, nullptr, TlMaskDesc{umask}, cs, tid); }
#endif
    { const float sc = g1 / l;
#pragma unroll
      for (int i = 0; i < 16; ++i) { Of[0][i] += sc * O[0][i]; Of[1][i] += sc * O[1][i]; } }
    zero_o(O); m = -1e30f; l = 0.f;
#ifndef X_WIN
    __builtin_amdgcn_sched_barrier(0);
    { const int r = tid_now() & 31, h = (tid_now() >> 5) & 1; CfNsa<false> cw{Q, O, m, l, t, r, h, sl2, 0ull}; att_pipe<false>(KB, VB, zb + Z_KW + g * 64, ZP, zb + Z_VW + g * 64, ZP, nullptr, TlRangeDesc{qt >= 8 ? qt - 8 : 0, qt}, cw, tid); }
#endif
    { const float sc = g2 / l;
#pragma unroll
      for (int i = 0; i < 16; ++i) { Of[0][i] += sc * O[0][i]; Of[1][i] += sc * O[1][i]; } }
    write_o(F.mix() + row * DM + 512 + hd * 64, Of, 1.f, h);
}
DI void phase_attn_fast(Frame& F, int l) {
    const int tid = tid_now();
    PG8_LAS int* qidx = (PG8_LAS int*)(F.ldsp + A_QIDX);
    unsigned* ctr = (unsigned*)(F.ws + WS_CTL) + (l & 3);
    unsigned* done = (unsigned*)(F.ws + WS_CTL) + 8 + (l & 1);
    if (blockIdx.x < 16 && l < 2) {
        const int c = blockIdx.x, G = gridDim.x, v = c >> 3, u = c & 7;
        if (v == 0) run_gemm(F.ldsp, pg8::Gemm{F.z() + Z_KC, F.wl(l, W_C1K), 2048, 256, 2048, 16 * ZP, ZP * 2, 1}, pg8::EpiG<pg8::EM_GELU, 0>{F.hidk(), 256, 128, nullptr, 0, F.b1(l, 0), nullptr, nullptr, nullptr}, G, u);
        else run_gemm(F.ldsp, pg8::Gemm{F.z() + Z_VC, F.wl(l, W_C1V), 2048, 256, 2048, 16 * ZP, ZP * 2, 1}, pg8::EpiG<pg8::EM_GELU, 0>{F.hidv(), 256, 128, nullptr, 0, F.b1(l, 1), nullptr, nullptr, nullptr}, G, u);
        __threadfence(); __syncthreads(); __builtin_amdgcn_fence(__ATOMIC_ACQUIRE, "agent");
        if (v == 0) ngemm(APlain{F.hidk() + (size_t)u * 256 * 256, 256}, F.wl(l, W_C2K), 128, 256, 64, 128, EpiPlain{F.kcmp() + (size_t)u * 256 * 64, 64}, true);
        else ngemm(APlain{F.hidv() + (size_t)u * 256 * 256, 256}, F.wl(l, W_C2V), 128, 256, 64, 128, EpiPlain{F.vcmp() + (size_t)u * 256 * 64, 64}, true);
        __threadfence(); __syncthreads();
        if (tid == 0) __hip_atomic_fetch_add(done, 1u, __ATOMIC_RELEASE, __HIP_MEMORY_SCOPE_AGENT);
    }
    bool cmp_ok = false;
    __syncthreads();
    if (tid == 0) qidx[0] = (int)atomicAdd(ctr, 1u);
    for (;;) {
        __syncthreads();
        const int i = qidx[0];
        if (i >= 1024) break;
        unsigned nxt = 0u; if (tid == 0) nxt = atomicAdd(ctr, 1u);
        int tidu = tid; asm volatile("" : "+v"(tidu));
        if (i < 512) { const int k = i & 31; unit_mla(F, k >> 3, k & 7, 15 - (i >> 5), tidu); }
        else {
            if (!cmp_ok) {
                if (tid == 0) { while (__hip_atomic_load(done, __ATOMIC_RELAXED, __HIP_MEMORY_SCOPE_AGENT) < 16u) __builtin_amdgcn_s_sleep(8); }
                __syncthreads(); __builtin_amdgcn_fence(__ATOMIC_ACQUIRE, "agent"); cmp_ok = true;
            }
            const int j = i - 512; unit_nsa(F, (j & 7) >> 1, j & 1, 63 - (j >> 3), tidu);
        }
        __syncthreads();
        if (tid == 0) qidx[0] = (int)nxt;
    }
}
DI void phase_conv(Frame& F, int l, int b) {
    const float* cw = F.gin(16) + (size_t)l * 3 * NUP; const float* cb = F.gin(17) + (size_t)l * NUP;
    const bf16_t* hu = F.hu(); bf16_t* ga = F.gact() + (size_t)b * S * DFF;
    for (size_t i = (size_t)blockIdx.x * NT + F.tid; i < (size_t)S * DFF; i += (size_t)gridDim.x * NT) {
        const int t = (int)(i / DFF), c = (int)(i % DFF), pn = c >> 7, j = c & 127, colg = pn * 256 + j, colu = colg + 128, cu = DFF + c;
        float hg = cb[c], hup = cb[cu];
#pragma unroll
        for (int k = 0; k < 3; ++k) { const int tt = t - 2 + k; if (tt >= 0) { hg += cw[k * NUP + c] * bf2f(hu[(size_t)tt * NUP + colg]); hup += cw[k * NUP + cu] * bf2f(hu[(size_t)tt * NUP + colu]); } }
        ga[(size_t)t * DFF + c] = f2bf(hg / (1.f + __expf(-hg)) * hup);
    }
}
DI void phase_final(Frame& F) {
    const float* fn = F.gin(19);
    for (int row = F.gw; row < M; row += F.ngw) {
        const float rs = rstd_h(F.ssqh(), row); f32x4* hr = (f32x4*)(F.h() + (size_t)row * DM) + F.lane; const f32x4* gn = (const f32x4*)fn + F.lane;
#pragma unroll
        for (int j = 0; j < 4; ++j) hr[64 * j] = hr[64 * j] * rs * gn[64 * j];
    }
}

constexpr int NPH = 13;
DI void run_phase(Frame& F, int ph) {
    if (ph == 0) { phase_prep(F);
#ifdef DUP_PREP
        __syncthreads(); phase_prep(F);
#endif
        return; }
    const int l = (ph - 1) / 6, s0_ = (ph - 1) % 6;
    const int s = s0_ == 0 ? 0 : (s0_ == 1 ? 2 : (s0_ == 2 ? 4 : (s0_ == 3 ? 5 : (s0_ == 4 ? 7 : 15))));
#ifdef ONLY_S
    if (s != ONLY_S) return;
#endif
    int G = gridDim.x, c = blockIdx.x; asm volatile("" : "+s"(G), "+s"(c));
    if (s == 0) { run_gemm(F.ldsp, pg8::Gemm{F.hb(), F.wl(l, W_IN), M, ZP, 1024, DM, 128, 0}, pg8::EpiG<pg8::EM_SCALEH, 2>{F.z(), ZP, ZP, F.ssqh(), 0, nullptr, nullptr, F.ssqz(), nullptr}, G, c);
#ifdef DUP_ZP
        run_gemm(F.ldsp, pg8::Gemm{F.hb(), F.wl(l, W_IN), M, ZP, 1024, DM, 128, 0}, pg8::EpiG<pg8::EM_SCALEH, 2>{F.z(), ZP, ZP, F.ssqh(), 0, nullptr, nullptr, F.ssqz(), nullptr}, G, c);
#endif
        return; }
    if (s == 1) { phase_stat_z(F); return; }
    if (s == 2) {
        run_gemm(F.ldsp, pg8::Gemm{F.z() + Z_CQ, F.wl(l, W_UQ), M, 768, 384, ZP, 128, 0}, pg8::EpiG<pg8::EM_SCALEQ, 0>{F.q(), 768, 768, F.ssqz(), 0, nullptr, nullptr, nullptr, nullptr}, G, c);
        run_gemm(F.ldsp, pg8::Gemm{F.z() + Z_CKV, F.wl(l, W_UKV), M, 1024, 256, ZP, 128, 0}, pg8::EpiG<pg8::EM_SCALEKV, 0>{F.kv(), 1024, 1024, F.ssqz(), 0, nullptr, nullptr, nullptr, nullptr}, G, c);
        job_krope(F);
        if (blockIdx.x == gridDim.x - 1 && F.tid < 256) {
            const int v = F.tid >> 7, e = F.tid & 127; const float* pp = (const float*)(F.ws + WS_B1) + 1024 + ((l * 2 + v) * 16) * 128 + e; float s = 0.f;
            for (int kp = 0; kp < 16; ++kp) s += pp[kp * 128];
            F.b1(l, v)[e] = s;
        }
#ifdef DUP_ZP
        run_gemm(F.ldsp, pg8::Gemm{F.z() + Z_CQ, F.wl(l, W_UQ), M, 768, 384, ZP, 128, 0}, pg8::EpiG<pg8::EM_SCALEQ, 0>{F.q(), 768, 768, F.ssqz(), 0, nullptr, nullptr, nullptr, nullptr}, G, c);
        run_gemm(F.ldsp, pg8::Gemm{F.z() + Z_CKV, F.wl(l, W_UKV), M, 1024, 256, ZP, 128, 0}, pg8::EpiG<pg8::EM_SCALEKV, 0>{F.kv(), 1024, 1024, F.ssqz(), 0, nullptr, nullptr, nullptr, nullptr}, G, c);
        job_krope(F);
#endif
        return;
    }
#ifdef NAIVE_ATTN
    if (s == 4) { phase_attn_naive(F); return; }
#else
    if (s == 4) { phase_attn_fast(F, l);
#ifdef DUP_ATT
        phase_attn_fast(F, l + 2);
#endif
        return; }
#endif
    if (s == 5) { run_gemm(F.ldsp, pg8::Gemm{F.mix(), F.wl(l, W_O), M, DM, 1024, DM, 128, 0}, pg8::EpiG<pg8::EM_RES, 1>{F.hb(), DM, DM, nullptr, 0, nullptr, F.h(), F.ssqh(), l == 0 ? F.gin(0) : (const float*)F.h()}, G, c); return; }
    if (s == 6 || s == 16) { phase_stat_h(F); return; }
    if (s == 7) {
#ifdef CONV256
        run_gemm(F.ldsp, pg8::Gemm{F.hb(), F.wl(l, W_UP), M, NUP, 1024, DM, 128, 0},
                 pg8::EpiConv<256>{F.gact(), F.ssqh(), F.gin(16) + (size_t)l * 3 * NUP, F.gin(17) + (size_t)l * NUP, (PG8_LAS float*)(F.ldsp + 131072)}, G, c);
        return;
#endif
        run_gemm(F.ldsp, pg8::Gemm{F.hb(), F.wl(l, W_UP), 68 * 256, NUP, 1024, DM, 128, 2},
                 pg8::EpiConv<254>{F.gact(), F.ssqh(), F.gin(16) + (size_t)l * 3 * NUP, F.gin(17) + (size_t)l * NUP, (PG8_LAS float*)(F.ldsp + 131072)}, G, c);
#ifdef DUP_UP
        run_gemm(F.ldsp, pg8::Gemm{F.hb(), F.wl(l, W_UP), 68 * 256, NUP, 1024, DM, 128, 2},
                 pg8::EpiConv<254>{F.gact(), F.ssqh(), F.gin(16) + (size_t)l * 3 * NUP, F.gin(17) + (size_t)l * NUP, (PG8_LAS float*)(F.ldsp + 131072)}, G, c);
#endif
        return;
    }
    if (s == 15 && l == 1) {
        run_gemm(F.ldsp, pg8::Gemm{F.gact(), F.wl(l, W_DN), M, DM, DFF, DFF, 128, 0},
                 pg8::EpiFinal{(const float*)F.h(), F.h(), F.gin(19), F.ssqh(), (unsigned*)(F.ws + WS_CTL + 32768), (PG8_LAS unsigned*)(F.ldsp + 131072)}, G, c);
        return;
    }
    if (s == 15) { run_gemm(F.ldsp, pg8::Gemm{F.gact(), F.wl(l, W_DN), M, DM, DFF, DFF, 128, 0}, pg8::EpiG<pg8::EM_RES, 1>{F.hb(), DM, DM, nullptr, 0, nullptr, F.h(), F.ssqh(), (const float*)F.h()}, G, c); return; }
}

__global__ void __launch_bounds__(NT, 2) mk(Params p) {
    extern __shared__ __attribute__((aligned(16))) unsigned char lds_raw[];
    float* smem = (float*)lds_raw;
    cg::grid_group grid = cg::this_grid();
    Frame F; F.kp = (const Params __attribute__((address_space(4)))*)__builtin_amdgcn_kernarg_segment_ptr(); F.ws = p.ws; F.smem = smem; F.ldsp = (PG8_LAS unsigned char*)lds_raw; F.tid = threadIdx.x; F.lane = F.tid & 63; F.wave = F.tid >> 6;
    F.gw = blockIdx.x * 8 + F.wave; F.ngw = gridDim.x * 8;
    if (threadIdx.x < 2) ((PG8_LAS unsigned*)(F.ldsp + LDS_ST))[threadIdx.x] = 0u;
    __syncthreads();
    XcdBarrier bar = xcd_barrier_post((unsigned*)(p.ws + WS_CTL + 1024), (volatile PG8_LAS unsigned*)(F.ldsp + LDS_ST));
    for (int ph = p.ph_lo; ph < p.ph_hi; ++ph) {
        { __attribute__((address_space(1))) unsigned char* wsg = (__attribute__((address_space(1))) unsigned char*)F.ws; asm volatile("" : "+s"(wsg), "+s"(F.kp)); F.ws = (unsigned char*)wsg; }
        { int t_ = threadIdx.x; asm volatile("" : "+v"(t_)); F.tid = t_; F.lane = t_ & 63; F.wave = t_ >> 6; F.gw = blockIdx.x * 8 + F.wave; }
        run_phase(F, ph);
        if (ph + 1 < p.ph_hi) {
            if (ph < 0) grid.sync();
            xcd_barrier(bar);
        }
    }
}

extern "C" void kernel_launch(void* const* d_in, const int* in_sizes, int n_in, void* d_out, int out_size, void* d_ws, size_t ws_size, hipStream_t stream) {
    if (n_in != 20 || ws_size < WS_ENDALL) { fprintf(stderr, "kernel_launch: unexpected n_in %d / ws %zu\n", n_in, ws_size); return; }
    static int grid_blocks = 0;
    if (!grid_blocks) {
        int dev = 0, cus = 0, per_cu = 0;
        hipGetDevice(&dev);
        hipDeviceGetAttribute(&cus, hipDeviceAttributeMultiprocessorCount, dev);
        hipFuncSetAttribute((const void*)mk, hipFuncAttributeMaxDynamicSharedMemorySize, LDS_BYTES);
        hipOccupancyMaxActiveBlocksPerMultiprocessor(&per_cu, mk, NT, LDS_BYTES);
        if (per_cu < 1) per_cu = 1;
        if (per_cu > 1) per_cu = 1;
        grid_blocks = cus * per_cu;
    }
    Params p{};
    for (int i = 0; i < 20; ++i) p.in[i] = (const float*)d_in[i];
    p.out = (float*)d_out; p.ws = (unsigned char*)d_ws;
    {
        p.ph_lo = 0; p.ph_hi = NPH;
        hipMemsetAsync((char*)d_ws + WS_CTL, 0, 65536, stream);
        void* args[] = {&p};
        hipError_t e = hipLaunchCooperativeKernel((void*)mk, dim3(grid_blocks), dim3(NT), args, LDS_BYTES, stream);
        if (e != hipSuccess) { fprintf(stderr, "cooperative launch failed: %s (grid %d)\n", hipGetErrorString(e), grid_blocks); }
    }
}
```

```cpp
#include <hip/hip_runtime.h>
#include <hip/hip_cooperative_groups.h>
#include <stdint.h>
#include <cstdio>
namespace cg = cooperative_groups;

#define DI __device__ __forceinline__
typedef unsigned short bf16_t;
typedef short bf16x8 __attribute__((ext_vector_type(8)));
typedef float f32x4 __attribute__((ext_vector_type(4)));
typedef float f32x16 __attribute__((ext_vector_type(16)));
typedef unsigned u32x2 __attribute__((ext_vector_type(2)));
typedef unsigned u32x4 __attribute__((ext_vector_type(4)));
#define MFMA32(a, b, c) __builtin_amdgcn_mfma_f32_32x32x16_bf16((a), (b), (c), 0, 0, 0)

constexpr int NB = 4, S = 4096, M = NB * S, DM = 1024, ZP = 2048, NT = 512;
constexpr int DFF = 2816, NUP = 2 * DFF;
constexpr float EPS = 1e-6f;
constexpr int LDS_BYTES = 147456, LDS_ST = LDS_BYTES - 64;
constexpr int Z_CQ = 0, Z_KR = 384, Z_GT = 416, Z_CKV = 512, Z_QN = 768, Z_KC = 1280, Z_KS = 1408, Z_KW = 1536, Z_VC = 1664, Z_VS = 1792, Z_VW = 1920;
constexpr size_t MiB = 1024 * 1024;
constexpr size_t W_IN = 0, W_UQ = W_IN + (size_t)2048 * 1024 * 2, W_UKV = W_UQ + (size_t)768 * 384 * 2, W_C1K = W_UKV + (size_t)1024 * 256 * 2,
                 W_C1V = W_C1K + (size_t)256 * 2048 * 2, W_C2K = W_C1V + (size_t)256 * 2048 * 2, W_C2V = W_C2K + (size_t)256 * 128 * 2,
                 W_O = W_C2V + (size_t)256 * 128 * 2, W_UP = W_O + (size_t)1024 * 1024 * 2, W_DN = W_UP + (size_t)NUP * 1024 * 2,
                 W_END = W_DN + (size_t)1024 * DFF * 2;
constexpr size_t WL_STRIDE = 26 * MiB;
static_assert(W_END <= WL_STRIDE, "weights per layer");
constexpr size_t WS_A = 52 * MiB;
constexpr size_t WS_Z = WS_A, WS_Q = WS_A + 64 * MiB + 256 * 1024, WS_GACT = WS_A;
constexpr size_t WS_KV = 141 * MiB, WS_MIX = 173 * MiB, WS_HU = WS_KV;
constexpr size_t WS_HB = 205 * MiB + 64 * 1024;
constexpr size_t WS_MISC = 238 * MiB;
constexpr size_t WS_SSQH = WS_MISC, WS_SSQZ = WS_SSQH + 1 * MiB, WS_KR = WS_SSQZ + 2 * MiB, WS_HIDK = WS_KR + 1 * MiB, WS_HIDV = WS_HIDK + 1 * MiB,
                 WS_KCMP = WS_HIDV + 1 * MiB, WS_VCMP = WS_KCMP + 1 * MiB, WS_ROPE = WS_VCMP + 1 * MiB, WS_B1 = WS_ROPE + 1 * MiB, WS_CTL = WS_B1 + 64 * 1024,
                 WS_ENDALL = WS_CTL + 64 * 1024;
static_assert(WS_ENDALL <= 256 * MiB, "workspace");

struct Params {
    const float* in[20];
    float* out;
    unsigned char* ws;
    int ph_lo, ph_hi;
};

DI bf16_t f2bf(float x) { unsigned u = __float_as_uint(x); u += 0x7fffu + ((u >> 16) & 1u); return (bf16_t)(u >> 16); }
DI int tid_now() { int t = threadIdx.x; asm volatile("" : "+v"(t)); return t; }
DI float bf2f(bf16_t b) { return __uint_as_float(((unsigned)b) << 16); }
DI unsigned pk2(float lo, float hi) { return (unsigned)f2bf(lo) | ((unsigned)f2bf(hi) << 16); }
DI float wave_sum(float v) {
#pragma unroll
    for (int o = 1; o < 64; o <<= 1) v += __shfl_xor(v, o);
    return v;
}
DI float wave_max(float v) {
#pragma unroll
    for (int o = 1; o < 64; o <<= 1) v = fmaxf(v, __shfl_xor(v, o));
    return v;
}
DI float gelu_tanh(float x) { return 0.5f * x * (1.f + tanhf(0.7978845608028654f * (x + 0.044715f * x * x * x))); }
DI float rstd_h(const float* ssqh, int row) {
    const f32x4* p = (const f32x4*)(ssqh + (size_t)row * 16); float s = 0.f;
#pragma unroll
    for (int i = 0; i < 4; ++i) { f32x4 v = p[i]; s += (v[0] + v[1]) + (v[2] + v[3]); }
    return rsqrtf(s * (1.f / 1024.f) + EPS);
}
DI float rstd_q(const float* ssqz, int row) {
    const f32x4* p = (const f32x4*)(ssqz + (size_t)row * 24); float s = 0.f;
#pragma unroll
    for (int i = 0; i < 3; ++i) { f32x4 v = p[i]; s += (v[0] + v[1]) + (v[2] + v[3]); }
    return rsqrtf(s * (1.f / 384.f) + EPS);
}
DI float rstd_kv(const float* ssqz, int row) {
    const f32x4* p = (const f32x4*)(ssqz + (size_t)row * 24 + 16); float s = 0.f;
#pragma unroll
    for (int i = 0; i < 2; ++i) { f32x4 v = p[i]; s += (v[0] + v[1]) + (v[2] + v[3]); }
    return rsqrtf(s * (1.f / 256.f) + EPS);
}

namespace pg8 {
#define PG8_LAS __attribute__((address_space(3)))
typedef unsigned short bf16_t;
typedef short bf16x8 __attribute__((ext_vector_type(8)));
typedef float f32x4 __attribute__((ext_vector_type(4)));
typedef unsigned u32x4 __attribute__((ext_vector_type(4)));
constexpr int BM = 256, BK = 64, HALF = 128, HTB = HALF * BK * 2  , STAGE_BYTES = 8 * HTB, NXCD = 8, WGM = 8;

__host__ __device__ __forceinline__ int lds_byte(int r, int c) { const int st = (r >> 4) * 2 + (c >> 5), rr = r & 15, cc = c & 31, ob = rr * 64 + cc * 2; return st * 1024 + (ob ^ (((ob >> 9) & 1) << 5)); }
__host__ __device__ __forceinline__ void stage_rc(int b, int& R, int& C) { const int st = b / 1024, sb = b % 1024, swz = sb ^ (((sb >> 9) & 1) << 5); R = (st >> 1) * 16 + swz / 64; C = (st & 1) * 32 + (swz % 64) / 2; }
__host__ __device__ __forceinline__ int perm32(int rho) { const int n = rho >> 4, i = rho & 15; return 8 * (i >> 2) + 4 * n + (i & 3); }

struct Unit { int pm, pn; };
struct Gemm { const bf16_t* A; const bf16_t* Bt; int M, N, K; int lda; int kstepA; int cmp; };
__device__ __forceinline__ long long tileA_off(const Gemm& g, int pm) {
    if (g.cmp == 1) return (long long)(pm >> 1) * ((long long)4096 * 2048 * 2) + (long long)(pm & 1) * 128;
    if (g.cmp == 2) return ((long long)(pm / 17) * 4096 + 254 * (pm % 17) - 2) * (long long)(g.lda * 2);
    return (long long)pm * ((long long)BM * g.lda * 2); }

struct StaticOrder {
    int nM, nN, nwg, G, c;
    __host__ __device__ void init(int M, int N, int G_, int c_) { nM = M / BM; nN = N / BM; nwg = nM * nN; G = G_; c = c_; }
    __host__ __device__ bool next(int i, Unit& u) const {
        const long L = (long)i * G + c; if (L >= nwg) return false;
        int wgid = (int)L; { const int q = nwg / NXCD, r = nwg % NXCD, xcd = wgid % NXCD, off = wgid / NXCD; wgid = (xcd < r ? xcd * (q + 1) : r * (q + 1) + (xcd - r) * q) + off; }
        const int nig = WGM * nN, gid = wgid / nig, fm = gid * WGM, gsz = (nM - fm) < WGM ? (nM - fm) : WGM;
        u.pm = fm + ((wgid % nig) % gsz); u.pn = (wgid % nig) / gsz; return true;
    }
    __device__ __forceinline__ void a_ready(const Unit&) const {}
    __device__ __forceinline__ void done(const Unit&) const {}
};
__device__ __forceinline__ unsigned cvt_pk_bf16(float lo, float hi) { unsigned r; asm volatile("v_cvt_pk_bf16_f32 %0, %1, %2" : "=v"(r) : "v"(lo), "v"(hi)); return r; }
template <class Epi, class Sched, bool ALIGN_EPI = false, bool SP2 = false>
__device__ __forceinline__ void gemm_phase(PG8_LAS unsigned char* lds, const Gemm g, const Sched& S, const Epi& E) {
    int tid_ = threadIdx.x; asm volatile("" : "+v"(tid_));
    const int tid = tid_, wid = __builtin_amdgcn_readfirstlane(tid >> 6), lane = tid & 63, wr = wid >> 2, wc = wid & 3, fr = lane & 15, fq = lane >> 4;
    const int K = g.K, nt = K / BK;
    unsigned voffA[2], voffB[2];
#pragma unroll
    for (int i = 0; i < 2; ++i) { int R, C; stage_rc(tid * 16 + i * 8192, R, C); const int Rb = Epi::PERM ? ((R & ~31) + perm32(R & 31)) : R;
        voffA[i] = (unsigned)(R * g.lda + C) * 2u; voffB[i] = (unsigned)(Rb * K + C) * 2u; }
    const size_t kstepB = (size_t)(BK * 2), kstepA = (size_t)g.kstepA;
    const size_t hstepB = (size_t)HALF * K * 2, hstepA = (size_t)HALF * g.lda * 2;
    const size_t tstepB = 2 * hstepB;
    const unsigned ldsw = (unsigned)wid * 1024u;
    const int aoff = lds_byte(wr * 64 + fr, fq * 8), boff = lds_byte(wc * 32 + fr, fq * 8);
#define PG8_SA(b, h) (((b) * 2 + (h)) * HTB)
#define PG8_SB(b, h) ((4 + (b) * 2 + (h)) * HTB)
#define PG8_STAGE(bufoff, gbase, voff) do { _Pragma("unroll") for (int _i = 0; _i < 2; ++_i) \
        __builtin_amdgcn_global_load_lds((const unsigned*)((const char*)(gbase) + (voff)[_i]), (PG8_LAS unsigned*)(lds + (bufoff) + ldsw + _i * 8192), 16, 0, 0); } while (0)
#define PG8_LDA(dst, b, h) do { _Pragma("unroll") for (int m = 0; m < 4; ++m) _Pragma("unroll") for (int k = 0; k < 2; ++k) dst[m][k] = *(const PG8_LAS bf16x8*)(lds + PG8_SA(b, h) + aoff + m * 2048 + k * 1024); } while (0)
#define PG8_LDB(dst, b, h) do { _Pragma("unroll") for (int n = 0; n < 2; ++n) _Pragma("unroll") for (int k = 0; k < 2; ++k) dst[n][k] = *(const PG8_LAS bf16x8*)(lds + PG8_SB(b, h) + boff + n * 2048 + k * 1024); } while (0)
#define PG8_MMA(ai, bj, At, Bt) do { __builtin_amdgcn_s_setprio(1); _Pragma("unroll") for (int m = 0; m < 4; ++m) _Pragma("unroll") for (int n = 0; n < 2; ++n) _Pragma("unroll") for (int k = 0; k < 2; ++k) \
        acc[ai][bj][m][n] = __builtin_amdgcn_mfma_f32_16x16x32_bf16(Bt[n][k], At[m][k], acc[ai][bj][m][n], 0, 0, 0); __builtin_amdgcn_s_setprio(0); } while (0)
#define PG8_WAIT_V(n) asm volatile("s_waitcnt vmcnt(" #n ")" ::: "memory")
#define PG8_WAIT_L(n) asm volatile("s_waitcnt lgkmcnt(" #n ")" ::: "memory")
#define PG8_BAR __builtin_amdgcn_s_barrier()
#define PG8_SCHED __builtin_amdgcn_sched_barrier(0)
    Unit cur, nxt; int ui = 0;
    if (!S.next(0, cur)) return;
    f32x4 acc[2][2][4][2];
#pragma unroll
    for (int a = 0; a < 2; ++a)
#pragma unroll
        for (int b = 0; b < 2; ++b)
#pragma unroll
            for (int m = 0; m < 4; ++m)
#pragma unroll
                for (int n = 0; n < 2; ++n) acc[a][b][m][n] = (f32x4){0.f, 0.f, 0.f, 0.f};
    bf16x8 At[4][2], B0[2][2], B1[2][2];
    const char* cA = (const char*)g.A + tileA_off(g, cur.pm); const char* cB = (const char*)g.Bt + (size_t)cur.pn * tstepB;
    S.a_ready(cur);
    if constexpr (SP2) {
        PG8_STAGE(PG8_SB(0, 0), cB, voffB); PG8_STAGE(PG8_SB(0, 1), cB + hstepB, voffB); PG8_STAGE(PG8_SA(0, 0), cA, voffA); PG8_STAGE(PG8_SA(0, 1), cA + hstepA, voffA);
        if (wr == 1) PG8_BAR;
        PG8_WAIT_V(2); PG8_BAR;
        PG8_STAGE(PG8_SB(1, 0), cB + kstepB, voffB); PG8_STAGE(PG8_SA(1, 0), cA + kstepA, voffA); PG8_STAGE(PG8_SB(1, 1), cB + hstepB + kstepB, voffB);
        PG8_WAIT_V(6); PG8_BAR;
    } else {
        PG8_STAGE(PG8_SB(0, 0), cB, voffB); PG8_STAGE(PG8_SA(0, 0), cA, voffA); PG8_STAGE(PG8_SB(0, 1), cB + hstepB, voffB); PG8_STAGE(PG8_SA(0, 1), cA + hstepA, voffA);
        if (wr == 1) PG8_BAR;
        PG8_WAIT_V(4); PG8_BAR;
        PG8_STAGE(PG8_SB(1, 0), cB + kstepB, voffB); PG8_STAGE(PG8_SA(1, 0), cA + kstepA, voffA); PG8_STAGE(PG8_SB(1, 1), cB + hstepB + kstepB, voffB);
        PG8_WAIT_V(6); PG8_BAR;
    }
    for (;;) {
        const bool has_next = S.next(ui + 1, nxt);
        const char* nA = has_next ? (const char*)g.A + tileA_off(g, nxt.pm) : cA; const char* nB = has_next ? (const char*)g.Bt + (size_t)nxt.pn * tstepB : cB;
        for (int t = 0; t < nt; t += 2) {
            const bool last = (t == nt - 2);
            const char* a1 = cA + (size_t)(t + 1) * kstepA;
            const char* a2 = last ? nA : cA + (size_t)(t + 2) * kstepA; const char* b2 = last ? nB : cB + (size_t)(t + 2) * kstepB;
            const char* a3 = a2 + kstepA; const char* b3 = b2 + kstepB;
            if (last && has_next) S.a_ready(nxt);
            if constexpr (SP2) {
            PG8_LDB(B0, 0, 0); PG8_LDB(B1, 0, 1); PG8_SCHED; PG8_LDA(At, 0, 0); PG8_STAGE(PG8_SA(1, 1), a1 + hstepA, voffA);
            PG8_WAIT_V(8); PG8_WAIT_L(0); PG8_BAR; PG8_MMA(0, 0, At, B0); PG8_MMA(0, 1, At, B1); PG8_BAR; PG8_SCHED;
            PG8_LDA(At, 0, 1); PG8_STAGE(PG8_SB(0, 0), b2, voffB); PG8_STAGE(PG8_SB(0, 1), b2 + hstepB, voffB); PG8_STAGE(PG8_SA(0, 0), a2, voffA);
            PG8_WAIT_V(8); PG8_WAIT_L(0); PG8_BAR; PG8_MMA(1, 0, At, B0); PG8_MMA(1, 1, At, B1); PG8_BAR; PG8_SCHED;
            PG8_LDB(B0, 1, 0); PG8_LDB(B1, 1, 1); PG8_SCHED; PG8_LDA(At, 1, 0); PG8_STAGE(PG8_SA(0, 1), a2 + hstepA, voffA);
            PG8_WAIT_V(8); PG8_WAIT_L(0); PG8_BAR; PG8_MMA(0, 0, At, B0); PG8_MMA(0, 1, At, B1); PG8_BAR; PG8_SCHED;
            PG8_LDA(At, 1, 1); PG8_STAGE(PG8_SB(1, 0), b3, voffB); PG8_STAGE(PG8_SB(1, 1), b3 + hstepB, voffB); PG8_STAGE(PG8_SA(1, 0), a3, voffA);
            PG8_WAIT_V(8); PG8_WAIT_L(0); PG8_BAR; PG8_MMA(1, 0, At, B0); PG8_MMA(1, 1, At, B1); PG8_BAR; PG8_SCHED;
            } else {
            PG8_LDB(B0, 0, 0); PG8_SCHED; PG8_LDA(At, 0, 0); PG8_STAGE(PG8_SA(1, 1), a1 + hstepA, voffA);
            PG8_WAIT_L(8); PG8_BAR; PG8_WAIT_L(0); PG8_MMA(0, 0, At, B0); PG8_BAR; PG8_SCHED;
            PG8_LDB(B1, 0, 1); PG8_STAGE(PG8_SB(0, 0), b2, voffB);
            PG8_BAR; PG8_WAIT_L(0); PG8_MMA(0, 1, At, B1); PG8_BAR;
            PG8_LDA(At, 0, 1); PG8_STAGE(PG8_SA(0, 0), a2, voffA);
            PG8_BAR; PG8_WAIT_L(0); PG8_MMA(1, 0, At, B0); PG8_BAR; PG8_SCHED;
            PG8_STAGE(PG8_SB(0, 1), b2 + hstepB, voffB);
            PG8_WAIT_V(6); PG8_BAR; PG8_MMA(1, 1, At, B1); PG8_BAR;
            PG8_LDB(B0, 1, 0); PG8_SCHED; PG8_LDA(At, 1, 0); PG8_STAGE(PG8_SA(0, 1), a2 + hstepA, voffA);
            PG8_WAIT_L(8); PG8_BAR; PG8_WAIT_L(0); PG8_MMA(0, 0, At, B0); PG8_BAR; PG8_SCHED;
            PG8_LDB(B1, 1, 1); PG8_STAGE(PG8_SB(1, 0), b3, voffB);
            PG8_BAR; PG8_WAIT_L(0); PG8_MMA(0, 1, At, B1); PG8_BAR;
            PG8_LDA(At, 1, 1); PG8_STAGE(PG8_SA(1, 0), a3, voffA);
            PG8_BAR; PG8_WAIT_L(0); PG8_MMA(1, 0, At, B0); PG8_BAR; PG8_SCHED;
            PG8_STAGE(PG8_SB(1, 1), b3 + hstepB, voffB);
            PG8_WAIT_V(6); PG8_BAR; PG8_MMA(1, 1, At, B1); PG8_BAR;
            }
        }
        if constexpr (ALIGN_EPI) { if (wr == 0) PG8_BAR; }
        if constexpr (!Epi::AFTER_DRAIN) { E(acc, cur, wr, wc, fr, fq); S.done(cur); }
        if (!has_next) break;
#pragma unroll
        for (int a = 0; a < 2; ++a)
#pragma unroll
            for (int b = 0; b < 2; ++b)
#pragma unroll
                for (int m = 0; m < 4; ++m)
#pragma unroll
                    for (int n = 0; n < 2; ++n) acc[a][b][m][n] = (f32x4){0.f, 0.f, 0.f, 0.f};
        cur = nxt; cA = nA; cB = nB; ++ui;
        if constexpr (ALIGN_EPI) { if (wr == 1) PG8_BAR; }
    }
    PG8_WAIT_V(0);
    if constexpr (!ALIGN_EPI) { if (wr == 0) PG8_BAR; }
    PG8_BAR;
    if constexpr (Epi::AFTER_DRAIN) { E.fused(acc, cur, wr, wc, fr, fq, lds, wid, lane); S.done(cur); }
#undef PG8_SA
#undef PG8_SB
#undef PG8_STAGE
#undef PG8_LDA
#undef PG8_LDB
#undef PG8_MMA
#undef PG8_WAIT_V
#undef PG8_WAIT_L
#undef PG8_BAR
#undef PG8_SCHED
}
}

namespace pg8 {
enum { EM_SCALEH = 0, EM_SCALEQ = 1, EM_SCALEKV = 2, EM_GELU = 3, EM_PLAIN = 4, EM_RES = 5 };
template <int MODE, int STATS  > struct EpiG {
    static constexpr bool PERM = true, AFTER_DRAIN = false;
    bf16_t* O; int ldc; int nvalid; const float* ssq_in; int rowoff; const float* bias; float* H; float* ssq_out; const float* Hin;
    __device__ __forceinline__ void operator()(const f32x4 (&acc)[2][2][4][2], const Unit& u, int wr, int wc, int fr, int fq) const {
        const int row0 = u.pm * BM + wr * 64 + fr, col0 = u.pn * BM + wc * 32 + 8 * fq;
#pragma unroll
        for (int ai = 0; ai < 2; ++ai)
#pragma unroll
            for (int m = 0; m < 4; ++m) {
                const int row = row0 + ai * HALF + m * 16;
                float sc = 1.f;
                if (MODE == EM_SCALEH) sc = ::rstd_h(ssq_in, row + rowoff);
                if (MODE == EM_SCALEQ) sc = ::rstd_q(ssq_in, row);
                if (MODE == EM_SCALEKV) sc = ::rstd_kv(ssq_in, row);
                float ss[2] = {0.f, 0.f};
#pragma unroll
                for (int bj = 0; bj < 2; ++bj) {
                    const int col = col0 + bj * HALF;
                    f32x4 v0 = acc[ai][bj][m][0] * sc, v1 = acc[ai][bj][m][1] * sc;
                    if (MODE == EM_GELU) { if (col < nvalid) { const f32x4 b0 = *(const f32x4*)(bias + col), b1 = *(const f32x4*)(bias + col + 4);
#pragma unroll
                        for (int i = 0; i < 4; ++i) { v0[i] = ::gelu_tanh(v0[i] + b0[i]); v1[i] = ::gelu_tanh(v1[i] + b1[i]); } } }
                    if (MODE == EM_RES) { const f32x4* hi = (const f32x4*)(Hin + (size_t)row * 1024 + col); f32x4* hp = (f32x4*)(H + (size_t)row * 1024 + col); v0 += hi[0]; v1 += hi[1]; hp[0] = v0; hp[1] = v1; }
                    if (STATS) ss[bj] = ((v0[0] * v0[0] + v0[1] * v0[1]) + (v0[2] * v0[2] + v0[3] * v0[3])) + ((v1[0] * v1[0] + v1[1] * v1[1]) + (v1[2] * v1[2] + v1[3] * v1[3]));
                    if (col < nvalid) { u32x4 w; w.x = cvt_pk_bf16(v0[0], v0[1]); w.y = cvt_pk_bf16(v0[2], v0[3]); w.z = cvt_pk_bf16(v1[0], v1[1]); w.w = cvt_pk_bf16(v1[2], v1[3]);
                        *(u32x4*)(O + (size_t)row * ldc + col) = w; }
                }
                if (STATS == 1) { float t = ss[0] + ss[1]; t += __shfl_xor(t, 16); t += __shfl_xor(t, 32); if (fq == 0) ssq_out[(size_t)row * 16 + u.pn * 4 + wc] = t; }
                if (STATS == 2) { if (u.pn <= 2) { float t0 = ss[0], t1 = ss[1]; t0 += __shfl_xor(t0, 16); t0 += __shfl_xor(t0, 32); t1 += __shfl_xor(t1, 16); t1 += __shfl_xor(t1, 32);
                    if (fq == 0) { ssq_out[(size_t)row * 24 + u.pn * 8 + wc] = t0; ssq_out[(size_t)row * 24 + u.pn * 8 + 4 + wc] = t1; } } }
            }
    }
};

typedef unsigned u32x2_t __attribute__((ext_vector_type(2)));
template <int CTRL> __device__ __forceinline__ float dppf(float v) { return __int_as_float(__builtin_amdgcn_update_dpp(0, __float_as_int(v), CTRL, 0xf, 0xf, true)); }
#define DPPF(v, ctrl) dppf<ctrl>(v)
template <int STRIDE> struct EpiConv {
    static constexpr bool PERM = true, AFTER_DRAIN = false;
    bf16_t* Gt; const float* ssqh; const float* cw; const float* cb; PG8_LAS float* xch;
    __device__ __forceinline__ void operator()(f32x4 (&acc)[2][2][4][2], const Unit& u, int wr, int wc, int fr_in, int fq_in) const {
        int fr = fr_in, fq = fq_in; asm volatile("" : "+v"(fr), "+v"(fq));
        const int b = STRIDE == 254 ? u.pm / 17 : u.pm / 16, tl0 = STRIDE == 254 ? 254 * (u.pm % 17) - 2 : 256 * (u.pm % 16), wid = wr * 4 + wc;
#pragma unroll
        for (int ai = 0; ai < 2; ++ai)
#pragma unroll
            for (int m = 0; m < 4; ++m) {
                const int tl = tl0 + ai * HALF + wr * 64 + m * 16 + fr; float sc = 0.f;
                if (tl >= 0 && tl < 4096) sc = ::rstd_h(ssqh, b * 4096 + tl);
#pragma unroll
                for (int bj = 0; bj < 2; ++bj)
#pragma unroll
                    for (int n = 0; n < 2; ++n) acc[ai][bj][m][n] *= sc;
            }
        if (fr >= 14) {
#pragma unroll
            for (int ai = 0; ai < 2; ++ai)
#pragma unroll
                for (int bj = 0; bj < 2; ++bj)
#pragma unroll
                    for (int n = 0; n < 2; ++n) *(PG8_LAS f32x4*)(xch + ((((wid * 2 + ai) * 4 + fq) * 2 + (fr - 14)) * 4 + bj * 2 + n) * 4) = acc[ai][bj][3][n];
        }
        asm volatile("s_waitcnt lgkmcnt(0)" ::: "memory"); __builtin_amdgcn_s_barrier(); asm volatile("" ::: "memory");
        const int chl = u.pn * 128 + wc * 32 + 8 * fq;
#pragma unroll
        for (int n = 0; n < 2; ++n) {
            const int ch = chl + 4 * n;
            const float* cwv = cw + ch; const float* cbv = cb + ch; asm volatile("" : "+v"(cwv), "+v"(cbv));
            const f32x4 wg0 = *(const f32x4*)(cwv), wg1 = *(const f32x4*)(cwv + 5632), wg2 = *(const f32x4*)(cwv + 2 * 5632), bg = *(const f32x4*)(cbv);
            const f32x4 wu0 = *(const f32x4*)(cwv + 2816), wu1 = *(const f32x4*)(cwv + 5632 + 2816), wu2 = *(const f32x4*)(cwv + 2 * 5632 + 2816), bu = *(const f32x4*)(cbv + 2816);
#pragma unroll
            for (int ai = 0; ai < 2; ++ai)
#pragma unroll
                for (int m = 0; m < 4; ++m) {
                    f32x4 pg = {0.f, 0.f, 0.f, 0.f}, pu = {0.f, 0.f, 0.f, 0.f};
                    if (m > 0) { pg = acc[ai][0][m - 1][n]; pu = acc[ai][1][m - 1][n]; }
                    else if (wr == 1 || ai == 1) {
                        const int sw = (wr == 1 ? 0 : 4) + wc, sai = wr == 1 ? ai : 0;
                        if (fr >= 14) { const PG8_LAS float* xp = xch + ((((sw * 2 + sai) * 4 + fq) * 2 + (fr - 14)) * 4 + n) * 4; pg = *(const PG8_LAS f32x4*)xp; pu = *(const PG8_LAS f32x4*)(xp + 8); }
                    }
                    const f32x4 cg = acc[ai][0][m][n], cu = acc[ai][1][m][n];
                    f32x4 o;
#pragma unroll
                    for (int k = 0; k < 4; ++k) {
                        float hg = fmaf(wg2[k], cg[k], bg[k]), hu = fmaf(wu2[k], cu[k], bu[k]);
                        {
                            const float cgk = cg[k], pgk = pg[k], cuk = cu[k], puk = pu[k], g1w = wg1[k], g0w = wg0[k], u1w = wu1[k], u0w = wu0[k];
                            asm volatile("s_nop 1\n\t"
                                         "v_fmac_f32_dpp %0, %2, %4 row_shr:1 row_mask:0xf bank_mask:0xf bound_ctrl:1\n\t"
                                         "v_fmac_f32_dpp %1, %6, %8 row_shr:1 row_mask:0xf bank_mask:0xf bound_ctrl:1\n\t"
                                         "v_fmac_f32_dpp %0, %3, %4 row_shl:15 row_mask:0xf bank_mask:0xf bound_ctrl:1\n\t"
                                         "v_fmac_f32_dpp %1, %7, %8 row_shl:15 row_mask:0xf bank_mask:0xf bound_ctrl:1\n\t"
                                         "v_fmac_f32_dpp %0, %2, %5 row_shr:2 row_mask:0xf bank_mask:0xf bound_ctrl:1\n\t"
                                         "v_fmac_f32_dpp %1, %6, %9 row_shr:2 row_mask:0xf bank_mask:0xf bound_ctrl:1\n\t"
                                         "v_fmac_f32_dpp %0, %3, %5 row_shl:14 row_mask:0xf bank_mask:0xf bound_ctrl:1\n\t"
                                         "v_fmac_f32_dpp %1, %7, %9 row_shl:14 row_mask:0xf bank_mask:0xf bound_ctrl:1"
                                         : "+v"(hg), "+v"(hu) : "v"(cgk), "v"(pgk), "v"(g1w), "v"(g0w), "v"(cuk), "v"(puk), "v"(u1w), "v"(u0w));
                        }
                        o[k] = hg * __builtin_amdgcn_rcpf(1.f + __builtin_amdgcn_exp2f(-1.4426950408889634f * hg)) * hu;
                    }
                    const int lr = ai * HALF + wr * 64 + m * 16 + fr, tl = tl0 + lr;
                    if (lr >= (STRIDE == 254 ? 2 : 0) && tl < 4096) { u32x2_t w; w.x = cvt_pk_bf16(o[0], o[1]); w.y = cvt_pk_bf16(o[2], o[3]); *(u32x2_t*)(Gt + (size_t)(b * 4096 + tl) * 2816 + ch) = w; }
                }
        }
    }
};

struct EpiFinal {
    static constexpr bool PERM = true, AFTER_DRAIN = false;
    const float* Hin; float* Out; const float* gain; float* part; unsigned* cnt; PG8_LAS unsigned* flag;
    __device__ __forceinline__ void operator()(f32x4 (&acc)[2][2][4][2], const Unit& u, int wr, int wc, int fr, int fq) const {
        const int row0 = u.pm * BM + wr * 64 + fr, col0 = u.pn * BM + wc * 32 + 8 * fq;
#pragma unroll
        for (int ai = 0; ai < 2; ++ai)
#pragma unroll
            for (int m = 0; m < 4; ++m) {
                const int row = row0 + ai * HALF + m * 16; float ss = 0.f;
#pragma unroll
                for (int bj = 0; bj < 2; ++bj) { const f32x4* hi = (const f32x4*)(Hin + (size_t)row * 1024 + col0 + bj * HALF);
                    const f32x4 v0 = acc[ai][bj][m][0] + hi[0], v1 = acc[ai][bj][m][1] + hi[1]; acc[ai][bj][m][0] = v0; acc[ai][bj][m][1] = v1;
                    ss += ((v0[0] * v0[0] + v0[1] * v0[1]) + (v0[2] * v0[2] + v0[3] * v0[3])) + ((v1[0] * v1[0] + v1[1] * v1[1]) + (v1[2] * v1[2] + v1[3] * v1[3])); }
                ss += __shfl_xor(ss, 16); ss += __shfl_xor(ss, 32);
                if (fq == 0) __hip_atomic_store(part + (size_t)row * 16 + u.pn * 4 + wc, ss, __ATOMIC_RELAXED, __HIP_MEMORY_SCOPE_AGENT);
            }
        asm volatile("s_waitcnt vmcnt(0)" ::: "memory");
        unsigned* pc = cnt + 16 * u.pm;
        if (fr == 0 && fq == 0) __hip_atomic_fetch_add(pc, 1u, __ATOMIC_RELAXED, __HIP_MEMORY_SCOPE_AGENT);
        if (wr == 0 && wc == 0) {
            unsigned spins = 0;
            while (__hip_atomic_load(pc, __ATOMIC_RELAXED, __HIP_MEMORY_SCOPE_AGENT) < 32u && ++spins < (1u << 22)) __builtin_amdgcn_s_sleep(2);
        }
        asm volatile("s_waitcnt vmcnt(0) lgkmcnt(0)" ::: "memory"); __builtin_amdgcn_s_barrier(); asm volatile("" ::: "memory");
        __builtin_amdgcn_fence(__ATOMIC_ACQUIRE, "agent");
#pragma unroll
        for (int ai = 0; ai < 2; ++ai)
#pragma unroll
            for (int m = 0; m < 4; ++m) {
                const int row = row0 + ai * HALF + m * 16; float sq = 0.f;
#pragma unroll
                for (int i = 0; i < 4; ++i) sq += __hip_atomic_load(part + (size_t)row * 16 + 4 * fq + i, __ATOMIC_RELAXED, __HIP_MEMORY_SCOPE_AGENT);
                sq += __shfl_xor(sq, 16); sq += __shfl_xor(sq, 32);
                const float rs = rsqrtf(sq * (1.f / 1024.f) + 1e-6f);
#pragma unroll
                for (int bj = 0; bj < 2; ++bj) { const int col = col0 + bj * HALF; const f32x4 g0 = *(const f32x4*)(gain + col), g1 = *(const f32x4*)(gain + col + 4);
                    f32x4* op = (f32x4*)(Out + (size_t)row * 1024 + col); op[0] = acc[ai][bj][m][0] * rs * g0; op[1] = acc[ai][bj][m][1] * rs * g1; }
            }
    }
};
}
template <class Epi> __device__ __forceinline__ void run_gemm(PG8_LAS unsigned char* lds, const pg8::Gemm& g, const Epi& E, int G, int c) {
    pg8::StaticOrder So; So.init(g.M, g.N, G, c);
    pg8::gemm_phase<Epi, pg8::StaticOrder, true, true>(lds, g, So, E);
}

struct MapZ { DI int operator()(int n) const {
    if (n < 384) return n; if (n < 416) return 640 + (n - 384); if (n < 440) return 1952 + (n - 416); if (n < 512) return -1;
    if (n < 768) return 384 + (n - 512); if (n < 1280) return 672 + (n - 768); if (n < 1408) return 1184 + (n - 1280);
    if (n < 1536) return 1440 + (n - 1408); if (n < 1664) return 1696 + (n - 1536); if (n < 1792) return 1312 + (n - 1664);
    if (n < 1920) return 1568 + (n - 1792); return 1824 + (n - 1920); } };
struct MapUQ { DI int operator()(int n) const { if (n < 512) return (n >> 6) * 96 + (n & 63); n -= 512; return (n >> 5) * 96 + 64 + (n & 31); } };
struct MapUKV { DI int operator()(int n) const { if (n < 512) return (n >> 6) * 128 + (n & 63); n -= 512; return (n >> 6) * 128 + 64 + (n & 63); } };
struct MapUP { DI int operator()(int n) const { const int pn = n >> 8, j = n & 255; return j < 128 ? 128 * pn + j : DFF + 128 * pn + (j - 128); } };
struct MapId { int nvalid; DI int operator()(int n) const { return n < nvalid ? n : -1; } };

template <class Map>
DI void wconv(const float* __restrict__ W, int K, int Nsrc, const float* __restrict__ gain, bf16_t* __restrict__ dst, int Ndst, Map map, float* tile) {
    const int nkt = K / 64, ntiles = nkt * (Ndst / 64); const int tid = tid_now();
    const int kk0 = tid >> 4, nn4 = (tid & 15) * 4, nw = tid >> 3, cw = tid & 7;
    int it = blockIdx.x; if (it >= ntiles) return;
    f32x4 a0, a1, b0 = {0.f, 0.f, 0.f, 0.f}, b1 = {0.f, 0.f, 0.f, 0.f};
#define WCONV_LOAD(IT, R0, R1) do { const int kt_ = (IT) % nkt, nt_ = (IT) / nkt, k0_ = kt_ * 64, n0_ = nt_ * 64; const int src_ = map(n0_ + nn4); \
        R0 = (f32x4){0.f, 0.f, 0.f, 0.f}; R1 = R0; \
        if (src_ >= 0) { R0 = *(const f32x4*)(W + (size_t)(k0_ + kk0) * Nsrc + src_); R1 = *(const f32x4*)(W + (size_t)(k0_ + kk0 + 32) * Nsrc + src_); \
            if (gain) { R0 *= gain[k0_ + kk0]; R1 *= gain[k0_ + kk0 + 32]; } } } while (0)
    WCONV_LOAD(it, a0, a1);
    for (;;) {
        const int nit = it + gridDim.x;
        __syncthreads();
#pragma unroll
        for (int e = 0; e < 4; ++e) { tile[kk0 * 65 + nn4 + e] = a0[e]; tile[(kk0 + 32) * 65 + nn4 + e] = a1[e]; }
        if (nit < ntiles) WCONV_LOAD(nit, b0, b1);
        __syncthreads();
        { const int kt = it % nkt, nt = it / nkt, k0 = kt * 64, n0 = nt * 64;
          const float* tp = tile + (8 * cw) * 65 + nw;
          u32x4 w; w.x = pk2(tp[0], tp[65]); w.y = pk2(tp[2 * 65], tp[3 * 65]); w.z = pk2(tp[4 * 65], tp[5 * 65]); w.w = pk2(tp[6 * 65], tp[7 * 65]);
          *(u32x4*)(dst + (size_t)(n0 + nw) * K + k0 + 8 * cw) = w; }
        if (nit >= ntiles) break;
        a0 = b0; a1 = b1; it = nit;
    }
#undef WCONV_LOAD
}

template <class AF, class Epi>
DI void ngemm(AF af, const bf16_t* __restrict__ Bt, int ldb, int Mr, int N, int K, Epi epi, bool local = false) {
    const int tid = tid_now(), lane = tid & 63, wv = tid >> 6, r = lane & 31, h = lane >> 5;
    const int ntn = N / 64, ntm = Mr / 64; const int gw = local ? wv : blockIdx.x * 8 + wv, ngw = local ? 8 : gridDim.x * 8;
    for (int t = gw; t < ntn * ntm; t += ngw) {
        const int tn = t % ntn, tm = t / ntn, m0 = tm * 64, n0 = tn * 64;
        f32x16 acc[2][2];
#pragma unroll
        for (int a = 0; a < 2; ++a)
#pragma unroll
            for (int b = 0; b < 2; ++b)
#pragma unroll
                for (int i = 0; i < 16; ++i) acc[a][b][i] = 0.f;
        for (int k0 = 0; k0 < K; k0 += 16) {
            bf16x8 a[2], b[2];
#pragma unroll
            for (int mi = 0; mi < 2; ++mi) a[mi] = *(const bf16x8*)af(m0 + mi * 32 + r, k0 + 8 * h);
#pragma unroll
            for (int ni = 0; ni < 2; ++ni) b[ni] = *(const bf16x8*)(Bt + (size_t)(n0 + ni * 32 + r) * ldb + k0 + 8 * h);
#pragma unroll
            for (int mi = 0; mi < 2; ++mi)
#pragma unroll
                for (int ni = 0; ni < 2; ++ni) acc[mi][ni] = MFMA32(b[ni], a[mi], acc[mi][ni]);
        }
#pragma unroll
        for (int mi = 0; mi < 2; ++mi) {
            const int row = m0 + mi * 32 + r; const float ctx = epi.prep(row);
#pragma unroll
            for (int ni = 0; ni < 2; ++ni)
#pragma unroll
                for (int g = 0; g < 4; ++g) {
                    f32x4 v = {acc[mi][ni][4 * g], acc[mi][ni][4 * g + 1], acc[mi][ni][4 * g + 2], acc[mi][ni][4 * g + 3]};
                    epi.store(row, n0 + ni * 32 + 8 * g + 4 * h, v, ctx);
                }
        }
    }
}
struct APlain { const bf16_t* A; size_t lda; DI const bf16_t* operator()(int row, int k) const { return A + (size_t)row * lda + k; } };
struct ACmp { const bf16_t* z; int col0; DI const bf16_t* operator()(int row, int k) const {
    const int bg = row >> 8, n = row & 255, b = bg >> 1, g = bg & 1; return z + (size_t)(b * S + 16 * n + (k >> 6)) * ZP + col0 + g * 64 + (k & 63); } };

DI void st_bf4(bf16_t* p, f32x4 v) { u32x2 w; w.x = pk2(v[0], v[1]); w.y = pk2(v[2], v[3]); *(u32x2*)p = w; }
struct EpiScaleH { bf16_t* O; int ldc; const float* ssqh; int rowoff;
    DI float prep(int row) const { return rstd_h(ssqh, row + rowoff); }
    DI void store(int row, int col, f32x4 v, float c) const { st_bf4(O + (size_t)row * ldc + col, v * c); } };
struct EpiScaleQ { bf16_t* O; int ldc; const float* ssqz; int kv;
    DI float prep(int row) const { return kv ? rstd_kv(ssqz, row) : rstd_q(ssqz, row); }
    DI void store(int row, int col, f32x4 v, float c) const { st_bf4(O + (size_t)row * ldc + col, v * c); } };
struct EpiGelu { bf16_t* O; int ldc; const float* bias;
    DI float prep(int) const { return 0.f; }
    DI void store(int row, int col, f32x4 v, float) const { f32x4 o; for (int i = 0; i < 4; ++i) o[i] = gelu_tanh(v[i] + bias[col + i]); st_bf4(O + (size_t)row * ldc + col, o); } };
struct EpiPlain { bf16_t* O; int ldc;
    DI float prep(int) const { return 0.f; }
    DI void store(int row, int col, f32x4 v, float) const { st_bf4(O + (size_t)row * ldc + col, v); } };
struct EpiRes { float* H; bf16_t* HB;
    DI float prep(int) const { return 0.f; }
    DI void store(int row, int col, f32x4 v, float) const { f32x4* hp = (f32x4*)(H + (size_t)row * DM + col); f32x4 o = *hp + v; *hp = o; st_bf4(HB + (size_t)row * DM + col, o); } };

#define LAS PG8_LAS
#define XB_TMO      128
#define XB_XCNT(j)  (256  + 64 * (j))
#define XB_XSUB(j)  (1280 + 64 * (j))
#define XB_XGEN(j)  (2304 + 64 * (j))
#define XB_TOP      3328
#define XB_TOPGEN   3392
#define XCD_BAR_WORDS 3456
#define XB_SPIN_CAP (1u << 22)

__device__ __forceinline__ unsigned xb_ld(unsigned* p)              { return __hip_atomic_load(p, __ATOMIC_RELAXED, __HIP_MEMORY_SCOPE_AGENT); }
__device__ __forceinline__ unsigned xb_add(unsigned* p, unsigned v) { return __hip_atomic_fetch_add(p, v, __ATOMIC_RELAXED, __HIP_MEMORY_SCOPE_AGENT); }
__device__ __forceinline__ unsigned xb_xcc_id() { return (unsigned)__builtin_amdgcn_s_getreg((3 << 11) | 20) & 0xFu; }
#define XB_SPIN(cond, bar) do { unsigned _sp = 0; while (cond) { __builtin_amdgcn_s_sleep(1); \
    if ((++_sp & 255u) == 0u) { if (xb_ld(&(bar)[XB_TMO])) break; if (_sp > XB_SPIN_CAP) { atomicAdd(&(bar)[XB_TMO], 1u); break; } } } } while (0)

struct XcdBarrier {
    unsigned* bar; unsigned x;
    volatile LAS unsigned* st;
};

__device__ __forceinline__ XcdBarrier xcd_barrier_post(unsigned* bar, volatile LAS unsigned* st) {
    XcdBarrier b; b.bar = bar; b.x = xb_xcc_id(); b.st = st;
    if (threadIdx.x == 0) (void)xb_add(&bar[XB_XCNT(b.x)], 1u);
    return b;
}
__device__ __forceinline__ void xcd_barrier_complete(unsigned* bar, unsigned x, unsigned& nloc, unsigned& nx) {
    const unsigned G = gridDim.x * gridDim.y * gridDim.z;
    unsigned sum, cnt, mine, sp = 0u;
    for (;;) {
        sum = 0u; cnt = 0u; mine = 0u;
#pragma unroll
        for (unsigned j = 0; j < 16; ++j) { const unsigned c = xb_ld(&bar[XB_XCNT(j)]); sum += c; cnt += (c > 0u) ? 1u : 0u; mine = (j == x) ? c : mine; }
        if (sum == G) break;
        __builtin_amdgcn_s_sleep(1);
        if ((++sp & 255u) == 0u) { if (xb_ld(&bar[XB_TMO])) break; if (sp > XB_SPIN_CAP) { atomicAdd(&bar[XB_TMO], 1u); break; } }
    }
    nloc = mine > 0u ? mine : 1u; nx = cnt > 0u ? cnt : 1u;
}

__device__ __forceinline__ void xcd_barrier(const XcdBarrier& b) {
    asm volatile("s_waitcnt vmcnt(0)" ::: "memory");
    __syncthreads();
    if (threadIdx.x == 0) {
        unsigned* bar = b.bar;
        __builtin_amdgcn_s_waitcnt(0);
        unsigned nloc = b.st[0], nx = b.st[1];
        if (nloc == 0u) { xcd_barrier_complete(bar, b.x, nloc, nx); b.st[0] = nloc; b.st[1] = nx; }
        const unsigned old = xb_add(&bar[XB_XSUB(b.x)], 1u);
        const unsigned gen = old / nloc;
        if (old + 1u == (gen + 1u) * nloc) {
            __builtin_amdgcn_fence(__ATOMIC_RELEASE, "agent");
            asm volatile("s_waitcnt vmcnt(0)" ::: "memory");
            const unsigned og = xb_add(&bar[XB_TOP], 1u);
            const unsigned tg = og / nx;
            if (og + 1u == (tg + 1u) * nx) xb_add(&bar[XB_TOPGEN], 1u);
            else XB_SPIN(xb_ld(&bar[XB_TOPGEN]) == tg, bar);
            __builtin_amdgcn_fence(__ATOMIC_ACQUIRE, "agent");
            xb_add(&bar[XB_XGEN(b.x)], 1u);
            asm volatile("s_waitcnt vmcnt(0)" ::: "memory");
        } else {
            XB_SPIN(xb_ld(&bar[XB_XGEN(b.x)]) == gen, bar);
            __builtin_amdgcn_fence(__ATOMIC_ACQUIRE, "agent");
            asm volatile("s_waitcnt vmcnt(0)" ::: "memory");
        }
    }
    __syncthreads();
}
struct Frame {
    const Params __attribute__((address_space(4)))* kp; unsigned char* ws; float* smem; PG8_LAS unsigned char* ldsp;
    int tid, lane, wave, gw, ngw;
    DI bf16_t* wl(int l, size_t off) const { return (bf16_t*)(ws + (size_t)l * WL_STRIDE + off); }
    DI bf16_t* z() const { return (bf16_t*)(ws + WS_Z); }
    DI bf16_t* q() const { return (bf16_t*)(ws + WS_Q); }
    DI bf16_t* kv() const { return (bf16_t*)(ws + WS_KV); }
    DI bf16_t* mix() const { return (bf16_t*)(ws + WS_MIX); }
    DI bf16_t* hu() const { return (bf16_t*)(ws + WS_HU); }
    DI bf16_t* gact() const { return (bf16_t*)(ws + WS_GACT); }
    DI bf16_t* hb() const { return (bf16_t*)(ws + WS_HB); }
    DI float* ssqh() const { return (float*)(ws + WS_SSQH); }
    DI float* ssqz() const { return (float*)(ws + WS_SSQZ); }
    DI bf16_t* kr() const { return (bf16_t*)(ws + WS_KR); }
    DI bf16_t* hidk() const { return (bf16_t*)(ws + WS_HIDK); }
    DI bf16_t* hidv() const { return (bf16_t*)(ws + WS_HIDV); }
    DI bf16_t* kcmp() const { return (bf16_t*)(ws + WS_KCMP); }
    DI bf16_t* vcmp() const { return (bf16_t*)(ws + WS_VCMP); }
    DI float* rope() const { return (float*)(ws + WS_ROPE); }
    DI float* b1(int l, int v) const { return (float*)(ws + WS_B1) + (l * 2 + v) * 128; }
    DI float* h() const { return (float*)(__attribute__((address_space(1))) float*)kp->out; }
    DI const float* gin(int i) const { return (const float*)(const __attribute__((address_space(1))) float*)kp->in[i]; }
};

DI void phase_prep(Frame& F) {
    for (int l = 0; l < 2; ++l) {
        wconv(F.gin(2) + (size_t)l * 1024 * 1976, 1024, 1976, F.gin(1) + l * 1024, F.wl(l, W_IN), 2048, MapZ(), F.smem);
        wconv(F.gin(5) + (size_t)l * 384 * 768, 384, 768, F.gin(3) + l * 384, F.wl(l, W_UQ), 768, MapUQ(), F.smem);
        wconv(F.gin(6) + (size_t)l * 256 * 1024, 256, 1024, F.gin(4) + l * 256, F.wl(l, W_UKV), 1024, MapUKV(), F.smem);
        wconv(F.gin(9) + (size_t)l * 2048 * 128, 2048, 128, nullptr, F.wl(l, W_C1K), 256, MapId{128}, F.smem);
        wconv(F.gin(11) + (size_t)l * 2048 * 128, 2048, 128, nullptr, F.wl(l, W_C1V), 256, MapId{128}, F.smem);
        wconv(F.gin(10) + (size_t)l * 128 * 64, 128, 64, nullptr, F.wl(l, W_C2K), 256, MapId{64}, F.smem);
        wconv(F.gin(12) + (size_t)l * 128 * 64, 128, 64, nullptr, F.wl(l, W_C2V), 256, MapId{64}, F.smem);
        wconv(F.gin(13) + (size_t)l * 1024 * 1024, 1024, 1024, nullptr, F.wl(l, W_O), 1024, MapId{1024}, F.smem);
        wconv(F.gin(15) + (size_t)l * 1024 * NUP, 1024, NUP, F.gin(14) + l * 1024, F.wl(l, W_UP), NUP, MapUP(), F.smem);
        wconv(F.gin(18) + (size_t)l * DFF * 1024, DFF, 1024, nullptr, F.wl(l, W_DN), 1024, MapId{1024}, F.smem);
    }
    if (blockIdx.x >= gridDim.x - 64) {
        const int bb = blockIdx.x - (gridDim.x - 64), lv = bb >> 4, kp = bb & 15, l = lv >> 1, v = lv & 1, e = F.tid & 127, sub = F.tid >> 7;
        const float* pos = (v ? F.gin(8) : F.gin(7)) + l * 2048; const float* w1 = (v ? F.gin(11) : F.gin(9)) + (size_t)l * 2048 * 128;
        float s = 0.f; const int k0 = kp * 128 + sub * 32;
#pragma unroll 8
        for (int k = k0; k < k0 + 32; ++k) s += pos[k] * w1[(size_t)k * 128 + e];
        __syncthreads(); F.smem[F.tid] = s; __syncthreads();
        if (F.tid < 128) ((float*)(F.ws + WS_B1))[1024 + (lv * 16 + kp) * 128 + e] = (F.smem[e] + F.smem[128 + e]) + (F.smem[256 + e] + F.smem[384 + e]);
        __syncthreads();
    }
    for (int i = blockIdx.x * NT + F.tid; i < S * 16; i += gridDim.x * NT) {
        const int t = i >> 4, j = i & 15; const float inv = 1.0f / powf(10000.0f, (float)(2 * j) / 32.0f); const float ang = (float)t * inv;
        F.rope()[i] = cosf(ang); F.rope()[S * 16 + i] = sinf(ang);
    }
    for (int row = F.gw; row < M; row += F.ngw) {
        const f32x4* xr = (const f32x4*)(F.gin(0) + (size_t)row * DM) + F.lane; float s = 0.f;
#pragma unroll
        for (int j = 0; j < 4; ++j) { f32x4 v = xr[64 * j]; s += (v[0] * v[0] + v[1] * v[1]) + (v[2] * v[2] + v[3] * v[3]);
            st_bf4(F.hb() + (size_t)row * DM + 4 * (F.lane + 64 * j), v); }
        s = wave_sum(s);
        if (F.lane < 16) F.ssqh()[(size_t)row * 16 + F.lane] = F.lane == 0 ? s : 0.f;
    }
}
DI void phase_stat_h(Frame& F) {
    for (int row = F.gw; row < M; row += F.ngw) {
        const f32x4* hr = (const f32x4*)(F.h() + (size_t)row * DM) + F.lane; float s = 0.f;
#pragma unroll
        for (int j = 0; j < 4; ++j) { f32x4 v = hr[64 * j]; s += (v[0] * v[0] + v[1] * v[1]) + (v[2] * v[2] + v[3] * v[3]); }
        s = wave_sum(s);
        if (F.lane < 16) F.ssqh()[(size_t)row * 16 + F.lane] = F.lane == 0 ? s : 0.f;
    }
}
DI void phase_stat_z(Frame& F) {
    for (int row = F.gw; row < M; row += F.ngw) {
        const bf16_t* zr = F.z() + (size_t)row * ZP; float sq = 0.f, sk = 0.f;
        for (int j = 0; j < 6; ++j) { float v = bf2f(zr[Z_CQ + F.lane + 64 * j]); sq += v * v; }
        for (int j = 0; j < 4; ++j) { float v = bf2f(zr[Z_CKV + F.lane + 64 * j]); sk += v * v; }
        sq = wave_sum(sq); sk = wave_sum(sk);
        if (F.lane < 24) F.ssqz()[(size_t)row * 24 + F.lane] = F.lane == 0 ? sq : (F.lane == 16 ? sk : 0.f);
    }
}
DI void job_krope(Frame& F) {
    for (int i = blockIdx.x * NT + F.tid; i < M * 16; i += gridDim.x * NT) {
        const int row = i >> 4, j = i & 15, t = row & (S - 1);
        const float c = F.rope()[t * 16 + j], s = F.rope()[S * 16 + t * 16 + j];
        const float x1 = bf2f(F.z()[(size_t)row * ZP + Z_KR + j]), x2 = bf2f(F.z()[(size_t)row * ZP + Z_KR + 16 + j]);
        F.kr()[(size_t)row * 32 + j] = f2bf(x1 * c - x2 * s); F.kr()[(size_t)row * 32 + 16 + j] = f2bf(x2 * c + x1 * s);
    }
}

struct OS { float m, l, o; };
DI void os_init(OS& s) { s.m = -INFINITY; s.l = 0.f; s.o = 0.f; }
DI void os_chunk(OS& st, float s, bool valid, const bf16_t* vbase, size_t vstride, int lane) {
    unsigned long long bal = __ballot(valid);
    if (!bal) return;
    const float cm = wave_max(valid ? s : -INFINITY);
    const float mn = fmaxf(st.m, cm);
    const float alpha = __expf(st.m - mn);
    const float p = valid ? __expf(s - mn) : 0.f;
    st.l = st.l * alpha + wave_sum(p);
    float acc = st.o * alpha;
    while (bal) { const int kk = __ffsll((long long)bal) - 1; bal &= bal - 1; const float pk = __shfl(p, kk); acc += pk * bf2f(vbase[(size_t)kk * vstride + lane]); }
    st.o = acc; st.m = mn;
}
DI float dot_bf(const float* q, const bf16_t* k, int n) {
    float s = 0.f;
    for (int d = 0; d < n; d += 8) { bf16x8 kv = *(const bf16x8*)(k + d);
#pragma unroll
        for (int j = 0; j < 8; ++j) s += q[d + j] * bf2f((bf16_t)kv[j]); }
    return s;
}
DI void phase_attn_naive(Frame& F) {
    float* wq = F.smem + F.wave * 640;
    float* pl = wq + 128;
    const bf16_t* q = F.q(); const bf16_t* kv = F.kv(); const bf16_t* kr = F.kr(); const bf16_t* z = F.z(); bf16_t* mix = F.mix();
    const int lane = F.lane;
    for (int task = F.gw; task < M * 8; task += F.ngw) {
        const int hd = task & 7, row = task >> 3, b = row >> 12, t = row & (S - 1);
        wq[lane] = bf2f(q[(size_t)row * 768 + hd * 64 + lane]);
        if (lane < 16) { const float c = F.rope()[t * 16 + lane], s = F.rope()[S * 16 + t * 16 + lane];
            const float x1 = bf2f(q[(size_t)row * 768 + 512 + hd * 32 + lane]), x2 = bf2f(q[(size_t)row * 768 + 512 + hd * 32 + 16 + lane]);
            wq[64 + lane] = x1 * c - x2 * s; wq[80 + lane] = x2 * c + x1 * s; }
        __builtin_amdgcn_wave_barrier();
        OS st; os_init(st);
        const float scale = 0.10206207261596575f;
        for (int k0 = 0; k0 <= t; k0 += 64) {
            const int key = k0 + lane; const bool valid = key <= t; const size_t kro = (size_t)(b * S + (valid ? key : t));
            const float s = (dot_bf(wq, kv + kro * 1024 + hd * 64, 64) + dot_bf(wq + 64, kr + kro * 32, 32)) * scale;
            os_chunk(st, s, valid, kv + (size_t)(b * S + k0) * 1024 + 512 + hd * 64, 1024, lane);
        }
        mix[(size_t)row * DM + hd * 64 + lane] = f2bf(st.o / st.l);
        __builtin_amdgcn_wave_barrier();
    }
    for (int task = F.gw; task < M * 2; task += F.ngw) {
        const int g = task & 1, row = task >> 1, b = row >> 12, t = row & (S - 1), bg = b * 2 + g, cur = t >> 6;
        const int nvis = t >= 31 ? ((t - 31) >> 4) + 1 : 0;
        float* ocs = wq + 384; float imp = 0.f;
        const bf16_t* kc = F.kcmp() + (size_t)bg * 256 * 64; const bf16_t* vc = F.vcmp() + (size_t)bg * 256 * 64;
        for (int r = 0; r < 4; ++r) {
            const int hd = g * 4 + r; const float slope = exp2f(-(float)(hd + 1));
            wq[lane] = bf2f(z[(size_t)row * ZP + Z_QN + hd * 64 + lane]);
            __builtin_amdgcn_wave_barrier();
            float sc[4]; float mx = -INFINITY;
#pragma unroll
            for (int i = 0; i < 4; ++i) { const int n = lane + 64 * i; const bool valid = n < nvis;
                sc[i] = valid ? dot_bf(wq, kc + (size_t)n * 64, 64) * 0.125f - slope * (float)(t - (16 * n + 31)) : -INFINITY; mx = fmaxf(mx, sc[i]); }
            mx = wave_max(mx);
            float ps[4]; float l = 0.f;
#pragma unroll
            for (int i = 0; i < 4; ++i) { ps[i] = (lane + 64 * i) < nvis ? __expf(sc[i] - mx) : 0.f; l += ps[i]; }
            l = wave_sum(l); const float il = nvis > 0 ? 1.f / l : 0.f;
            float o = 0.f;
#pragma unroll
            for (int i = 0; i < 4; ++i) { ps[i] *= il; pl[lane + 64 * i] = ps[i];
                const int cnt = nvis - 64 * i; for (int kk = 0; kk < 64 && kk < cnt; ++kk) { const float pk = __shfl(ps[i], kk); o += pk * bf2f(vc[(size_t)(64 * i + kk) * 64 + lane]); } }
            ocs[r * 64 + lane] = o;
            __builtin_amdgcn_wave_barrier();
            { const int j = lane; float a = 0.f; for (int n = 4 * j - 1; n <= 4 * j + 3; ++n) if (n >= 0 && n < 255) a += pl[n]; imp += a; }
            __builtin_amdgcn_wave_barrier();
        }
        float v = imp; if (lane > cur) v = -INFINITY; if (lane == 0 || lane == cur || lane == cur - 1) v = INFINITY;
        int rank = 0;
        for (int j = 0; j < 64; ++j) { const float vj = __shfl(v, j); rank += (vj > v || (vj == v && j < lane)) ? 1 : 0; }
        const unsigned long long selmask = __ballot(rank < 16 && lane <= cur);
        for (int r = 0; r < 4; ++r) {
            const int hd = g * 4 + r; const float slope = exp2f(-(float)(hd + 1));
            wq[lane] = bf2f(z[(size_t)row * ZP + Z_QN + hd * 64 + lane]);
            __builtin_amdgcn_wave_barrier();
            OS ss; os_init(ss);
            unsigned long long mm = selmask;
            while (mm) { const int j = __ffsll((long long)mm) - 1; mm &= mm - 1; const int key = 64 * j + lane; const bool valid = key <= t;
                const size_t kro = (size_t)(b * S + (valid ? key : t));
                const float s = dot_bf(wq, z + kro * ZP + Z_KS + g * 64, 64) * 0.125f - slope * (float)(t - key);
                os_chunk(ss, s, valid, z + (size_t)(b * S + 64 * j) * ZP + Z_VS + g * 64, ZP, lane); }
            OS sw; os_init(sw);
            for (int c = 0; c < 9; ++c) { const int j = cur - 8 + c; if (j < 0) continue; const int key = 64 * j + lane; const bool valid = key <= t && (t - key) < 512;
                const size_t kro = (size_t)(b * S + (key <= t ? key : t));
                const float s = dot_bf(wq, z + kro * ZP + Z_KW + g * 64, 64) * 0.125f - slope * (float)(t - key);
                os_chunk(sw, s, valid, z + (size_t)(b * S + 64 * j) * ZP + Z_VW + g * 64, ZP, lane); }
            const bf16_t* gt = z + (size_t)row * ZP + Z_GT + hd * 3;
            const float g0 = 1.f / (1.f + __expf(-bf2f(gt[0]))), g1 = 1.f / (1.f + __expf(-bf2f(gt[1]))), g2 = 1.f / (1.f + __expf(-bf2f(gt[2])));
            const float o = g0 * ocs[r * 64 + lane] + g1 * (ss.o / ss.l) + g2 * (sw.o / sw.l);
            mix[(size_t)row * DM + 512 + hd * 64 + lane] = f2bf(o);
            __builtin_amdgcn_wave_barrier();
        }
    }
}

typedef PG8_LAS bf16_t* lbf;
typedef short s16x4 __attribute__((ext_vector_type(4)));
typedef __bf16 bfv2 __attribute__((ext_vector_type(2)));
typedef float f32x2 __attribute__((ext_vector_type(2)));
constexpr int A_KSZ = 64 * 104, A_VLD = 72, A_VSZ = 64 * A_VLD;
constexpr int A_KOFF = 0, A_VOFF = 2 * A_KSZ * 2, A_IMP = A_VOFF + 2 * A_VSZ * 2, A_IMPLD = 65, A_SELM = A_IMP + 4 * 64 * A_IMPLD * 4, A_UNI = A_SELM + 512, A_IL = A_UNI + 16, A_QIDX = A_IL + 1024, A_END = A_QIDX + 16;
static_assert(A_END <= LDS_BYTES, "attention LDS");
constexpr float LOG2E = 1.4426950408889634f;
DI unsigned cvt2(float lo, float hi) { f32x2 f = {lo, hi}; bfv2 b = __builtin_convertvector(f, bfv2); return __builtin_bit_cast(unsigned, b); }
DI int crow_(int i, int h) { return (i & 3) + 8 * (i >> 2) + 4 * h; }
struct TileRegs { u32x4 k, v, k2; };
template <bool MLA> DI void tile_gload(TileRegs& R, const bf16_t* kp, size_t kst, const bf16_t* vp, size_t vst, const bf16_t* k2p, int kb, int tid) {
    const int key = tid >> 3, c = tid & 7;
    R.k = *(const u32x4*)(kp + (size_t)(kb + key) * kst + 8 * c);
    R.v = *(const u32x4*)(vp + (size_t)(kb + (tid & 63)) * vst + 8 * (tid >> 6));
    if (MLA) R.k2 = *(const u32x4*)(k2p + (size_t)(kb + ((tid & 255) >> 2)) * 32 + 8 * (tid & 3));
}
template <bool MLA> DI void tile_lstore(const TileRegs& R, lbf Ks, lbf Vt, int tid) {
    constexpr int KLD = MLA ? 104 : 72;
    const int key = tid >> 3, c = tid & 7;
    *(PG8_LAS u32x4*)(Ks + key * KLD + 8 * c) = R.k;
    if (MLA) { if (tid < 256) *(PG8_LAS u32x4*)(Ks + (tid >> 2) * KLD + 64 + 8 * (tid & 3)) = R.k2; }
    { const int kv = tid & 63, cv = tid >> 6, kp = (kv & ~12) | ((kv & 4) << 1) | ((kv & 8) >> 1);
#pragma unroll
      for (int j = 0; j < 8; ++j) Vt[(8 * cv + j) * A_VLD + kp] = (bf16_t)(R.v[j >> 1] >> (16 * (j & 1))); }
}
template <int KS> DI void qk_tile(lbf Ks, const bf16x8 (&Q)[KS], f32x16& s0, f32x16& s1, int r, int h) {
    constexpr int KLD = KS == 6 ? 104 : 72;
#pragma unroll
    for (int i = 0; i < 16; ++i) { s0[i] = 0.f; s1[i] = 0.f; }
    const PG8_LAS bf16x8* p0 = (const PG8_LAS bf16x8*)(Ks + r * KLD + 8 * h); const PG8_LAS bf16x8* p1 = (const PG8_LAS bf16x8*)(Ks + (32 + r) * KLD + 8 * h);
    bf16x8 a0 = p0[0], a1 = p1[0], b0, b1;
#pragma unroll
    for (int ks = 0; ks < KS; ks += 2) {
        b0 = p0[2 * (ks + 1)]; b1 = p1[2 * (ks + 1)];
        __builtin_amdgcn_sched_barrier(0);
        s0 = MFMA32(a0, Q[ks], s0); s1 = MFMA32(a1, Q[ks], s1);
        __builtin_amdgcn_sched_barrier(0);
        if (ks + 2 < KS) { a0 = p0[2 * (ks + 2)]; a1 = p1[2 * (ks + 2)]; }
        __builtin_amdgcn_sched_barrier(0);
        s0 = MFMA32(b0, Q[ks + 1], s0); s1 = MFMA32(b1, Q[ks + 1], s1);
        __builtin_amdgcn_sched_barrier(0);
    }
}
DI bf16x8 pack8(const f32x16& p, int s) {
    u32x4 w; w.x = cvt2(p[8 * s], p[8 * s + 1]); w.y = cvt2(p[8 * s + 2], p[8 * s + 3]); w.z = cvt2(p[8 * s + 4], p[8 * s + 5]); w.w = cvt2(p[8 * s + 6], p[8 * s + 7]);
    return __builtin_bit_cast(bf16x8, w);
}
DI void pv_load(lbf Vt, int g, int r, int h, bf16x8& v0, bf16x8& v1) {
    const int col = 32 * (g >> 1) + 16 * (g & 1) + 8 * h;
    v0 = *(const PG8_LAS bf16x8*)(Vt + r * A_VLD + col); v1 = *(const PG8_LAS bf16x8*)(Vt + (32 + r) * A_VLD + col);
}
DI void pv_tile(lbf Vt, const f32x16& p0, const f32x16& p1, f32x16 (&O)[2], int r, int h) {
    bf16x8 va0, va1, vb0, vb1;
    pv_load(Vt, 0, r, h, va0, va1);
#pragma unroll
    for (int g = 0; g < 4; g += 2) {
        pv_load(Vt, g + 1, r, h, vb0, vb1);
        const bf16x8 pa = pack8(g >> 1 ? p1 : p0, 0);
        __builtin_amdgcn_sched_barrier(0);
        O[0] = MFMA32(va0, pa, O[0]); O[1] = MFMA32(va1, pa, O[1]);
        __builtin_amdgcn_sched_barrier(0);
        if (g + 2 < 4) pv_load(Vt, g + 2, r, h, va0, va1);
        const bf16x8 pb = pack8(g >> 1 ? p1 : p0, 1);
        __builtin_amdgcn_sched_barrier(0);
        O[0] = MFMA32(vb0, pb, O[0]); O[1] = MFMA32(vb1, pb, O[1]);
        __builtin_amdgcn_sched_barrier(0);
    }
}
DI float row_max(const f32x16& x0, const f32x16& x1) {
    float mx = fmaxf(x0[0], x1[0]);
#pragma unroll
    for (int i = 1; i < 16; ++i) mx = fmaxf(mx, fmaxf(x0[i], x1[i]));
    return fmaxf(mx, __shfl_xor(mx, 32));
}
template <bool PV> DI void online_step_mx(f32x16& x0, f32x16& x1, float mx, float& m, float& l, f32x16 (&O)[2]);
template <bool PV> DI void online_step(f32x16& x0, f32x16& x1, float& m, float& l, f32x16 (&O)[2]) { online_step_mx<PV>(x0, x1, row_max(x0, x1), m, l, O); }
template <bool PV> DI void online_step_mx(f32x16& x0, f32x16& x1, float mx, float& m, float& l, f32x16 (&O)[2]) {
    const float mn = fmaxf(m, mx), alpha = __builtin_amdgcn_exp2f(m - mn);
    float ls = 0.f;
#pragma unroll
    for (int i = 0; i < 16; ++i) { x0[i] = __builtin_amdgcn_exp2f(x0[i] - mn); x1[i] = __builtin_amdgcn_exp2f(x1[i] - mn); ls += x0[i] + x1[i]; }
    ls += __shfl_xor(ls, 32);
    l = l * alpha + ls; m = mn;
    if (PV) { if (__any(alpha != 1.f)) {
#pragma unroll
        for (int i = 0; i < 16; ++i) { O[0][i] *= alpha; O[1][i] *= alpha; } } }
}
DI void online_raw(f32x16& s0, f32x16& s1, float c1, float& m, float& l, f32x16 (&O)[2]) {
    float mx = fmaxf(s0[0], s1[0]);
#pragma unroll
    for (int i = 1; i < 16; ++i) mx = fmaxf(mx, fmaxf(s0[i], s1[i]));
    mx = fmaxf(mx, __shfl_xor(mx, 32));
    const float mxe = mx * c1;
    if (__any(mxe - m > 8.f)) {
        const float mn = fmaxf(m, mxe), alpha = __builtin_amdgcn_exp2f(m - mn);
        l *= alpha; m = mn;
#pragma unroll
        for (int i = 0; i < 16; ++i) { O[0][i] *= alpha; O[1][i] *= alpha; }
    }
    const float nmn = -m;
    float ls = 0.f;
#pragma unroll
    for (int i = 0; i < 16; ++i) { s0[i] = __builtin_amdgcn_exp2f(fmaf(s0[i], c1, nmn)); s1[i] = __builtin_amdgcn_exp2f(fmaf(s1[i], c1, nmn)); ls += s0[i] + s1[i]; }
    ls += __shfl_xor(ls, 32);
    l += ls;
}
struct TlRange { int lo, hi; DI int first() const { return lo <= hi ? lo * 64 : -1; } DI int next(int kb) const { return kb + 64 <= hi * 64 ? kb + 64 : -1; } };
struct TlRangeDesc { int lo, hi; DI int first() const { return lo <= hi ? hi * 64 : -1; } DI int next(int kb) const { return kb - 64 >= lo * 64 ? kb - 64 : -1; } };
struct TlMaskDesc { unsigned long long mask; DI int first() const { return mask ? (63 - __clzll((long long)mask)) * 64 : -1; }
    DI int next(int kb) const { const int j = kb >> 6; const unsigned long long rest = j == 0 ? 0ull : (mask & ((1ull << j) - 1ull)); return rest ? (63 - __clzll((long long)rest)) * 64 : -1; } };
struct TlMask { unsigned long long mask; DI int first() const { return mask ? (__ffsll((long long)mask) - 1) * 64 : -1; }
    DI int next(int kb) const { const int j = kb >> 6; const unsigned long long rest = j >= 63 ? 0ull : (mask >> (j + 1)); return rest ? (j + 1 + __ffsll((long long)rest) - 1) * 64 : -1; } };
template <bool MLA, class TL, class CF>
DI void att_pipe(lbf KB, lbf VB, const bf16_t* kp, size_t kst, const bf16_t* vp, size_t vst, const bf16_t* k2p, const TL& tl, CF& cf, int) {
    int kb = tl.first(); if (kb < 0) return;
    const int tid = tid_now();
    TileRegs R0, R1; tile_gload<MLA>(R0, kp, kst, vp, vst, k2p, kb, tid);
    int nk = tl.next(kb);
    tile_gload<MLA>(R1, kp, kst, vp, vst, k2p, nk >= 0 ? nk : kb, tid);
    __syncthreads();
    tile_lstore<MLA>(R0, KB, VB, tid);
    __syncthreads();
    int cb = 0;
#define ATT_STEP(RA, RB) { const int nn = nk >= 0 ? tl.next(nk) : -1; \
        tile_gload<MLA>(RA, kp, kst, vp, vst, k2p, nn >= 0 ? nn : kb, tid);     \
        cf(KB + cb * A_KSZ, VB + cb * A_VSZ, kb); \
        if (nk >= 0) tile_lstore<MLA>(RB, KB + (cb ^ 1) * A_KSZ, VB + (cb ^ 1) * A_VSZ, tid); \
        __syncthreads(); \
        if (nk < 0) break; \
        kb = nk; nk = nn; cb ^= 1; }
    for (;;) {
        ATT_STEP(R0, R1)
        ATT_STEP(R1, R0)
    }
#undef ATT_STEP
}
struct CfMla { const bf16x8 (&Q)[6]; f32x16 (&O)[2]; float& m; float& l; int t, tq0, r, h;
    DI void operator()(lbf Ks, lbf Vt, int kb) {
        if (kb > __builtin_amdgcn_readfirstlane(tq0) + 31) return;
        f32x16 x0, x1; qk_tile<6>(Ks, Q, x0, x1, r, h);
        const float c1 = 0.10206207261596575f * LOG2E;
        if (kb + 63 > __builtin_amdgcn_readfirstlane(tq0)) {
            const int dt = t - kb - 4 * h;
#pragma unroll
            for (int i = 0; i < 16; ++i) { const int ci = (i & 3) + 8 * (i >> 2); x0[i] = ci <= dt ? x0[i] : -INFINITY; x1[i] = ci + 32 <= dt ? x1[i] : -INFINITY; }
        }
        online_raw(x0, x1, c1, m, l, O); pv_tile(Vt, x0, x1, O, r, h);
    } };
template <bool SEL> struct CfNsa { const bf16x8 (&Q)[4]; f32x16 (&O)[2]; float& m; float& l; int t, r, h; float sl2; unsigned long long qsel;
    DI void operator()(lbf Ks, lbf Vt, int kb) {
        f32x16 x0, x1; qk_tile<4>(Ks, Q, x0, x1, r, h);
        const float c1 = 0.125f * LOG2E; const bool on = !SEL || ((qsel >> (kb >> 6)) & 1ull);
        const int tq0 = __builtin_amdgcn_readfirstlane(t - r);
        const float base = on ? sl2 * (float)(kb + 4 * h - t) : -INFINITY;
#pragma unroll
        for (int i = 0; i < 16; ++i) { const int ci = (i & 3) + 8 * (i >> 2); x0[i] = fmaf(x0[i], c1, fmaf(sl2, (float)ci, base)); x1[i] = fmaf(x1[i], c1, fmaf(sl2, (float)(ci + 32), base)); }
        if (kb + 63 > tq0 || (!SEL && tq0 + 31 - kb >= 512)) {
            const int dt = t - kb - 4 * h;
#pragma unroll
            for (int i = 0; i < 16; ++i) { const int ci = (i & 3) + 8 * (i >> 2);
                const bool v0 = ci <= dt && (SEL || dt - ci < 512), v1 = ci + 32 <= dt && (SEL || dt - ci - 32 < 512);
                x0[i] = v0 ? x0[i] : -INFINITY; x1[i] = v1 ? x1[i] : -INFINITY; }
        }
        {
            const float mx = row_max(x0, x1);
            if (!__any(mx - m > -160.f)) return;
            online_step_mx<true>(x0, x1, mx, m, l, O);
        }
        pv_tile(Vt, x0, x1, O, r, h);
    } };
struct CfCmp { const bf16x8 (&Q)[4]; f32x16 (&O)[2]; float& m; float& l; int t, r, h; float sl2; int nvis; PG8_LAS float* imp; int nvmin;
    DI void operator()(lbf Ks, lbf Vt, int kb) {
        f32x16 x0, x1; qk_tile<4>(Ks, Q, x0, x1, r, h);
        const float c1 = 0.125f * LOG2E;
        const int dn = nvis - kb - 4 * h;
        const float df = sl2 * (float)(16 * (kb + 4 * h) + 31 - t), s16 = 16.f * sl2;
#pragma unroll
        for (int i = 0; i < 16; ++i) { const int ci = (i & 3) + 8 * (i >> 2); const float bi = fmaf(s16, (float)ci, df); x0[i] = fmaf(x0[i], c1, bi); x1[i] = fmaf(x1[i], c1, bi + 32.f * s16); }
        if (kb + 64 > __builtin_amdgcn_readfirstlane(nvmin)) {
#pragma unroll
            for (int i = 0; i < 16; ++i) { const int ci = (i & 3) + 8 * (i >> 2); x0[i] = ci < dn ? x0[i] : -INFINITY; x1[i] = ci + 32 < dn ? x1[i] : -INFINITY; }
        }
        const float mold = m, mxr = row_max(x0, x1);
        if (!__any(mxr - m > -160.f)) return;
        online_step_mx<true>(x0, x1, mxr, m, l, O);
        const float alpha = __builtin_amdgcn_exp2f(mold - m);
        if (__any(alpha != 1.f && mold > -1e29f)) {
#pragma unroll 4
            for (int k = 0; k < 32; ++k) imp[2 * k + h] *= alpha;
        }
        pv_tile(Vt, x0, x1, O, r, h);
        { const int a0 = (kb >> 2) + h; float o[8];
#pragma unroll
          for (int k = 0; k < 8; ++k) o[k] = imp[a0 + 2 * k];
#pragma unroll
          for (int k = 0; k < 8; ++k) { const f32x16& p = (k >> 2) ? x1 : x0; const int g4 = k & 3; imp[a0 + 2 * k] = o[k] + ((p[4 * g4] + p[4 * g4 + 1]) + (p[4 * g4 + 2] + p[4 * g4 + 3])); }
          asm volatile("" ::: "memory");
#pragma unroll
          for (int k = 0; k < 8; ++k) o[k] = imp[a0 + 2 * k + 1];
#pragma unroll
          for (int k = 0; k < 8; ++k) { const f32x16& p = (k >> 2) ? x1 : x0; imp[a0 + 2 * k + 1] = o[k] + p[4 * (k & 3) + 3]; }
          asm volatile("" ::: "memory"); }
    } };
DI void write_o(bf16_t* dst, const f32x16 (&O)[2], float sc, int h) {
#pragma unroll
    for (int dh = 0; dh < 2; ++dh)
#pragma unroll
        for (int g4 = 0; g4 < 4; ++g4) { u32x2 w; w.x = cvt2(O[dh][4 * g4] * sc, O[dh][4 * g4 + 1] * sc); w.y = cvt2(O[dh][4 * g4 + 2] * sc, O[dh][4 * g4 + 3] * sc);
            *(u32x2*)(dst + 32 * dh + 8 * g4 + 4 * h) = w; }
}
DI void zero_o(f32x16 (&O)[2]) {
#pragma unroll
    for (int i = 0; i < 16; ++i) { O[0][i] = 0.f; O[1][i] = 0.f; }
}
DI void unit_mla(Frame& F, int b, int hd, int qb, int tid) {
    const int lane = tid & 63, w = tid >> 6, r = lane & 31, h = lane >> 5, tq0 = qb * 256 + 32 * w, t = tq0 + r; const size_t row = (size_t)b * S + t;
    lbf KB = (lbf)(F.ldsp + A_KOFF), VB = (lbf)(F.ldsp + A_VOFF);
    bf16x8 Q[6];
    const bf16_t* qr = F.q() + row * 768;
#pragma unroll
    for (int ks = 0; ks < 4; ++ks) Q[ks] = *(const bf16x8*)(qr + hd * 64 + 16 * ks + 8 * h);
    { const bf16x8 x1 = *(const bf16x8*)(qr + 512 + hd * 32 + 8 * h), x2 = *(const bf16x8*)(qr + 512 + hd * 32 + 16 + 8 * h);
      int ro = t * 16 + 8 * h; asm volatile("" : "+v"(ro));
      const f32x4* cs = (const f32x4*)(F.rope() + ro); const f32x4* sn = (const f32x4*)(F.rope() + S * 16 + ro);
      const f32x4 c0 = cs[0], c1 = cs[1], s0 = sn[0], s1 = sn[1];
#pragma unroll
      for (int j = 0; j < 8; ++j) { const float a = bf2f((bf16_t)x1[j]), bb = bf2f((bf16_t)x2[j]), c = j < 4 ? c0[j & 3] : c1[j & 3], s = j < 4 ? s0[j & 3] : s1[j & 3]; Q[4][j] = (short)f2bf(a * c - bb * s); Q[5][j] = (short)f2bf(bb * c + a * s); } }
    __builtin_amdgcn_sched_barrier(0);
    f32x16 O[2]; zero_o(O); float m = -1e30f, l = 0.f;
    CfMla cf{Q, O, m, l, t, tq0, r, h};
    const bf16_t* kvb = F.kv() + (size_t)b * S * 1024;
    att_pipe<true>(KB, VB, kvb + hd * 64, 1024, kvb + 512 + hd * 64, 1024, F.kr() + (size_t)b * S * 32, TlRange{0, 4 * qb + 3}, cf, tid);
    write_o(F.mix() + row * DM + hd * 64, O, 1.f / l, h);
}
DI void unit_nsa(Frame& F, int b, int g, int qt, int tid) {
    const int lane = tid & 63, w = tid >> 6, r = lane & 31, h = lane >> 5, rh = w >> 1, sub = w & 1, hd = 4 * g + rh, ql = 32 * sub + r, t = qt * 64 + ql, bg = b * 2 + g;
    const size_t row = (size_t)b * S + t;
    lbf KB = (lbf)(F.ldsp + A_KOFF), VB = (lbf)(F.ldsp + A_VOFF);
    PG8_LAS float* impr = (PG8_LAS float*)(F.ldsp + A_IMP) + (rh * 64 + ql) * A_IMPLD;
    PG8_LAS unsigned* selm = (PG8_LAS unsigned*)(F.ldsp + A_SELM); PG8_LAS unsigned* uni = (PG8_LAS unsigned*)(F.ldsp + A_UNI);
    const bf16_t* zb = F.z() + (size_t)b * S * ZP;
    bf16x8 Q[4];
#pragma unroll
    for (int ks = 0; ks < 4; ++ks) Q[ks] = *(const bf16x8*)(F.z() + row * ZP + Z_QN + hd * 64 + 16 * ks + 8 * h);
    const float sl2 = exp2f(-(float)(hd + 1)) * LOG2E;
    const bf16_t* gt = F.z() + row * ZP + Z_GT + hd * 3;
    const float g0 = 1.f / (1.f + __expf(-bf2f(gt[0]))), g1 = 1.f / (1.f + __expf(-bf2f(gt[1]))), g2 = 1.f / (1.f + __expf(-bf2f(gt[2])));
    f32x16 O[2], Of[2]; float m, l;
    const int tmax = qt * 64 + 63, nvmax = tmax >= 31 ? ((tmax - 31) >> 4) + 1 : 0, ntc = (nvmax + 63) >> 6, nvis = t >= 31 ? ((t - 31) >> 4) + 1 : 0;
    const int tw0 = t - r, nvmin = tw0 >= 31 ? ((tw0 - 31) >> 4) + 1 : 0;
    const bf16_t* kc = F.kcmp() + (size_t)bg * 256 * 64; const bf16_t* vc = F.vcmp() + (size_t)bg * 256 * 64;
    if (tid < 2) uni[tid] = 0u;
#pragma unroll
    for (int i = 0; i < 32; ++i) impr[32 * h + i] = 0.f;
    zero_o(O); m = -1e30f; l = 0.f;
    PG8_LAS float* ilq = (PG8_LAS float*)(F.ldsp + A_IL);
    { CfCmp c1{Q, O, m, l, t, r, h, sl2, nvis, impr, nvmin}; att_pipe<false>(KB, VB, kc, 64, vc, 64, nullptr, TlRangeDesc{0, ntc - 1}, c1, tid); }
    { const float il = l > 0.f ? 1.f / l : 0.f; if (h == 0) ilq[rh * 64 + ql] = il;
#pragma unroll
      for (int i = 0; i < 16; ++i) { Of[0][i] = (g0 * il) * O[0][i]; Of[1][i] = (g0 * il) * O[1][i]; } }
    __syncthreads();
#ifndef X_TOPK
    __builtin_amdgcn_sched_barrier(0);
    { const int tid = tid_now();
        PG8_LAS float* ib = (PG8_LAS float*)(F.ldsp + A_IMP);
        const int q = tid >> 3, jj = tid & 7;
        float mine[8];
#pragma unroll
        for (int k = 0; k < 8; ++k) { const int j = 8 * jj + k; const int o = q * A_IMPLD + j;
            float v = ((ib[o] * ilq[q] + ib[64 * A_IMPLD + o] * ilq[64 + q]) + ib[2 * 64 * A_IMPLD + o] * ilq[128 + q]) + ib[3 * 64 * A_IMPLD + o] * ilq[192 + q];
            if (j > qt) v = -INFINITY; if (j == 0 || j == qt || j == qt - 1) v = INFINITY; mine[k] = v; }
        __syncthreads();
#pragma unroll
        for (int k = 0; k < 8; ++k) ib[q * A_IMPLD + 8 * jj + k] = mine[k];
        __syncthreads();
        int rank[8];
#pragma unroll
        for (int k = 0; k < 8; ++k) rank[k] = 0;
        for (int j2 = 0; j2 <= qt; ++j2) { const float v2 = ib[q * A_IMPLD + j2];
#pragma unroll
            for (int k = 0; k < 8; ++k) rank[k] += (v2 > mine[k] || (v2 == mine[k] && j2 < 8 * jj + k)) ? 1 : 0; }
        unsigned bits = 0u;
#pragma unroll
        for (int k = 0; k < 8; ++k) if (rank[k] < 16 && 8 * jj + k <= qt) bits |= 1u << k;
        unsigned lo = jj < 4 ? bits << (8 * jj) : 0u, hi = jj >= 4 ? bits << (8 * (jj - 4)) : 0u;
#pragma unroll
        for (int o = 1; o < 8; o <<= 1) { lo |= __shfl_xor(lo, o); hi |= __shfl_xor(hi, o); }
        if (jj == 0) { selm[2 * q] = lo; selm[2 * q + 1] = hi; __hip_atomic_fetch_or(uni, lo, __ATOMIC_RELAXED, __HIP_MEMORY_SCOPE_WORKGROUP); __hip_atomic_fetch_or(uni + 1, hi, __ATOMIC_RELAXED, __HIP_MEMORY_SCOPE_WORKGROUP); }
        __syncthreads();
    }
#endif
    const unsigned long long qsel = (unsigned long long)selm[2 * ql] | ((unsigned long long)selm[2 * ql + 1] << 32);
    const unsigned long long umask = (unsigned long long)uni[0] | ((unsigned long long)uni[1] << 32);
    zero_o(O); m = -1e30f; l = 0.f;
#ifndef X_SEL
    __builtin_amdgcn_sched_barrier(0);
    { const int r = tid_now() & 31, h = (tid_now() >> 5) & 1; CfNsa<true> cs{Q, O, m, l, t, r, h, sl2, qsel}; att_pipe<false>(KB, VB, zb + Z_KS + g * 64, ZP, zb + Z_VS + g * 64, ZP, nullptr, TlMaskDesc{umask}, cs, tid); }
#endif
    { const float sc = g1 / l;
#pragma unroll
      for (int i = 0; i < 16; ++i) { Of[0][i] += sc * O[0][i]; Of[1][i] += sc * O[1][i]; } }
    zero_o(O); m = -1e30f; l = 0.f;
#ifndef X_WIN
    __builtin_amdgcn_sched_barrier(0);
    { const int r = tid_now() & 31, h = (tid_now() >> 5) & 1; CfNsa<false> cw{Q, O, m, l, t, r, h, sl2, 0ull}; att_pipe<false>(KB, VB, zb + Z_KW + g * 64, ZP, zb + Z_VW + g * 64, ZP, nullptr, TlRangeDesc{qt >= 8 ? qt - 8 : 0, qt}, cw, tid); }
#endif
    { const float sc = g2 / l;
#pragma unroll
      for (int i = 0; i < 16; ++i) { Of[0][i] += sc * O[0][i]; Of[1][i] += sc * O[1][i]; } }
    write_o(F.mix() + row * DM + 512 + hd * 64, Of, 1.f, h);
}
DI void phase_attn_fast(Frame& F, int l) {
    const int tid = tid_now();
    PG8_LAS int* qidx = (PG8_LAS int*)(F.ldsp + A_QIDX);
    unsigned* ctr = (unsigned*)(F.ws + WS_CTL) + (l & 3);
    unsigned* done = (unsigned*)(F.ws + WS_CTL) + 8 + (l & 1);
    if (blockIdx.x < 16 && l < 2) {
        const int c = blockIdx.x, G = gridDim.x, v = c >> 3, u = c & 7;
        if (v == 0) run_gemm(F.ldsp, pg8::Gemm{F.z() + Z_KC, F.wl(l, W_C1K), 2048, 256, 2048, 16 * ZP, ZP * 2, 1}, pg8::EpiG<pg8::EM_GELU, 0>{F.hidk(), 256, 128, nullptr, 0, F.b1(l, 0), nullptr, nullptr, nullptr}, G, u);
        else run_gemm(F.ldsp, pg8::Gemm{F.z() + Z_VC, F.wl(l, W_C1V), 2048, 256, 2048, 16 * ZP, ZP * 2, 1}, pg8::EpiG<pg8::EM_GELU, 0>{F.hidv(), 256, 128, nullptr, 0, F.b1(l, 1), nullptr, nullptr, nullptr}, G, u);
        __threadfence(); __syncthreads(); __builtin_amdgcn_fence(__ATOMIC_ACQUIRE, "agent");
        if (v == 0) ngemm(APlain{F.hidk() + (size_t)u * 256 * 256, 256}, F.wl(l, W_C2K), 128, 256, 64, 128, EpiPlain{F.kcmp() + (size_t)u * 256 * 64, 64}, true);
        else ngemm(APlain{F.hidv() + (size_t)u * 256 * 256, 256}, F.wl(l, W_C2V), 128, 256, 64, 128, EpiPlain{F.vcmp() + (size_t)u * 256 * 64, 64}, true);
        __threadfence(); __syncthreads();
        if (tid == 0) __hip_atomic_fetch_add(done, 1u, __ATOMIC_RELEASE, __HIP_MEMORY_SCOPE_AGENT);
    }
    bool cmp_ok = false;
    __syncthreads();
    if (tid == 0) qidx[0] = (int)atomicAdd(ctr, 1u);
    for (;;) {
        __syncthreads();
        const int i = qidx[0];
        if (i >= 1024) break;
        unsigned nxt = 0u; if (tid == 0) nxt = atomicAdd(ctr, 1u);
        int tidu = tid; asm volatile("" : "+v"(tidu));
        if (i < 512) { const int k = i & 31; unit_mla(F, k >> 3, k & 7, 15 - (i >> 5), tidu); }
        else {
            if (!cmp_ok) {
                if (tid == 0) { while (__hip_atomic_load(done, __ATOMIC_RELAXED, __HIP_MEMORY_SCOPE_AGENT) < 16u) __builtin_amdgcn_s_sleep(8); }
                __syncthreads(); __builtin_amdgcn_fence(__ATOMIC_ACQUIRE, "agent"); cmp_ok = true;
            }
            const int j = i - 512; unit_nsa(F, (j & 7) >> 1, j & 1, 63 - (j >> 3), tidu);
        }
        __syncthreads();
        if (tid == 0) qidx[0] = (int)nxt;
    }
}
DI void phase_conv(Frame& F, int l, int b) {
    const float* cw = F.gin(16) + (size_t)l * 3 * NUP; const float* cb = F.gin(17) + (size_t)l * NUP;
    const bf16_t* hu = F.hu(); bf16_t* ga = F.gact() + (size_t)b * S * DFF;
    for (size_t i = (size_t)blockIdx.x * NT + F.tid; i < (size_t)S * DFF; i += (size_t)gridDim.x * NT) {
        const int t = (int)(i / DFF), c = (int)(i % DFF), pn = c >> 7, j = c & 127, colg = pn * 256 + j, colu = colg + 128, cu = DFF + c;
        float hg = cb[c], hup = cb[cu];
#pragma unroll
        for (int k = 0; k < 3; ++k) { const int tt = t - 2 + k; if (tt >= 0) { hg += cw[k * NUP + c] * bf2f(hu[(size_t)tt * NUP + colg]); hup += cw[k * NUP + cu] * bf2f(hu[(size_t)tt * NUP + colu]); } }
        ga[(size_t)t * DFF + c] = f2bf(hg / (1.f + __expf(-hg)) * hup);
    }
}
DI void phase_final(Frame& F) {
    const float* fn = F.gin(19);
    for (int row = F.gw; row < M; row += F.ngw) {
        const float rs = rstd_h(F.ssqh(), row); f32x4* hr = (f32x4*)(F.h() + (size_t)row * DM) + F.lane; const f32x4* gn = (const f32x4*)fn + F.lane;
#pragma unroll
        for (int j = 0; j < 4; ++j) hr[64 * j] = hr[64 * j] * rs * gn[64 * j];
    }
}

constexpr int NPH = 13;
DI void run_phase(Frame& F, int ph) {
    if (ph == 0) { phase_prep(F);
#ifdef DUP_PREP
        __syncthreads(); phase_prep(F);
#endif
        return; }
    const int l = (ph - 1) / 6, s0_ = (ph - 1) % 6;
    const int s = s0_ == 0 ? 0 : (s0_ == 1 ? 2 : (s0_ == 2 ? 4 : (s0_ == 3 ? 5 : (s0_ == 4 ? 7 : 15))));
#ifdef ONLY_S
    if (s != ONLY_S) return;
#endif
    int G = gridDim.x, c = blockIdx.x; asm volatile("" : "+s"(G), "+s"(c));
    if (s == 0) { run_gemm(F.ldsp, pg8::Gemm{F.hb(), F.wl(l, W_IN), M, ZP, 1024, DM, 128, 0}, pg8::EpiG<pg8::EM_SCALEH, 2>{F.z(), ZP, ZP, F.ssqh(), 0, nullptr, nullptr, F.ssqz(), nullptr}, G, c);
#ifdef DUP_ZP
        run_gemm(F.ldsp, pg8::Gemm{F.hb(), F.wl(l, W_IN), M, ZP, 1024, DM, 128, 0}, pg8::EpiG<pg8::EM_SCALEH, 2>{F.z(), ZP, ZP, F.ssqh(), 0, nullptr, nullptr, F.ssqz(), nullptr}, G, c);
#endif
        return; }
    if (s == 1) { phase_stat_z(F); return; }
    if (s == 2) {
        run_gemm(F.ldsp, pg8::Gemm{F.z() + Z_CQ, F.wl(l, W_UQ), M, 768, 384, ZP, 128, 0}, pg8::EpiG<pg8::EM_SCALEQ, 0>{F.q(), 768, 768, F.ssqz(), 0, nullptr, nullptr, nullptr, nullptr}, G, c);
        run_gemm(F.ldsp, pg8::Gemm{F.z() + Z_CKV, F.wl(l, W_UKV), M, 1024, 256, ZP, 128, 0}, pg8::EpiG<pg8::EM_SCALEKV, 0>{F.kv(), 1024, 1024, F.ssqz(), 0, nullptr, nullptr, nullptr, nullptr}, G, c);
        job_krope(F);
        if (blockIdx.x == gridDim.x - 1 && F.tid < 256) {
            const int v = F.tid >> 7, e = F.tid & 127; const float* pp = (const float*)(F.ws + WS_B1) + 1024 + ((l * 2 + v) * 16) * 128 + e; float s = 0.f;
            for (int kp = 0; kp < 16; ++kp) s += pp[kp * 128];
            F.b1(l, v)[e] = s;
        }
#ifdef DUP_ZP
        run_gemm(F.ldsp, pg8::Gemm{F.z() + Z_CQ, F.wl(l, W_UQ), M, 768, 384, ZP, 128, 0}, pg8::EpiG<pg8::EM_SCALEQ, 0>{F.q(), 768, 768, F.ssqz(), 0, nullptr, nullptr, nullptr, nullptr}, G, c);
        run_gemm(F.ldsp, pg8::Gemm{F.z() + Z_CKV, F.wl(l, W_UKV), M, 1024, 256, ZP, 128, 0}, pg8::EpiG<pg8::EM_SCALEKV, 0>{F.kv(), 1024, 1024, F.ssqz(), 0, nullptr, nullptr, nullptr, nullptr}, G, c);
        job_krope(F);
#endif
        return;
    }
#ifdef NAIVE_ATTN
    if (s == 4) { phase_attn_naive(F); return; }
#else
    if (s == 4) { phase_attn_fast(F, l);
#ifdef DUP_ATT
        phase_attn_fast(F, l + 2);
#endif
        return; }
#endif
    if (s == 5) { run_gemm(F.ldsp, pg8::Gemm{F.mix(), F.wl(l, W_O), M, DM, 1024, DM, 128, 0}, pg8::EpiG<pg8::EM_RES, 1>{F.hb(), DM, DM, nullptr, 0, nullptr, F.h(), F.ssqh(), l == 0 ? F.gin(0) : (const float*)F.h()}, G, c); return; }
    if (s == 6 || s == 16) { phase_stat_h(F); return; }
    if (s == 7) {
#ifdef CONV256
        run_gemm(F.ldsp, pg8::Gemm{F.hb(), F.wl(l, W_UP), M, NUP, 1024, DM, 128, 0},
                 pg8::EpiConv<256>{F.gact(), F.ssqh(), F.gin(16) + (size_t)l * 3 * NUP, F.gin(17) + (size_t)l * NUP, (PG8_LAS float*)(F.ldsp + 131072)}, G, c);
        return;
#endif
        run_gemm(F.ldsp, pg8::Gemm{F.hb(), F.wl(l, W_UP), 68 * 256, NUP, 1024, DM, 128, 2},
                 pg8::EpiConv<254>{F.gact(), F.ssqh(), F.gin(16) + (size_t)l * 3 * NUP, F.gin(17) + (size_t)l * NUP, (PG8_LAS float*)(F.ldsp + 131072)}, G, c);
#ifdef DUP_UP
        run_gemm(F.ldsp, pg8::Gemm{F.hb(), F.wl(l, W_UP), 68 * 256, NUP, 1024, DM, 128, 2},
                 pg8::EpiConv<254>{F.gact(), F.ssqh(), F.gin(16) + (size_t)l * 3 * NUP, F.gin(17) + (size_t)l * NUP, (PG8_LAS float*)(F.ldsp + 131072)}, G, c);
#endif
        return;
    }
    if (s == 15 && l == 1) {
        run_gemm(F.ldsp, pg8::Gemm{F.gact(), F.wl(l, W_DN), M, DM, DFF, DFF, 128, 0},
                 pg8::EpiFinal{(const float*)F.h(), F.h(), F.gin(19), F.ssqh(), (unsigned*)(F.ws + WS_CTL + 32768), (PG8_LAS unsigned*)(F.ldsp + 131072)}, G, c);
        return;
    }
    if (s == 15) { run_gemm(F.ldsp, pg8::Gemm{F.gact(), F.wl(l, W_DN), M, DM, DFF, DFF, 128, 0}, pg8::EpiG<pg8::EM_RES, 1>{F.hb(), DM, DM, nullptr, 0, nullptr, F.h(), F.ssqh(), (const float*)F.h()}, G, c); return; }
}

__global__ void __launch_bounds__(NT, 2) mk(Params p) {
    extern __shared__ __attribute__((aligned(16))) unsigned char lds_raw[];
    float* smem = (float*)lds_raw;
    cg::grid_group grid = cg::this_grid();
    Frame F; F.kp = (const Params __attribute__((address_space(4)))*)__builtin_amdgcn_kernarg_segment_ptr(); F.ws = p.ws; F.smem = smem; F.ldsp = (PG8_LAS unsigned char*)lds_raw; F.tid = threadIdx.x; F.lane = F.tid & 63; F.wave = F.tid >> 6;
    F.gw = blockIdx.x * 8 + F.wave; F.ngw = gridDim.x * 8;
    if (threadIdx.x < 2) ((PG8_LAS unsigned*)(F.ldsp + LDS_ST))[threadIdx.x] = 0u;
    __syncthreads();
    XcdBarrier bar = xcd_barrier_post((unsigned*)(p.ws + WS_CTL + 1024), (volatile PG8_LAS unsigned*)(F.ldsp + LDS_ST));
    for (int ph = p.ph_lo; ph < p.ph_hi; ++ph) {
        { __attribute__((address_space(1))) unsigned char* wsg = (__attribute__((address_space(1))) unsigned char*)F.ws; asm volatile("" : "+s"(wsg), "+s"(F.kp)); F.ws = (unsigned char*)wsg; }
        { int t_ = threadIdx.x; asm volatile("" : "+v"(t_)); F.tid = t_; F.lane = t_ & 63; F.wave = t_ >> 6; F.gw = blockIdx.x * 8 + F.wave; }
        run_phase(F, ph);
        if (ph + 1 < p.ph_hi) {
            if (ph < 0) grid.sync();
            xcd_barrier(bar);
        }
    }
}

extern "C" void kernel_launch(void* const* d_in, const int* in_sizes, int n_in, void* d_out, int out_size, void* d_ws, size_t ws_size, hipStream_t stream) {
    if (n_in != 20 || ws_size < WS_ENDALL) { fprintf(stderr, "kernel_launch: unexpected n_in %d / ws %zu\n", n_in, ws_size); return; }
    static int grid_blocks = 0;
    if (!grid_blocks) {
        int dev = 0, cus = 0, per_cu = 0;
        hipGetDevice(&dev);
        hipDeviceGetAttribute(&cus, hipDeviceAttributeMultiprocessorCount, dev);
        hipFuncSetAttribute((const void*)mk, hipFuncAttributeMaxDynamicSharedMemorySize, LDS_BYTES);
        hipOccupancyMaxActiveBlocksPerMultiprocessor(&per_cu, mk, NT, LDS_BYTES);
        if (per_cu < 1) per_cu = 1;
        if (per_cu > 1) per_cu = 1;
        grid_blocks = cus * per_cu;
    }
    Params p{};
    for (int i = 0; i < 20; ++i) p.in[i] = (const float*)d_in[i];
    p.out = (float*)d_out; p.ws = (unsigned char*)d_ws;
    {
        p.ph_lo = 0; p.ph_hi = NPH;
        hipMemsetAsync((char*)d_ws + WS_CTL, 0, 65536, stream);
        void* args[] = {&p};
        hipError_t e = hipLaunchCooperativeKernel((void*)mk, dim3(grid_blocks), dim3(NT), args, LDS_BYTES, stream);
        if (e != hipSuccess) { fprintf(stderr, "cooperative launch failed: %s (grid %d)\n", hipGetErrorString(e), grid_blocks); }
    }
}
```
